# Optimizing an MI355X kernel written in HIP

```python
import math
import jax, jax.numpy as jnp
from jax import lax
import numpy as np

D_MODEL = 2048
BATCH = 2
SEQ = 4096
DEPTH = 2

N_A_LAYERS = DEPTH // 2
N_B_LAYERS = DEPTH - N_A_LAYERS
CHUNK = 128
SGU_GROUPS = 16
SGU_GROUP_DIM = D_MODEL // SGU_GROUPS
D_FF = -(-8 * D_MODEL // (3 * 256)) * 256
HEAD_DIM = 128
DIFF_HEADS = D_MODEL // (2 * HEAD_DIM)
N_SUB = 2 * DIFF_HEADS
V_DIM = 2 * HEAD_DIM
ROPE_THETA = 10000.0
Q_BLOCK = 128
EPS = 1e-6

kernel_name = 'yoco_gmlp_diffattn_adaln'


def rms_norm(x, g):
    xf = x.astype(jnp.float32)
    y = xf * lax.rsqrt(jnp.mean(xf * xf, axis=-1, keepdims=True) + EPS)
    return (y * g.astype(jnp.float32)).astype(x.dtype)


def layer_norm(x, g, b):
    xf = x.astype(jnp.float32)
    mu = jnp.mean(xf, axis=-1, keepdims=True)
    var = jnp.mean(jnp.square(xf - mu), axis=-1, keepdims=True)
    y = (xf - mu) * lax.rsqrt(var + EPS)
    return (y * g.astype(jnp.float32) + b.astype(jnp.float32)).astype(x.dtype)


def modulate(h, shift, scale):
    return h * (1.0 + scale[:, None, :]) + shift[:, None, :]


def ada_mod(c, w, b, n):
    m = jax.nn.silu(c) @ w + b
    return jnp.split(m, n, axis=-1)


def swiglu(h, wi, wo):
    g, u = jnp.split(h @ wi, 2, axis=-1)
    return (jax.nn.silu(g) * u) @ wo


def rope_tables(positions):
    inv_freq = 1.0 / (ROPE_THETA ** (jnp.arange(0, HEAD_DIM, 2, dtype=jnp.float32) / HEAD_DIM))
    ang = positions.astype(jnp.float32)[..., None] * inv_freq
    return jnp.cos(ang), jnp.sin(ang)


def apply_rope(x, cos, sin):
    xf = x.astype(jnp.float32)
    x1, x2 = jnp.split(xf, 2, axis=-1)
    cs = cos[:, :, None, :]
    sn = sin[:, :, None, :]
    return jnp.concatenate([x1 * cs - x2 * sn, x2 * cs + x1 * sn], axis=-1).astype(x.dtype)


def gmlp_layer(x, c, ada_w, ada_b, norm1_g, in_w, in_b, ln_g, ln_b, sgu_w, sgu_b, out_w,
               norm2_g, ffn_wi, ffn_wo):
    sh1, sc1, g1, sh2, sc2, g2 = ada_mod(c, ada_w, ada_b, 6)
    bsz, seq, _ = x.shape
    h = modulate(rms_norm(x, norm1_g), sh1, sc1)
    z = jax.nn.gelu(h @ in_w + in_b, approximate=False)
    u, v = jnp.split(z, 2, axis=-1)
    v = layer_norm(v, ln_g, ln_b)
    v = v.reshape(bsz, seq // CHUNK, CHUNK, SGU_GROUPS, SGU_GROUP_DIM)
    w = sgu_w * jnp.tril(jnp.ones((CHUNK, CHUNK), sgu_w.dtype))
    sv = jnp.einsum('gts,bnsgc->bntgc', w, v) + sgu_b.T[None, None, :, :, None]
    y = (u * sv.reshape(bsz, seq, D_MODEL)) @ out_w
    x = x + g1[:, None, :] * y
    h = modulate(rms_norm(x, norm2_g), sh2, sc2)
    return x + g2[:, None, :] * swiglu(h, ffn_wi, ffn_wo)


def shared_kv(x, c, kv_ada_w, kv_ada_b, kv_norm_g, kv_w, k_norm_g, cos, sin):
    bsz, seq, _ = x.shape
    sh, sc = ada_mod(c, kv_ada_w, kv_ada_b, 2)
    h = modulate(rms_norm(x, kv_norm_g), sh, sc)
    kv = h @ kv_w
    k = kv[..., :D_MODEL].reshape(bsz, seq, N_SUB, HEAD_DIM)
    k = apply_rope(rms_norm(k, k_norm_g), cos, sin)
    v = kv[..., D_MODEL:].reshape(bsz, seq, DIFF_HEADS, V_DIM)
    return k, v


def diff_attention(q, k, v, lam):
    bsz, seq, _, _ = q.shape
    n_blk = seq // Q_BLOCK
    scale = HEAD_DIM ** -0.5
    kh = k.transpose(0, 2, 1, 3)
    vh = v.transpose(0, 2, 1, 3)
    qb = q.transpose(0, 2, 1, 3).reshape(bsz, N_SUB, n_blk, Q_BLOCK, HEAD_DIM)
    qb = qb.transpose(2, 0, 1, 3, 4)
    key_pos = jnp.arange(seq)
    neg = jnp.finfo(jnp.float32).min

    def one_block(args):
        q_blk, i = args
        s = jnp.einsum('bhqd,bhkd->bhqk', q_blk, kh).astype(jnp.float32) * scale
        q_pos = i * Q_BLOCK + jnp.arange(Q_BLOCK)
        s = jnp.where(key_pos[None, :] <= q_pos[:, None], s, neg)
        p = jax.nn.softmax(s, axis=-1).reshape(bsz, DIFF_HEADS, 2, Q_BLOCK, seq)
        p = p[:, :, 0] - lam * p[:, :, 1]
        return jnp.einsum('bhqk,bhkd->bhqd', p.astype(vh.dtype), vh)

    out = lax.map(one_block, (qb, jnp.arange(n_blk)))
    return out.transpose(1, 0, 3, 2, 4).reshape(bsz, seq, DIFF_HEADS, V_DIM)


def diff_layer(x, c, k, v, cos, sin, layer_idx, ada_w, ada_b, norm1_g, q_w, q_norm_g,
               lq1, lk1, lq2, lk2, subln_g, o_w, norm2_g, ffn_wi, ffn_wo):
    sh1, sc1, g1, sh2, sc2, g2 = ada_mod(c, ada_w, ada_b, 6)
    bsz, seq, _ = x.shape
    h = modulate(rms_norm(x, norm1_g), sh1, sc1)
    q = (h @ q_w).reshape(bsz, seq, N_SUB, HEAD_DIM)
    q = apply_rope(rms_norm(q, q_norm_g), cos, sin)
    lam_init = 0.8 - 0.6 * math.exp(-0.3 * layer_idx)
    f32 = jnp.float32
    lam = (jnp.exp(jnp.sum(lq1.astype(f32) * lk1.astype(f32)))
           - jnp.exp(jnp.sum(lq2.astype(f32) * lk2.astype(f32))) + lam_init)
    o = diff_attention(q, k, v, lam)
    o = rms_norm(o, subln_g) * (1.0 - lam_init)
    y = o.reshape(bsz, seq, D_MODEL) @ o_w
    x = x + g1[:, None, :] * y
    h = modulate(rms_norm(x, norm2_g), sh2, sc2)
    return x + g2[:, None, :] * swiglu(h, ffn_wi, ffn_wo)


def setup_inputs(seed: int = 0) -> dict:
    key = jax.random.key(seed)
    ks = iter(jax.random.split(key, 48))
    f32 = jnp.float32

    def nrm(shape, fan_in, mult=1.0):
        return jax.random.normal(next(ks), shape, f32) * (mult * fan_in ** -0.5)

    def gain(shape):
        return 1.0 + 0.05 * jax.random.normal(next(ks), shape, f32)

    def bias(shape, s=0.02):
        return s * jax.random.normal(next(ks), shape, f32)

    D, NA, NB = D_MODEL, N_A_LAYERS, N_B_LAYERS
    x = jax.random.normal(next(ks), (BATCH, SEQ, D), f32)
    c = jax.random.normal(next(ks), (BATCH, D), f32)
    offs = jax.random.randint(next(ks), (BATCH, 1), 0, 1024, dtype=jnp.int32)
    positions = jnp.arange(SEQ, dtype=jnp.int32)[None, :] + offs
    return {
        'x': x, 'c': c, 'positions': positions,
        'a_ada_w': nrm((NA, D, 6 * D), D, 0.5), 'a_ada_b': bias((NA, 6 * D)),
        'a_norm1_g': gain((NA, D)),
        'a_in_w': nrm((NA, D, 2 * D), D), 'a_in_b': bias((NA, 2 * D)),
        'a_sgu_ln_g': gain((NA, D)), 'a_sgu_ln_b': bias((NA, D)),
        'a_sgu_w': nrm((NA, SGU_GROUPS, CHUNK, CHUNK), CHUNK),
        'a_sgu_b': 1.0 + bias((NA, SGU_GROUPS, CHUNK), 0.05),
        'a_out_w': nrm((NA, D, D), D),
        'a_norm2_g': gain((NA, D)),
        'a_ffn_wi': nrm((NA, D, 2 * D_FF), D), 'a_ffn_wo': nrm((NA, D_FF, D), D_FF),
        'kv_ada_w': nrm((D, 2 * D), D, 0.5), 'kv_ada_b': bias((2 * D,)),
        'kv_norm_g': gain((D,)), 'kv_w': nrm((D, 2 * D), D), 'k_norm_g': gain((HEAD_DIM,)),
        'b_ada_w': nrm((NB, D, 6 * D), D, 0.5), 'b_ada_b': bias((NB, 6 * D)),
        'b_norm1_g': gain((NB, D)),
        'b_q_w': nrm((NB, D, D), D), 'b_q_norm_g': gain((NB, HEAD_DIM)),
        'b_lambda_q1': bias((NB, HEAD_DIM), 0.1), 'b_lambda_k1': bias((NB, HEAD_DIM), 0.1),
        'b_lambda_q2': bias((NB, HEAD_DIM), 0.1), 'b_lambda_k2': bias((NB, HEAD_DIM), 0.1),
        'b_subln_g': gain((NB, V_DIM)),
        'b_o_w': nrm((NB, D, D), D),
        'b_norm2_g': gain((NB, D)),
        'b_ffn_wi': nrm((NB, D, 2 * D_FF), D), 'b_ffn_wo': nrm((NB, D_FF, D), D_FF),
    }


def reference(x, c, positions,
              a_ada_w, a_ada_b, a_norm1_g, a_in_w, a_in_b, a_sgu_ln_g, a_sgu_ln_b,
              a_sgu_w, a_sgu_b, a_out_w, a_norm2_g, a_ffn_wi, a_ffn_wo,
              kv_ada_w, kv_ada_b, kv_norm_g, kv_w, k_norm_g,
              b_ada_w, b_ada_b, b_norm1_g, b_q_w, b_q_norm_g,
              b_lambda_q1, b_lambda_k1, b_lambda_q2, b_lambda_k2, b_subln_g, b_o_w,
              b_norm2_g, b_ffn_wi, b_ffn_wo):
    cos, sin = rope_tables(positions)
    k_sh = None
    v_sh = None
    for l in range(DEPTH):
        if l < N_A_LAYERS:
            x = gmlp_layer(x, c, a_ada_w[l], a_ada_b[l], a_norm1_g[l], a_in_w[l], a_in_b[l],
                           a_sgu_ln_g[l], a_sgu_ln_b[l], a_sgu_w[l], a_sgu_b[l], a_out_w[l],
                           a_norm2_g[l], a_ffn_wi[l], a_ffn_wo[l])
        else:
            if l == N_A_LAYERS:
                k_sh, v_sh = shared_kv(x, c, kv_ada_w, kv_ada_b, kv_norm_g, kv_w, k_norm_g,
                                       cos, sin)
            j = l - N_A_LAYERS
            x = diff_layer(x, c, k_sh, v_sh, cos, sin, l, b_ada_w[j], b_ada_b[j],
                           b_norm1_g[j], b_q_w[j], b_q_norm_g[j], b_lambda_q1[j],
                           b_lambda_k1[j], b_lambda_q2[j], b_lambda_k2[j], b_subln_g[j],
                           b_o_w[j], b_norm2_g[j], b_ffn_wi[j], b_ffn_wo[j])
    return x
```

```cpp
#define MK_N_LAUNCHES 1
#include <hip/hip_runtime.h>
#include <hip/hip_bf16.h>
#include <cstdio>
#include <cstdint>
#include <cmath>
__host__ __device__ __forceinline__ size_t tidx(int r, int k, int K) { return ((size_t)(r >> 7) * (size_t)(K >> 6) + (size_t)(k >> 6)) * 8192 + (size_t)((r & 127) * 64 + (k & 63)); }
namespace pg8 {
#define PG8_LAS __attribute__((address_space(3)))
typedef unsigned short bf16_t;
typedef short bf16x8 __attribute__((ext_vector_type(8)));
typedef float f32x4 __attribute__((ext_vector_type(4)));
typedef unsigned u32x4 __attribute__((ext_vector_type(4)));
constexpr int BM = 256, BK = 64, HALF = 128, HTB = HALF * BK * 2  , STAGE_BYTES = 8 * HTB, NXCD = 8, WGM = 8;

__host__ __device__ __forceinline__ int lds_byte(int r, int c) { const int st = (r >> 4) * 2 + (c >> 5), rr = r & 15, cc = c & 31, ob = rr * 64 + cc * 2; return st * 1024 + (ob ^ (((ob >> 9) & 1) << 5)); }
__host__ __device__ __forceinline__ void stage_rc(int b, int& R, int& C) { const int st = b / 1024, sb = b % 1024, swz = sb ^ (((sb >> 9) & 1) << 5); R = (st >> 1) * 16 + swz / 64; C = (st & 1) * 32 + (swz % 64) / 2; }
__host__ __device__ __forceinline__ int perm32(int rho) { const int n = rho >> 4, i = rho & 15; return 8 * (i >> 2) + 4 * n + (i & 3); }

struct Unit { int pm, pn; };
struct Gemm { const bf16_t* A; const bf16_t* Bt; int M, N, K; };

struct StaticOrder {
    int nM, nN, nwg, G, c;
    __host__ __device__ void init(int M, int N, int G_, int c_) { nM = M / BM; nN = N / BM; nwg = nM * nN; G = G_; c = c_; }
    __host__ __device__ bool next(int i, Unit& u) const {
        const long L = (long)i * G + c; if (L >= nwg) return false;
        int wgid = (int)L; { const int q = nwg / NXCD, r = nwg % NXCD, xcd = wgid % NXCD, off = wgid / NXCD; wgid = (xcd < r ? xcd * (q + 1) : r * (q + 1) + (xcd - r) * q) + off; }
        const int nig = WGM * nN, gid = wgid / nig, fm = gid * WGM, gsz = (nM - fm) < WGM ? (nM - fm) : WGM;
        u.pm = fm + ((wgid % nig) % gsz); u.pn = (wgid % nig) / gsz; return true;
    }
    __device__ __forceinline__ void a_ready(const Unit&) const {}
    __device__ __forceinline__ void done(const Unit&) const {}
};

__device__ __forceinline__ unsigned cvt_pk_bf16(float lo, float hi) { unsigned r; asm volatile("v_cvt_pk_bf16_f32 %0, %1, %2" : "=v"(r) : "v"(lo), "v"(hi)); return r; }
typedef float f32x2 __attribute__((ext_vector_type(2)));
__device__ __forceinline__ f32x2 gelu_pk(f32x2 v) {
    const f32x2 av = __builtin_elementwise_abs(v), d = av * 0.2316418882f + 1.0f;
    f32x2 t; t.x = __builtin_amdgcn_rcpf(d.x); t.y = __builtin_amdgcn_rcpf(d.y);
    f32x2 q = t * 0.5307027145f + (-0.7265760135f); q = q * t + 0.7107068705f; q = q * t + (-0.142248368f); q = q * t + 0.127414796f; q = q * t;
    const f32x2 s = (v * v) * (-0.72134752044f);
    f32x2 e; e.x = __builtin_amdgcn_exp2f(s.x); e.y = __builtin_amdgcn_exp2f(s.y);
    const f32x2 m = v * (q * e), r = v - m;
    f32x2 o; o.x = v.x < 0.f ? m.x : r.x; o.y = v.y < 0.f ? m.y : r.y; return o;
}

template <int ACT  > struct EpiBf16 {
    static constexpr bool PERM = true, AFTER_DRAIN = false; static_assert(ACT == 0 || ACT == 1, "EpiBf16: ACT is 0 (none) or 1 (gelu_pk)");
    bf16_t* O; int ldc; const float* bias; int split_cols; size_t split_stride; float scale0;
    __device__ __forceinline__ void operator()(const f32x4 (&acc)[2][2][4][2], const Unit& u, int wr, int wc, int fr, int fq) const {
        const int row0 = u.pm * BM + wr * 64 + fr; int colt = u.pn * BM; bf16_t* base = O;
        float sc = 1.f; if (split_cols) { const int t = colt / split_cols; base += (size_t)t * split_stride; colt -= t * split_cols; if (t == 0) sc = scale0; }
        const int col0 = colt + wc * 32 + 8 * fq, bcol0 = u.pn * BM + wc * 32 + 8 * fq;
        f32x4 bv[2][2];
#pragma unroll
        for (int bj = 0; bj < 2; ++bj)
#pragma unroll
            for (int n = 0; n < 2; ++n) bv[bj][n] = bias ? *(const f32x4*)(bias + bcol0 + bj * HALF + 4 * n) : (f32x4){0.f, 0.f, 0.f, 0.f};
#pragma unroll
        for (int ai = 0; ai < 2; ++ai)
#pragma unroll
            for (int m = 0; m < 4; ++m) { bf16_t* rowp = base + (size_t)(row0 + ai * HALF + m * 16) * ldc + col0;
#pragma unroll
                for (int bj = 0; bj < 2; ++bj) { f32x4 v0 = acc[ai][bj][m][0] + bv[bj][0], v1 = acc[ai][bj][m][1] + bv[bj][1];
                    if (ACT == 1) { f32x2 a = gelu_pk((f32x2){v0[0], v0[1]}), b = gelu_pk((f32x2){v0[2], v0[3]}), c = gelu_pk((f32x2){v1[0], v1[1]}), d = gelu_pk((f32x2){v1[2], v1[3]});
                        v0 = (f32x4){a.x, a.y, b.x, b.y}; v1 = (f32x4){c.x, c.y, d.x, d.y}; }
                    v0 = v0 * sc; v1 = v1 * sc; u32x4 w; w.x = cvt_pk_bf16(v0[0], v0[1]); w.y = cvt_pk_bf16(v0[2], v0[3]); w.z = cvt_pk_bf16(v1[0], v1[1]); w.w = cvt_pk_bf16(v1[2], v1[3]);
                    *(u32x4*)(rowp + bj * HALF) = w; } }
    }
};
template <class Epi, class Sched, bool ALIGN_EPI = false, bool SP2 = false>
__device__ __forceinline__ void gemm_phase(PG8_LAS unsigned char* lds, const Gemm g, const Sched& S, const Epi& E, int tid_in) {
    const int tid = tid_in, wid = __builtin_amdgcn_readfirstlane(tid >> 6), lane = tid & 63, wr = wid >> 2, wc = wid & 3, fr = lane & 15, fq = lane >> 4;
    const int K = g.K, nt = K / BK;
    unsigned voffA[2], voffB[2];
#pragma unroll
    for (int i = 0; i < 2; ++i) { int R, C; stage_rc(tid * 16 + i * 8192, R, C); const int Rb = Epi::PERM ? ((R & ~31) + perm32(R & 31)) : R;
        voffA[i] = (unsigned)(R * BK + C) * 2u; voffB[i] = (unsigned)(Rb * BK + C) * 2u; }
    const size_t kstep = (size_t)(HALF * BK * 2);
    const size_t hstep = (size_t)HALF * K * 2;
    const size_t tstep = 2 * hstep;
    const unsigned ldsw = (unsigned)wid * 1024u;
    const int aoff = lds_byte(wr * 64 + fr, fq * 8), boff = lds_byte(wc * 32 + fr, fq * 8);
#define PG8_SA(b, h) (((b) * 2 + (h)) * HTB)
#define PG8_SB(b, h) ((4 + (b) * 2 + (h)) * HTB)
#define PG8_STAGE(bufoff, gbase, voff) do { _Pragma("unroll") for (int _i = 0; _i < 2; ++_i) \
        __builtin_amdgcn_global_load_lds((const unsigned*)((const char*)(gbase) + (voff)[_i]), (PG8_LAS unsigned*)(lds + (bufoff) + ldsw + _i * 8192), 16, 0, 0); } while (0)
#define PG8_LDA(dst, b, h) do { _Pragma("unroll") for (int m = 0; m < 4; ++m) _Pragma("unroll") for (int k = 0; k < 2; ++k) dst[m][k] = *(const PG8_LAS bf16x8*)(lds + PG8_SA(b, h) + aoff + m * 2048 + k * 1024); } while (0)
#define PG8_LDB(dst, b, h) do { _Pragma("unroll") for (int n = 0; n < 2; ++n) _Pragma("unroll") for (int k = 0; k < 2; ++k) dst[n][k] = *(const PG8_LAS bf16x8*)(lds + PG8_SB(b, h) + boff + n * 2048 + k * 1024); } while (0)
#define PG8_MMA(ai, bj, At, Bt) do { __builtin_amdgcn_s_setprio(1); _Pragma("unroll") for (int m = 0; m < 4; ++m) _Pragma("unroll") for (int n = 0; n < 2; ++n) _Pragma("unroll") for (int k = 0; k < 2; ++k) \
        acc[ai][bj][m][n] = __builtin_amdgcn_mfma_f32_16x16x32_bf16(Bt[n][k], At[m][k], acc[ai][bj][m][n], 0, 0, 0); __builtin_amdgcn_s_setprio(0); } while (0)
#define PG8_WAIT_V(n) asm volatile("s_waitcnt vmcnt(" #n ")" ::: "memory")
#define PG8_WAIT_L(n) asm volatile("s_waitcnt lgkmcnt(" #n ")" ::: "memory")
#define PG8_BAR __builtin_amdgcn_s_barrier()
#define PG8_SCHED __builtin_amdgcn_sched_barrier(0)
    Unit cur, nxt; int ui = 0;
    if (!S.next(0, cur)) return;
    f32x4 acc[2][2][4][2];
#pragma unroll
    for (int a = 0; a < 2; ++a)
#pragma unroll
        for (int b = 0; b < 2; ++b)
#pragma unroll
            for (int m = 0; m < 4; ++m)
#pragma unroll
                for (int n = 0; n < 2; ++n) acc[a][b][m][n] = (f32x4){0.f, 0.f, 0.f, 0.f};
    bf16x8 At[4][2], B0[2][2], B1[2][2];
    const char* cA = (const char*)g.A + (size_t)cur.pm * tstep; const char* cB = (const char*)g.Bt + (size_t)cur.pn * tstep;
    S.a_ready(cur);
    if constexpr (SP2) {
        PG8_STAGE(PG8_SB(0, 0), cB, voffB); PG8_STAGE(PG8_SB(0, 1), cB + hstep, voffB); PG8_STAGE(PG8_SA(0, 0), cA, voffA); PG8_STAGE(PG8_SA(0, 1), cA + hstep, voffA);
        if (wr == 1) PG8_BAR;
        PG8_WAIT_V(2); PG8_BAR;
        PG8_STAGE(PG8_SB(1, 0), cB + kstep, voffB); PG8_STAGE(PG8_SA(1, 0), cA + kstep, voffA); PG8_STAGE(PG8_SB(1, 1), cB + hstep + kstep, voffB);
        PG8_WAIT_V(6); PG8_BAR;
    } else {
        PG8_STAGE(PG8_SB(0, 0), cB, voffB); PG8_STAGE(PG8_SA(0, 0), cA, voffA); PG8_STAGE(PG8_SB(0, 1), cB + hstep, voffB); PG8_STAGE(PG8_SA(0, 1), cA + hstep, voffA);
        if (wr == 1) PG8_BAR;
        PG8_WAIT_V(4); PG8_BAR;
        PG8_STAGE(PG8_SB(1, 0), cB + kstep, voffB); PG8_STAGE(PG8_SA(1, 0), cA + kstep, voffA); PG8_STAGE(PG8_SB(1, 1), cB + hstep + kstep, voffB);
        PG8_WAIT_V(6); PG8_BAR;
    }
    for (;;) {
        const bool has_next = S.next(ui + 1, nxt);
        const char* nA = has_next ? (const char*)g.A + (size_t)nxt.pm * tstep : cA; const char* nB = has_next ? (const char*)g.Bt + (size_t)nxt.pn * tstep : cB;
        for (int t = 0; t < nt; t += 2) {
            const bool last = (t == nt - 2);
            const char* a1 = cA + (size_t)(t + 1) * kstep;
            const char* a2 = last ? nA : cA + (size_t)(t + 2) * kstep; const char* b2 = last ? nB : cB + (size_t)(t + 2) * kstep;
            const char* a3 = a2 + kstep; const char* b3 = b2 + kstep;
            if (last && has_next) S.a_ready(nxt);
            if constexpr (SP2) {
            PG8_LDB(B0, 0, 0); PG8_LDB(B1, 0, 1); PG8_SCHED; PG8_LDA(At, 0, 0); PG8_STAGE(PG8_SA(1, 1), a1 + hstep, voffA);
            PG8_WAIT_V(8); PG8_WAIT_L(0); PG8_BAR; PG8_MMA(0, 0, At, B0); PG8_MMA(0, 1, At, B1); PG8_BAR; PG8_SCHED;
            PG8_LDA(At, 0, 1); PG8_STAGE(PG8_SB(0, 0), b2, voffB); PG8_STAGE(PG8_SB(0, 1), b2 + hstep, voffB); PG8_STAGE(PG8_SA(0, 0), a2, voffA);
            PG8_WAIT_V(8); PG8_WAIT_L(0); PG8_BAR; PG8_MMA(1, 0, At, B0); PG8_MMA(1, 1, At, B1); PG8_BAR; PG8_SCHED;
            PG8_LDB(B0, 1, 0); PG8_LDB(B1, 1, 1); PG8_SCHED; PG8_LDA(At, 1, 0); PG8_STAGE(PG8_SA(0, 1), a2 + hstep, voffA);
            PG8_WAIT_V(8); PG8_WAIT_L(0); PG8_BAR; PG8_MMA(0, 0, At, B0); PG8_MMA(0, 1, At, B1); PG8_BAR; PG8_SCHED;
            PG8_LDA(At, 1, 1); PG8_STAGE(PG8_SB(1, 0), b3, voffB); PG8_STAGE(PG8_SB(1, 1), b3 + hstep, voffB); PG8_STAGE(PG8_SA(1, 0), a3, voffA);
            PG8_WAIT_V(8); PG8_WAIT_L(0); PG8_BAR; PG8_MMA(1, 0, At, B0); PG8_MMA(1, 1, At, B1); PG8_BAR; PG8_SCHED;
            } else {
            PG8_LDB(B0, 0, 0); PG8_SCHED; PG8_LDA(At, 0, 0); PG8_STAGE(PG8_SA(1, 1), a1 + hstep, voffA);
            PG8_WAIT_L(8); PG8_BAR; PG8_WAIT_L(0); PG8_MMA(0, 0, At, B0); PG8_BAR; PG8_SCHED;
            PG8_LDB(B1, 0, 1); PG8_STAGE(PG8_SB(0, 0), b2, voffB);
            PG8_BAR; PG8_WAIT_L(0); PG8_MMA(0, 1, At, B1); PG8_BAR;
            PG8_LDA(At, 0, 1); PG8_STAGE(PG8_SA(0, 0), a2, voffA);
            PG8_BAR; PG8_WAIT_L(0); PG8_MMA(1, 0, At, B0); PG8_BAR; PG8_SCHED;
            PG8_STAGE(PG8_SB(0, 1), b2 + hstep, voffB);
            PG8_WAIT_V(6); PG8_BAR; PG8_MMA(1, 1, At, B1); PG8_BAR;
            PG8_LDB(B0, 1, 0); PG8_SCHED; PG8_LDA(At, 1, 0); PG8_STAGE(PG8_SA(0, 1), a2 + hstep, voffA);
            PG8_WAIT_L(8); PG8_BAR; PG8_WAIT_L(0); PG8_MMA(0, 0, At, B0); PG8_BAR; PG8_SCHED;
            PG8_LDB(B1, 1, 1); PG8_STAGE(PG8_SB(1, 0), b3, voffB);
            PG8_BAR; PG8_WAIT_L(0); PG8_MMA(0, 1, At, B1); PG8_BAR;
            PG8_LDA(At, 1, 1); PG8_STAGE(PG8_SA(1, 0), a3, voffA);
            PG8_BAR; PG8_WAIT_L(0); PG8_MMA(1, 0, At, B0); PG8_BAR; PG8_SCHED;
            PG8_STAGE(PG8_SB(1, 1), b3 + hstep, voffB);
            PG8_WAIT_V(6); PG8_BAR; PG8_MMA(1, 1, At, B1); PG8_BAR;
            }
        }
        if constexpr (ALIGN_EPI) { if (wr == 0) PG8_BAR; }
        if constexpr (!Epi::AFTER_DRAIN) { E(acc, cur, wr, wc, fr, fq); S.done(cur); }
        if (!has_next) break;
#pragma unroll
        for (int a = 0; a < 2; ++a)
#pragma unroll
            for (int b = 0; b < 2; ++b)
#pragma unroll
                for (int m = 0; m < 4; ++m)
#pragma unroll
                    for (int n = 0; n < 2; ++n) acc[a][b][m][n] = (f32x4){0.f, 0.f, 0.f, 0.f};
        cur = nxt; cA = nA; cB = nB; ++ui;
        if constexpr (ALIGN_EPI) { if (wr == 1) PG8_BAR; }
    }
    PG8_WAIT_V(0);
    if constexpr (!ALIGN_EPI) { if (wr == 0) PG8_BAR; }
    PG8_BAR;
    if constexpr (Epi::AFTER_DRAIN) { E.fused(acc, cur, wr, wc, fr, fq, lds, wid, lane); S.done(cur); }
#undef PG8_SA
#undef PG8_SB
#undef PG8_STAGE
#undef PG8_LDA
#undef PG8_LDB
#undef PG8_MMA
#undef PG8_WAIT_V
#undef PG8_WAIT_L
#undef PG8_BAR
#undef PG8_SCHED
}
}
namespace pg8 {
constexpr int TAB_OFF = 131072 + 256, TAB_SLOTS = 6;
__device__ __forceinline__ int tab_slot(PG8_LAS const unsigned char* tab, const Unit& u) { const PG8_LAS int* tags = (const PG8_LAS int*)tab; const int tag = (u.pm << 8) | u.pn; int slot = 0;
#pragma unroll
    for (int i = 1; i < TAB_SLOTS; ++i) if (tags[i] == tag) slot = i;
    return slot; }
constexpr int NBIAS = 28672;
typedef unsigned u32x2 __attribute__((ext_vector_type(2)));
__device__ __forceinline__ float silu_f(float x) { return x * __builtin_amdgcn_rcpf(1.0f + __builtin_amdgcn_exp2f(-1.4426950408889634f * x)); }
__device__ __forceinline__ void row_rstd8(const float* ssq, int row0, int fq, float (&rstd)[2][4]) {
    f32x4 p[2][4][2];
#pragma unroll
    for (int ai = 0; ai < 2; ++ai)
#pragma unroll
        for (int m = 0; m < 4; ++m) { const float* q = ssq + (size_t)(row0 + ai * HALF + m * 16) * 32 + fq * 8; p[ai][m][0] = *(const f32x4*)q; p[ai][m][1] = *(const f32x4*)(q + 4); }
#pragma unroll
    for (int ai = 0; ai < 2; ++ai)
#pragma unroll
        for (int m = 0; m < 4; ++m) { float t = ((p[ai][m][0][0] + p[ai][m][0][1]) + (p[ai][m][0][2] + p[ai][m][0][3])) + ((p[ai][m][1][0] + p[ai][m][1][1]) + (p[ai][m][1][2] + p[ai][m][1][3]));
            t += __shfl_xor(t, 16); t += __shfl_xor(t, 32); rstd[ai][m] = 1.0f / sqrtf(t * (1.0f / 2048.0f) + 1e-6f); }
}
struct EpiGeluStats {
    static constexpr bool PERM = true, AFTER_DRAIN = false;
    bf16_t* O; int ldc; PG8_LAS const unsigned char* tab; float* stats;
    __device__ __forceinline__ void operator()(const f32x4 (&acc)[2][2][4][2], const Unit& u, int wr, int wc, int fr, int fq) const {
        const int row0 = u.pm * BM + wr * 64 + fr; const int col0 = u.pn * BM + wc * 32 + 8 * fq;
        const PG8_LAS float* bT = (const PG8_LAS float*)(tab + 64 + TAB_SLOTS * 1024) + tab_slot(tab, u) * 256;
        f32x4 bv[2][2];
#pragma unroll
        for (int bj = 0; bj < 2; ++bj)
#pragma unroll
            for (int n = 0; n < 2; ++n) bv[bj][n] = *(const PG8_LAS f32x4*)(bT + bj * HALF + wc * 32 + 8 * fq + 4 * n);
#pragma unroll
        for (int ai = 0; ai < 2; ++ai)
#pragma unroll
            for (int m = 0; m < 4; ++m) { const int row = row0 + ai * HALF + m * 16; bf16_t* rowp = O + (size_t)row * ldc + col0; float s1 = 0.f, s2 = 0.f;
#pragma unroll
                for (int bj = 0; bj < 2; ++bj) { f32x4 v0 = acc[ai][bj][m][0] + bv[bj][0], v1 = acc[ai][bj][m][1] + bv[bj][1];
                    f32x2 a = gelu_pk((f32x2){v0[0], v0[1]}), b = gelu_pk((f32x2){v0[2], v0[3]}), c = gelu_pk((f32x2){v1[0], v1[1]}), d = gelu_pk((f32x2){v1[2], v1[3]});
                    s1 += ((a.x + a.y) + (b.x + b.y)) + ((c.x + c.y) + (d.x + d.y));
                    s2 += ((a.x * a.x + a.y * a.y) + (b.x * b.x + b.y * b.y)) + ((c.x * c.x + c.y * c.y) + (d.x * d.x + d.y * d.y));
                    u32x4 w; w.x = cvt_pk_bf16(a.x, a.y); w.y = cvt_pk_bf16(b.x, b.y); w.z = cvt_pk_bf16(c.x, c.y); w.w = cvt_pk_bf16(d.x, d.y);
                    *(u32x4*)(rowp + bj * HALF) = w; }
                if (u.pn >= 8) { s1 += __shfl_xor(s1, 16); s1 += __shfl_xor(s1, 32); s2 += __shfl_xor(s2, 16); s2 += __shfl_xor(s2, 32);
                    if (fq == 0) *(f32x2*)(stats + ((size_t)row * 32 + (u.pn - 8) * 4 + wc) * 2) = (f32x2){s1, s2}; } }
    }
};
struct EpiSwiGLU {
    static constexpr bool PERM = true, AFTER_DRAIN = false;
    bf16_t* O; int ldc; PG8_LAS const unsigned char* tab;
    __device__ __forceinline__ void operator()(const f32x4 (&acc)[2][2][4][2], const Unit& u, int wr, int wc, int fr, int fq) const {
        const int row0 = u.pm * BM + wr * 64 + fr; const int col0 = u.pn * HALF + wc * 32 + 8 * fq;
        const int slot = tab_slot(tab, u);
        const PG8_LAS float* rT = (const PG8_LAS float*)(tab + 64) + slot * 256; const PG8_LAS float* bT = (const PG8_LAS float*)(tab + 64 + TAB_SLOTS * 1024) + slot * 256;
        float rstd[2][4];
#pragma unroll
        for (int ai = 0; ai < 2; ++ai)
#pragma unroll
            for (int m = 0; m < 4; ++m) rstd[ai][m] = rT[ai * HALF + wr * 64 + m * 16 + fr];
        f32x4 bv[2][2];
#pragma unroll
        for (int bj = 0; bj < 2; ++bj)
#pragma unroll
            for (int n = 0; n < 2; ++n) bv[bj][n] = *(const PG8_LAS f32x4*)(bT + bj * HALF + wc * 32 + 8 * fq + 4 * n);
#pragma unroll
        for (int ai = 0; ai < 2; ++ai)
#pragma unroll
            for (int m = 0; m < 4; ++m) { bf16_t* rowp = O + tidx(row0 + ai * HALF + m * 16, col0, ldc); const float rs = rstd[ai][m];
                const f32x4 g0 = acc[ai][0][m][0] * rs + bv[0][0], g1 = acc[ai][0][m][1] * rs + bv[0][1], u0 = acc[ai][1][m][0] * rs + bv[1][0], u1 = acc[ai][1][m][1] * rs + bv[1][1];
                u32x4 w; w.x = cvt_pk_bf16(silu_f(g0[0]) * u0[0], silu_f(g0[1]) * u0[1]); w.y = cvt_pk_bf16(silu_f(g0[2]) * u0[2], silu_f(g0[3]) * u0[3]);
                w.z = cvt_pk_bf16(silu_f(g1[0]) * u1[0], silu_f(g1[1]) * u1[1]); w.w = cvt_pk_bf16(silu_f(g1[2]) * u1[2], silu_f(g1[3]) * u1[3]);
                *(u32x4*)rowp = w; }
    }
};
template <bool NTB> struct EpiResNorm {
    static constexpr bool PERM = false, AFTER_DRAIN = false;
    const float* base; float* out; const float* gate; int gate_bstride; int ldc;
    const float* gam1; bf16_t* A1; const float* gam2; bf16_t* A2; float* ssq;
    __device__ __forceinline__ void operator()(f32x4 (&acc)[2][2][4][2], const Unit& u, int wr, int wc, int fr, int fq) const {
        const int row0 = u.pm * BM + wr * 64 + fr; const int col0 = u.pn * BM + wc * 32 + 4 * fq; const int b = u.pm >> 4;
        f32x4 gv[2][2], g1[2][2];
#pragma unroll
        for (int bj = 0; bj < 2; ++bj)
#pragma unroll
            for (int n = 0; n < 2; ++n) { gv[bj][n] = *(const f32x4*)(gate + (size_t)b * gate_bstride + col0 + bj * HALF + n * 16);
                g1[bj][n] = gam1 ? *(const f32x4*)(gam1 + (size_t)b * 2048 + col0 + bj * HALF + n * 16) : (f32x4){0.f, 0.f, 0.f, 0.f}; }
#pragma unroll
        for (int ai = 0; ai < 2; ++ai)
#pragma unroll
            for (int mh = 0; mh < 2; ++mh) { f32x4 t[2][2][2];
#pragma unroll
                for (int mm = 0; mm < 2; ++mm) { const size_t off = (size_t)(row0 + ai * HALF + (2 * mh + mm) * 16) * ldc + col0;
#pragma unroll
                    for (int bj = 0; bj < 2; ++bj)
#pragma unroll
                        for (int n = 0; n < 2; ++n) { if constexpr (NTB) t[mm][bj][n] = __builtin_nontemporal_load((const f32x4*)(base + off + bj * HALF + n * 16)); else t[mm][bj][n] = *(const f32x4*)(base + off + bj * HALF + n * 16); } }
#pragma unroll
                for (int mm = 0; mm < 2; ++mm) { const int m = 2 * mh + mm; const int row = row0 + ai * HALF + m * 16; const size_t off = (size_t)row * ldc + col0;
#pragma unroll
                    for (int bj = 0; bj < 2; ++bj)
#pragma unroll
                        for (int n = 0; n < 2; ++n) { acc[ai][bj][m][n] = t[mm][bj][n] + acc[ai][bj][m][n] * gv[bj][n]; *(f32x4*)(out + off + bj * HALF + n * 16) = acc[ai][bj][m][n]; }
                    if (gam1) { float ss = 0.f;
#pragma unroll
                        for (int bj = 0; bj < 2; ++bj)
#pragma unroll
                            for (int n = 0; n < 2; ++n) { const f32x4 x = acc[ai][bj][m][n]; ss += (x[0] * x[0] + x[1] * x[1]) + (x[2] * x[2] + x[3] * x[3]);
                                const f32x4 y = x * g1[bj][n]; u32x2 w; w.x = cvt_pk_bf16(y[0], y[1]); w.y = cvt_pk_bf16(y[2], y[3]); *(u32x2*)(A1 + tidx(row, col0 + bj * HALF + n * 16, 2048)) = w; }
                        ss += __shfl_xor(ss, 16); ss += __shfl_xor(ss, 32);
                        if (fq == 0) ssq[(size_t)row * 32 + u.pn * 4 + wc] = ss; } } }
        if (gam2) {
#pragma unroll
            for (int bj = 0; bj < 2; ++bj)
#pragma unroll
                for (int n = 0; n < 2; ++n) g1[bj][n] = *(const f32x4*)(gam2 + (size_t)b * 2048 + col0 + bj * HALF + n * 16);
#pragma unroll
            for (int ai = 0; ai < 2; ++ai)
#pragma unroll
                for (int m = 0; m < 4; ++m) { const int row = row0 + ai * HALF + m * 16;
#pragma unroll
                    for (int bj = 0; bj < 2; ++bj)
#pragma unroll
                        for (int n = 0; n < 2; ++n) { const f32x4 y = acc[ai][bj][m][n] * g1[bj][n]; u32x2 w; w.x = cvt_pk_bf16(y[0], y[1]); w.y = cvt_pk_bf16(y[2], y[3]); *(u32x2*)(A2 + tidx(row, col0 + bj * HALF + n * 16, 2048)) = w; } } }
    }
};
struct EpiQKRope {
    static constexpr bool PERM = false, AFTER_DRAIN = true;
    bf16_t* O; const float* g; const float* rt; const float* ssq; const float* bias;
    __device__ __forceinline__ void fused(f32x4 (&acc)[2][2][4][2], const Unit& u, int wr, int wc, int fr, int fq, PG8_LAS unsigned char* lds, int wid, int lane) const {
        PG8_LAS float* P = (PG8_LAS float*)lds;
        { float rstd[2][4]; row_rstd8(ssq, u.pm * BM + wr * 64 + fr, fq, rstd);
#pragma unroll
          for (int bj = 0; bj < 2; ++bj)
#pragma unroll
            for (int n = 0; n < 2; ++n) { const f32x4 bv = *(const f32x4*)(bias + (size_t)(u.pm >> 4) * NBIAS + u.pn * BM + bj * HALF + wc * 32 + 16 * n + 4 * fq);
#pragma unroll
                for (int ai = 0; ai < 2; ++ai)
#pragma unroll
                    for (int m = 0; m < 4; ++m) acc[ai][bj][m][n] = acc[ai][bj][m][n] * rstd[ai][m] + bv; } }
#pragma unroll
        for (int ai = 0; ai < 2; ++ai)
#pragma unroll
            for (int m = 0; m < 4; ++m)
#pragma unroll
                for (int bj = 0; bj < 2; ++bj) { const f32x4 a = acc[ai][bj][m][0], c = acc[ai][bj][m][1];
                    float ss = ((a[0] * a[0] + a[1] * a[1]) + (a[2] * a[2] + a[3] * a[3])) + ((c[0] * c[0] + c[1] * c[1]) + (c[2] * c[2] + c[3] * c[3]));
                    ss += __shfl_xor(ss, 16); ss += __shfl_xor(ss, 32);
                    if (fq == 0) P[((ai * HALF + wr * 64 + m * 16 + fr) * 2 + bj) * 4 + wc] = ss; }
        asm volatile("s_waitcnt lgkmcnt(0)" ::: "memory"); __builtin_amdgcn_s_barrier(); asm volatile("" ::: "memory");
        const int d = 16 * wc + 4 * fq; const f32x4 ga = *(const f32x4*)(g + d), gb = *(const f32x4*)(g + 64 + d);
#pragma unroll
        for (int ai = 0; ai < 2; ++ai)
#pragma unroll
            for (int m = 0; m < 4; ++m) { const int rl = ai * HALF + wr * 64 + m * 16 + fr, row = u.pm * BM + rl, b = row >> 12, s = row & 4095;
                const f32x4 cs0 = *(const f32x4*)(rt + ((size_t)row * 64 + d) * 2), cs1 = *(const f32x4*)(rt + ((size_t)row * 64 + d) * 2 + 4);
                const float co[4] = {cs0[0], cs0[2], cs1[0], cs1[2]}, si[4] = {cs0[1], cs0[3], cs1[1], cs1[3]};
#pragma unroll
                for (int bj = 0; bj < 2; ++bj) { const f32x4 pp = *(const PG8_LAS f32x4*)(P + (rl * 2 + bj) * 4);
                    const float rstd = 1.0f / sqrtf(((pp[0] + pp[1]) + (pp[2] + pp[3])) * (1.0f / 128.0f) + 1e-6f);
                    const f32x4 x1 = acc[ai][bj][m][0] * rstd * ga, x2 = acc[ai][bj][m][1] * rstd * gb; float o1[4], o2[4];
#pragma unroll
                    for (int i = 0; i < 4; ++i) { o1[i] = x1[i] * co[i] - x2[i] * si[i]; o2[i] = x2[i] * co[i] + x1[i] * si[i]; }
                    bf16_t* op = O + ((size_t)(b * 16 + 2 * u.pn + bj) * 4096 + s) * 128 + d;
                    u32x2 w1, w2; w1.x = cvt_pk_bf16(o1[0], o1[1]); w1.y = cvt_pk_bf16(o1[2], o1[3]); w2.x = cvt_pk_bf16(o2[0], o2[1]); w2.y = cvt_pk_bf16(o2[2], o2[3]);
                    *(u32x2*)op = w1; *(u32x2*)(op + 64) = w2; } }
        asm volatile("s_waitcnt lgkmcnt(0)" ::: "memory"); __builtin_amdgcn_s_barrier(); asm volatile("" ::: "memory");
    }
};
struct EpiVhead {
    static constexpr bool PERM = true, AFTER_DRAIN = false;
    bf16_t* O; const float* ssq; const float* bias;
    __device__ __forceinline__ void operator()(const f32x4 (&acc)[2][2][4][2], const Unit& u, int wr, int wc, int fr, int fq) const {
        const int row0 = u.pm * BM + wr * 64 + fr;
        float rstd[2][4]; row_rstd8(ssq, row0, fq, rstd);
        f32x4 bv[2][2];
#pragma unroll
        for (int bj = 0; bj < 2; ++bj)
#pragma unroll
            for (int n = 0; n < 2; ++n) bv[bj][n] = *(const f32x4*)(bias + (size_t)(u.pm >> 4) * NBIAS + u.pn * BM + bj * HALF + wc * 32 + 8 * fq + 4 * n);
#pragma unroll
        for (int ai = 0; ai < 2; ++ai)
#pragma unroll
            for (int m = 0; m < 4; ++m) { const int row = row0 + ai * HALF + m * 16, b = row >> 12, s = row & 4095; const float rs = rstd[ai][m];
#pragma unroll
                for (int bj = 0; bj < 2; ++bj) { bf16_t* p = O + ((size_t)(b * 16 + 2 * u.pn + bj) * 4096 + s) * 128 + wc * 32 + 8 * fq;
                    const f32x4 v0 = acc[ai][bj][m][0] * rs + bv[bj][0], v1 = acc[ai][bj][m][1] * rs + bv[bj][1];
                    u32x4 w; w.x = cvt_pk_bf16(v0[0], v0[1]); w.y = cvt_pk_bf16(v0[2], v0[3]); w.z = cvt_pk_bf16(v1[0], v1[1]); w.w = cvt_pk_bf16(v1[2], v1[3]);
                    *(u32x4*)p = w; } }
    }
};
}
namespace att {
constexpr int D = 128; constexpr float THR = 8.f; constexpr bool WSKIP = false;
constexpr float SCALE = 0.08838834764831845f;
constexpr int NW = 8, QBLK = 32, KVBLK = 64, QB = NW * QBLK;
constexpr int SHM_V = KVBLK * D * 2, SHM_K = KVBLK * D * 2;
constexpr int LDS_BYTES = 2 * SHM_V + 2 * SHM_K + NW * 64 * 4;
using bf16 = __hip_bfloat16;
typedef short bf16x8 __attribute__((ext_vector_type(8)));
typedef short s16x4 __attribute__((ext_vector_type(4)));
typedef float f32x16 __attribute__((ext_vector_type(16)));
typedef float f32x4 __attribute__((ext_vector_type(4)));
typedef unsigned u32x4 __attribute__((ext_vector_type(4)));
template <class A, class Bt> struct same_t { static constexpr bool v = false; };
template <class A> struct same_t<A, A> { static constexpr bool v = true; };

#define KSWZ(row, colB) ((row) * 256 + ((colB) ^ (((row) & 7) << 4)))
#define SBAR() __builtin_amdgcn_sched_barrier(0)
__device__ __forceinline__ int v_st(int k, int c) { const int kk = (k & ~0xC) | ((k & 4) << 1) | ((k & 8) >> 1); return ((kk >> 3) * 4 + (c >> 5)) * 512 + ((kk & 7) * 32 + (c & 31)) * 2; }
__device__ __forceinline__ int v_rd_base(int lane) { return ((lane & 3) << 3) | (((lane >> 2) & 3) << 6) | (((lane >> 4) & 1) << 5) | (((lane >> 5) & 1) << 8); }
constexpr int v_rd_off(int d0, int ks, int half) { return d0 * 512 + ks * 4096 + half * 2048; }
__device__ __forceinline__ int crow(int r, int hi) { return (r & 3) + 8 * (r >> 2) + 4 * hi; }
__device__ __forceinline__ unsigned cvtpk(float lo, float hi) {
    unsigned r; asm volatile("v_cvt_pk_bf16_f32 %0, %1, %2" : "=v"(r) : "v"(lo), "v"(hi)); return r;
}
__device__ __forceinline__ bf16x8 pack8(f32x4 a, f32x4 b) {
    u32x4 w = {cvtpk(a[0], a[1]), cvtpk(a[2], a[3]), cvtpk(b[0], b[1]), cvtpk(b[2], b[3])};
    return *reinterpret_cast<bf16x8*>(&w);
}
template <class T> __device__ __forceinline__ bf16x8 load8(const T* p) {
    if constexpr (same_t<T, float>::v) { return pack8(*(const f32x4*)p, *(const f32x4*)(p + 4)); }
    else { return *reinterpret_cast<const bf16x8*>(p); }
}
__device__ __forceinline__ void mask_tile(f32x16& p0, f32x16& p1, int dq, unsigned W) {
    const float NEG = -__builtin_inff();
#pragma unroll
    for (int r = 0; r < 16; ++r) {
        const int c = (r & 3) + 8 * (r >> 2);
        if ((unsigned)(dq - c) >= W) p0[r] = NEG;
        if ((unsigned)(dq - c - 32) >= W) p1[r] = NEG;
    }
}
__device__ __forceinline__ void partialSM(f32x16& p0, f32x16& p1, float& m_reg, float& mn, float& alpha) {
    float pmax = p0[0]; for (int r = 1; r < 16; ++r) pmax = fmaxf(pmax, p0[r]); for (int r = 0; r < 16; ++r) pmax = fmaxf(pmax, p1[r]);
    { auto rr = __builtin_amdgcn_permlane32_swap(__float_as_uint(pmax), __float_as_uint(pmax), false, false);
      pmax = fmaxf(__uint_as_float(rr[0]), __uint_as_float(rr[1])); }
    constexpr float C2 = 1.4426950408889634f * SCALE;
    if (__builtin_expect(__all((pmax - m_reg) * SCALE <= THR), 1)) { mn = m_reg; alpha = 1.f; }
    else { mn = fmaxf(m_reg, pmax); alpha = __builtin_amdgcn_exp2f((m_reg - mn) * C2); m_reg = mn; }
    const float mnL = -mn * C2;
    for (int r = 0; r < 16; ++r) p0[r] = fmaf(p0[r], C2, mnL); for (int r = 0; r < 16; ++r) p1[r] = fmaf(p1[r], C2, mnL);
    for (int r = 0; r < 16; ++r) p0[r] = __builtin_amdgcn_exp2f(p0[r]);
}
__device__ __forceinline__ void finishSM(f32x16& p0, f32x16& p1, float alpha, float& l_reg, bf16x8& pa0, bf16x8& pa1, bf16x8& pa2, bf16x8& pa3) {
    for (int r = 0; r < 16; ++r) p1[r] = __builtin_amdgcn_exp2f(p1[r]);
    float ps = 0; for (int r = 0; r < 16; ++r) ps += p0[r]; for (int r = 0; r < 16; ++r) ps += p1[r];
    { auto rr = __builtin_amdgcn_permlane32_swap(__float_as_uint(ps), __float_as_uint(ps), false, false);
      ps = __uint_as_float(rr[0]) + __uint_as_float(rr[1]); }
    l_reg = l_reg * alpha + ps;
#define PK4(P, B_, OUT) do { unsigned a0 = cvtpk(P[B_+0], P[B_+1]), a1 = cvtpk(P[B_+2], P[B_+3]);                          \
        unsigned b0 = cvtpk(P[B_+4], P[B_+5]), b1 = cvtpk(P[B_+6], P[B_+7]);                                             \
        auto r0 = __builtin_amdgcn_permlane32_swap(a0, b0, false, false); auto r1 = __builtin_amdgcn_permlane32_swap(a1, b1, false, false); \
        u32x4 w = {r0[0], r1[0], r0[1], r1[1]}; OUT = *reinterpret_cast<bf16x8*>(&w); } while (0)
    PK4(p0, 0, pa0); PK4(p0, 8, pa1); PK4(p1, 0, pa2); PK4(p1, 8, pa3);
#undef PK4
}
template <int KB, bool SK>
__device__ __forceinline__ void qkt(f32x16& p0, f32x16& p1, const char* K_lds, int r32, int hi, const bf16x8* qr, bool act) {
    if (SK && !act) { const float NEG = -__builtin_inff();
#pragma unroll
        for (int r = 0; r < 16; ++r) { p0[r] = NEG; p1[r] = NEG; } return; }
    p0 = f32x16{}; p1 = f32x16{};
    const char* kb[4];
#pragma unroll
    for (int dd = 0; dd < 4; ++dd) kb[dd] = K_lds + KB * SHM_K + KSWZ(r32, (dd * 16 + hi * 8) * 2);
#pragma unroll
    for (int d0 = 0; d0 < 8; ++d0) { const char* a = kb[d0 & 3] + (d0 >> 2) * 128;
        bf16x8 b0 = *reinterpret_cast<const bf16x8*>(a);
        bf16x8 b1 = *reinterpret_cast<const bf16x8*>(a + 32 * 256);
        p0 = __builtin_amdgcn_mfma_f32_32x32x16_bf16(b0, qr[d0], p0, 0, 0, 0);
        p1 = __builtin_amdgcn_mfma_f32_32x32x16_bf16(b1, qr[d0], p1, 0, 0, 0); }
}
template <int VB, bool SK>
__device__ __forceinline__ void pv_tile(f32x16* o, int vb0, bf16x8 pa0, bf16x8 pa1, bf16x8 pa2, bf16x8 pa3, bool act) {
    if (SK && !act) return;
#define TRRD(dst, off) asm volatile("ds_read_b64_tr_b16 %0, %1 offset:%2" : "=&v"(dst) : "v"(vb0), "i"(off) : "memory")
#define PV_D0(d0) do { s16x4 l0, l1, l2, l3, h0, h1, h2, h3; constexpr int b_ = VB * SHM_V + v_rd_off(d0, 0, 0);     \
        TRRD(l0, b_); TRRD(h0, b_ + 2048); TRRD(l1, b_ + 4096); TRRD(h1, b_ + 6144); TRRD(l2, b_ + 8192); TRRD(h2, b_ + 10240); TRRD(l3, b_ + 12288); TRRD(h3, b_ + 14336); \
        asm volatile("s_waitcnt lgkmcnt(0)" ::: "memory"); SBAR();                 \
        o[d0] = __builtin_amdgcn_mfma_f32_32x32x16_bf16(pa0, (bf16x8){l0[0], l0[1], l0[2], l0[3], h0[0], h0[1], h0[2], h0[3]}, o[d0], 0, 0, 0);   \
        o[d0] = __builtin_amdgcn_mfma_f32_32x32x16_bf16(pa1, (bf16x8){l1[0], l1[1], l1[2], l1[3], h1[0], h1[1], h1[2], h1[3]}, o[d0], 0, 0, 0);   \
        o[d0] = __builtin_amdgcn_mfma_f32_32x32x16_bf16(pa2, (bf16x8){l2[0], l2[1], l2[2], l2[3], h2[0], h2[1], h2[2], h2[3]}, o[d0], 0, 0, 0);   \
        o[d0] = __builtin_amdgcn_mfma_f32_32x32x16_bf16(pa3, (bf16x8){l3[0], l3[1], l3[2], l3[3], h3[0], h3[1], h3[2], h3[3]}, o[d0], 0, 0, 0); } while (0)
    PV_D0(0); PV_D0(1); PV_D0(2); PV_D0(3);
#undef PV_D0
#undef TRRD
}

template <class TIn, class TOut> struct BlockRef { const TIn* Q; const TIn* K; const TIn* V; TOut* O; int P0; };
template <class TIn> struct Seam {
    bf16x8 qr[8];
    bf16x8 st_v0, st_v1, st_k0, st_k1; f32x4 sf0, sf1, sf2, sf3;
    f32x4 tq[16];
};
__device__ __forceinline__ int swa_jlo(int P0, int W) { const int lowk = P0 - W + 1; return lowk > 0 ? lowk / KVBLK : 0; }
#define ROW(p, k0, rr) ((p) + (size_t)((k0) + (rr)) * D + sc)
#define VMW() asm volatile("s_waitcnt vmcnt(0)" ::: "memory")
#define VMWN(n) asm volatile("s_waitcnt vmcnt(%0)" :: "i"(n) : "memory")
#define SLOAD_H(Kp, Vp, k0) do { S.st_v0 = load8<TIn>(ROW(Vp, k0, sr)); S.st_v1 = load8<TIn>(ROW(Vp, k0, 32 + sr));              \
                         S.st_k0 = load8<TIn>(ROW(Kp, k0, sr)); S.st_k1 = load8<TIn>(ROW(Kp, k0, 32 + sr)); } while (0)
#define SWRITE_HK(bf) do { *(bf16x8*)(K_lds + (bf) * SHM_K + kws) = S.st_k0; *(bf16x8*)(K_lds + (bf) * SHM_K + kws + 32 * 256) = S.st_k1; } while (0)
#define SWRITE_HV(bf) do { *(bf16x8*)(V_lds + (bf) * SHM_V + vst0) = S.st_v0; *(bf16x8*)(V_lds + (bf) * SHM_V + vst1) = S.st_v1; } while (0)
#define SWRITE_H(bf) do { SWRITE_HV(bf); SWRITE_HK(bf); } while (0)
#define SLOAD_F(p, k0) do { S.sf0 = *(const f32x4*)ROW(p, k0, sr); S.sf1 = *(const f32x4*)(ROW(p, k0, sr) + 4);                \
                            S.sf2 = *(const f32x4*)ROW(p, k0, 32 + sr); S.sf3 = *(const f32x4*)(ROW(p, k0, 32 + sr) + 4); } while (0)
#define SWRITE_KF(bf) do { *(bf16x8*)(K_lds + (bf) * SHM_K + kws) = pack8(S.sf0, S.sf1); *(bf16x8*)(K_lds + (bf) * SHM_K + kws + 32 * 256) = pack8(S.sf2, S.sf3); } while (0)
#define SWRITE_VF(bf) do { *(bf16x8*)(V_lds + (bf) * SHM_V + vst0) = pack8(S.sf0, S.sf1); *(bf16x8*)(V_lds + (bf) * SHM_V + vst1) = pack8(S.sf2, S.sf3); } while (0)
template <class TIn, class TOut>
__device__ __forceinline__ void causal_swa_prime(const BlockRef<TIn, TOut>& cur, int W, char* lds, Seam<TIn>& S, int tid_in) {
    constexpr bool F32 = same_t<TIn, float>::v;
    const int tid = tid_in, wid = __builtin_amdgcn_readfirstlane(tid >> 6), lane = tid & 63, r32 = lane & 31, hi = lane >> 5;
    const int sr = tid >> 4, sc = (tid & 15) * 8, kws = KSWZ(sr, sc * 2); char* K_lds = lds + 2 * SHM_V;
    const int kb0 = swa_jlo(cur.P0, W) * KVBLK;
    for (int d0 = 0; d0 < 8; ++d0) S.qr[d0] = load8<TIn>(cur.Q + (size_t)(wid * QBLK + r32) * D + d0 * 16 + hi * 8);
    if constexpr (F32) { SLOAD_F((const float*)cur.K, kb0); VMW(); SWRITE_KF(0); SBAR(); SLOAD_F((const float*)cur.V, kb0); }
    else { SLOAD_H(cur.K, cur.V, kb0); VMW(); SWRITE_HK(0); }
    __syncthreads();
}
template <class TIn, class TOut>
__device__ __forceinline__ void causal_swa_block(const BlockRef<TIn, TOut>& cur, const BlockRef<TIn, TOut>& nxt, int skv, int W, char* lds, Seam<TIn>& S, int tid_in) {
    constexpr bool F32 = same_t<TIn, float>::v;
    const int tid = tid_in, wid = __builtin_amdgcn_readfirstlane(tid >> 6), lane = tid & 63, r32 = lane & 31, hi = lane >> 5;
    const int j_lo = swa_jlo(cur.P0, W);
    int j_hi = (cur.P0 + QB - 1) / KVBLK + 1; if (j_hi > skv / KVBLK) j_hi = skv / KVBLK;
    const int NT = j_hi - j_lo;
    const int kbn = swa_jlo(nxt.P0, W) * KVBLK;
    const int qlo = cur.P0 + wid * QBLK, qm = qlo + r32 - 4 * hi;
    char* V_lds = lds; char* K_lds = lds + 2 * SHM_V;
    float* ws = (float*)(lds + 2 * SHM_V + 2 * SHM_K) + wid * 64; float* li_l = ws, * al_l = ws + 32;
    float m_reg = -1e30f, l_reg = 0; f32x16 o[4] = {};
    const int sr = tid >> 4, sc = (tid & 15) * 8, vst0 = v_st(sr, sc), vst1 = v_st(32 + sr, sc), kws = KSWZ(sr, sc * 2);
    const int vb0 = (int)(uintptr_t)V_lds + v_rd_base(lane);
    const TIn* Kh = cur.K; const TIn* Vh = cur.V;
#define RESC(a) do { if (__any((a) < 1.f)) { if (hi == 0) al_l[r32] = (a); asm volatile("s_waitcnt lgkmcnt(0)" ::: "memory");              \
                     for (int d_ = 0; d_ < 4; ++d_) for (int r = 0; r < 16; ++r) o[d_][r] *= al_l[crow(r, hi)]; } } while (0)
#define KBASE(t) ((j_lo + (t)) * KVBLK)
#define ACT(t) (KBASE(t) <= qlo + QBLK - 1 && KBASE(t) + KVBLK - 1 >= qlo - W + 1)
#define MASKT(P0_, P1_, t) do { const int kb_ = KBASE(t); if ((!SK || ACT(t)) && (kb_ + KVBLK - 1 > qlo || kb_ <= qlo + QBLK - 1 - W)) mask_tile(P0_, P1_, qm - kb_, (unsigned)W); } while (0)
    constexpr int NQL = F32 ? 16 : 8;
    constexpr bool SK = WSKIP && !F32;
#define SEAM_K0() do { VMWN(NQL); if constexpr (F32) { SWRITE_KF(0); SBAR(); SLOAD_F((const float*)nxt.V, kbn); } else { SWRITE_HK(0); } SBAR(); } while (0)
    f32x16 pA0, pA1, pB0, pB1; float mnA, mnB, alA, alB; bf16x8 pa0, pa1, pa2, pa3;
    if constexpr (F32) { VMW(); SWRITE_VF(0); SBAR(); } else { SWRITE_HV(0); SBAR(); }
    if (NT > 1) { if constexpr (F32) SLOAD_F((const float*)Kh, KBASE(1)); else SLOAD_H(Kh, Vh, KBASE(1)); }
    SBAR(); qkt<0, SK>(pA0, pA1, K_lds, r32, hi, S.qr, ACT(0));
    if constexpr (F32) { if (NT > 1) { VMW(); SWRITE_KF(1); SBAR(); SLOAD_F((const float*)Vh, KBASE(1)); } }
    MASKT(pA0, pA1, 0); partialSM(pA0, pA1, m_reg, mnA, alA);
    if (NT > 1) { VMW(); if constexpr (F32) { SWRITE_VF(1); SBAR(); if (NT > 2) SLOAD_F((const float*)Kh, KBASE(2)); } else SWRITE_H(1); }
    __syncthreads();
#define HALF_STEP(PX0, PX1, mnX, alX, PY0, PY1, alY, t, KB, VB, SB) do {                                                      \
        SBAR(); qkt<KB, SK>(PX0, PX1, K_lds, r32, hi, S.qr, ACT(t));                                             \
        finishSM(PY0, PY1, alY, l_reg, pa0, pa1, pa2, pa3); SBAR();                                                           \
        if ((t) + 1 < NT) { if constexpr (F32) { VMW(); SWRITE_KF(SB); SBAR(); SLOAD_F((const float*)Vh, KBASE((t) + 1)); }  \
                            else { SLOAD_H(Kh, Vh, KBASE((t) + 1)); } SBAR(); }                                               \
        pv_tile<VB, SK>(o, vb0, pa0, pa1, pa2, pa3, ACT((t) - 1)); MASKT(PX0, PX1, (t)); partialSM(PX0, PX1, m_reg, mnX, alX);                                        \
        __syncthreads();                                                                                                      \
        if ((t) + 1 < NT) { VMW(); if constexpr (F32) { SWRITE_VF(SB); SBAR(); if ((t) + 2 < NT) SLOAD_F((const float*)Kh, KBASE((t) + 2)); } \
                            else { SWRITE_H(SB); } }                                                                          \
        RESC(alX); __syncthreads(); } while (0)
    for (int t = 1; t + 1 < NT; t += 2) {
        HALF_STEP(pB0, pB1, mnB, alB, pA0, pA1, alA, t, 1, 0, 0);
        HALF_STEP(pA0, pA1, mnA, alA, pB0, pB1, alB, t + 1, 0, 1, 1);
    }
    const bool even = (NT & 1) == 0;
    if (even) { SBAR(); qkt<1, SK>(pB0, pB1, K_lds, r32, hi, S.qr, ACT(NT - 1)); SBAR(); }
#define QROW(e) (nxt.Q + (size_t)(wid * QBLK + r32) * D + ((e) >> 1) * 16 + hi * 8 + ((e) & 1) * 4)
    if constexpr (F32) { SLOAD_F((const float*)nxt.K, kbn); SBAR();
#pragma unroll
        for (int e = 0; e < 8; ++e) S.tq[e] = *(const f32x4*)QROW(e); }
    else { SLOAD_H(nxt.K, nxt.V, kbn); SBAR();
#pragma unroll
        for (int d0 = 0; d0 < 8; ++d0) S.qr[d0] = load8<TIn>(nxt.Q + (size_t)(wid * QBLK + r32) * D + d0 * 16 + hi * 8); }
    SBAR();
    finishSM(pA0, pA1, alA, l_reg, pa0, pa1, pa2, pa3); SBAR();
    if constexpr (F32) {
#pragma unroll
        for (int e = 8; e < 16; ++e) S.tq[e] = *(const f32x4*)QROW(e); SBAR(); }
#undef QROW
    pv_tile<0, SK>(o, vb0, pa0, pa1, pa2, pa3, ACT(even ? NT - 2 : NT - 1));
    if (even) { MASKT(pB0, pB1, NT - 1); partialSM(pB0, pB1, m_reg, mnB, alB); __syncthreads(); RESC(alB);
        finishSM(pB0, pB1, alB, l_reg, pa0, pa1, pa2, pa3); SBAR(); pv_tile<1, SK>(o, vb0, pa0, pa1, pa2, pa3, ACT(NT - 1)); }
    SBAR(); SEAM_K0();
    if (hi == 0) li_l[r32] = l_reg; asm volatile("s_waitcnt lgkmcnt(0)" ::: "memory");
    float rli[16];
#pragma unroll
    for (int r = 0; r < 16; ++r) rli[r] = __builtin_amdgcn_rcpf(li_l[crow(r, hi)]);
    TOut* Ow = cur.O + (size_t)(wid * QBLK) * D;
#pragma unroll
    for (int r = 0; r < 16; ++r) { const int orow = crow(r, hi);
#pragma unroll
        for (int d0 = 0; d0 < 4; ++d0) { const float v = o[d0][r] * rli[r];
            if constexpr (same_t<TOut, float>::v) { Ow[(size_t)orow * D + d0 * 32 + r32] = v; }
            else { const float vn = __shfl_xor(v, 1);
                   if ((r32 & 1) == 0) *(unsigned*)(Ow + (size_t)orow * D + d0 * 32 + r32) = cvtpk(v, vn); } } }
    if constexpr (F32) {
#pragma unroll
        for (int d0 = 0; d0 < 8; ++d0) S.qr[d0] = pack8(S.tq[2 * d0], S.tq[2 * d0 + 1]); }
    __syncthreads();
#undef RESC
#undef KBASE
#undef ACT
#undef MASKT
#undef SEAM_K0
#undef HALF_STEP
}
#undef ROW
#undef VMW
#undef VMWN
#undef SLOAD_H
#undef SWRITE_HK
#undef SWRITE_HV
#undef SWRITE_H
#undef SLOAD_F
#undef SWRITE_KF
#undef SWRITE_VF
}
#include <hip/hip_cooperative_groups.h>
namespace cg = cooperative_groups;
#ifndef MK_N_LAUNCHES
#define MK_N_LAUNCHES 1
#endif
constexpr int NWAVES = 8;
constexpr int BATCH = 2, SEQ = 4096, DM = 2048, M = BATCH * SEQ, DFF = 5632, NMOD = 28672;
constexpr int MOD_A = 0, MOD_KV = 12288, MOD_B = 16384;
constexpr float EPS = 1e-6f;
constexpr float LAM_INIT = 0.35550906759f;
constexpr size_t MiB = 1u << 20;
constexpr size_t WS_MODS = 1 * MiB, WS_RT = 2 * MiB, WS_STATS = 6 * MiB;
constexpr size_t WS_W_IN = 8 * MiB, WS_W_OUT = 24 * MiB, WS_W_FIA = 32 * MiB, WS_W_FOA = 76 * MiB, WS_W_KV = 98 * MiB, WS_W_Q = 114 * MiB, WS_W_O = 122 * MiB, WS_W_FIB = 130 * MiB, WS_W_FOB = 174 * MiB;
constexpr size_t WS_XA = 196 * MiB, WS_XB = 260 * MiB, WS_XN = 324 * MiB, WS_XQ = 356 * MiB, WS_A3 = 388 * MiB, WS_Z = 420 * MiB, WS_QRAW = 420 * MiB, WS_H = 484 * MiB, WS_KRAW = 484 * MiB;
constexpr size_t WS_O = 420 * MiB, WS_VB = 548 * MiB, WS_KB = 580 * MiB, WS_QB = 612 * MiB, WS_SSQ = 644 * MiB, WS_END = 646 * MiB;
constexpr size_t WS_GAM = WS_MODS + 256 * 1024, WS_BIAS = WS_MODS + 512 * 1024;
constexpr int OFF_FIA = 0, OFF_KV = 11264, OFF_Q = 15360, OFF_FIB = 17408;
constexpr int LDS_BYTES = 147456;

#define GAS __attribute__((address_space(1)))
#define LAS __attribute__((address_space(3)))
typedef unsigned short hb;
typedef unsigned v4u __attribute__((ext_vector_type(4)));
typedef unsigned v2u __attribute__((ext_vector_type(2)));
typedef float f32x4 __attribute__((ext_vector_type(4)));
typedef float f32x2 __attribute__((ext_vector_type(2)));
typedef short bf16x8 __attribute__((ext_vector_type(8)));
#define LDS_WAIT() asm volatile("s_waitcnt lgkmcnt(0)" ::: "memory")
__device__ __forceinline__ unsigned f2bf(float f) { unsigned u = __builtin_bit_cast(unsigned, f); return (u + 0x7fffu + ((u >> 16) & 1u)) >> 16; }
__device__ __forceinline__ unsigned pk2(float lo, float hi) { return f2bf(lo) | (f2bf(hi) << 16); }
__device__ __forceinline__ float bflo(unsigned w) { return __builtin_bit_cast(float, w << 16); }
__device__ __forceinline__ float bfhi(unsigned w) { return __builtin_bit_cast(float, w & 0xffff0000u); }
__device__ __forceinline__ float wave_sum(float v) {
#pragma unroll
    for (int o = 1; o < 64; o <<= 1) v += __shfl_xor(v, o);
    return v;
}

__device__ __forceinline__ int wt_rowmap(int n, int mode, int N, int rope_lim) {
    if (mode == 1) { const int half = N / 2; const int mm = n < half ? n : n - half; return 256 * (mm / 128) + (mm % 128) + (n < half ? 0 : 128); }
    if (mode == 2 && n < rope_lim) { const int d = n & 127; return (n & ~127) + 32 * ((d & 63) >> 4) + 16 * (d >> 6) + 4 * ((d & 15) >> 2) + (d & 3); }
    return n;
}
struct TrItem { const float* W; hb* WT; int K, N, mode, lim, k0, n0; };
__device__ __forceinline__ void tr_load(const TrItem& t, float (&tv)[32], int lane) {
#pragma unroll
    for (int i = 0; i < 32; ++i) { const int kk = 2 * i + (lane >> 5); tv[i] = __builtin_nontemporal_load(t.W + (size_t)(t.k0 + kk) * t.N + t.n0 + (lane & 31)); }
}

#define XB_TMO      128
#define XB_XCNT(j)  (256  + 64 * (j))
#define XB_XSUB(j)  (1280 + 64 * (j))
#define XB_XGEN(j)  (2304 + 64 * (j))
#define XB_TOP      3328
#define XB_TOPGEN   3392
#define XCD_BAR_WORDS 3456
#define XB_SPIN_CAP (1u << 18)

__device__ __forceinline__ unsigned xb_ld(unsigned* p)              { return __hip_atomic_load(p, __ATOMIC_RELAXED, __HIP_MEMORY_SCOPE_AGENT); }
__device__ __forceinline__ unsigned xb_add(unsigned* p, unsigned v) { return __hip_atomic_fetch_add(p, v, __ATOMIC_RELAXED, __HIP_MEMORY_SCOPE_AGENT); }
__device__ __forceinline__ unsigned xb_xcc_id() { return (unsigned)__builtin_amdgcn_s_getreg((3 << 11) | 20) & 0xFu; }
#define XB_SPIN(cond, bar) do { unsigned _sp = 0; while (cond) { __builtin_amdgcn_s_sleep(1); \
    if ((++_sp & 255u) == 0u) { if (xb_ld(&(bar)[XB_TMO])) break; if (_sp > XB_SPIN_CAP) { atomicAdd(&(bar)[XB_TMO], 1u); break; } } } } while (0)

struct XcdBarrier {
    unsigned* bar; unsigned x;
    volatile LAS unsigned* st;
};

__device__ __forceinline__ XcdBarrier xcd_barrier_post(unsigned* bar, volatile LAS unsigned* st, int tid) {
    XcdBarrier b; b.bar = bar; b.x = xb_xcc_id(); b.st = st;
    if (tid == 0) (void)xb_add(&bar[XB_XCNT(b.x)], 1u);
    return b;
}
__device__ __forceinline__ void xcd_barrier_complete(unsigned* bar, unsigned x, unsigned& nloc, unsigned& nx) {
    const unsigned G = gridDim.x * gridDim.y * gridDim.z;
    unsigned sum, cnt, mine, sp = 0u;
    for (;;) {
        sum = 0u; cnt = 0u; mine = 0u;
#pragma unroll
        for (unsigned j = 0; j < 16; ++j) { const unsigned c = xb_ld(&bar[XB_XCNT(j)]); sum += c; cnt += (c > 0u) ? 1u : 0u; mine = (j == x) ? c : mine; }
        if (sum == G) break;
        __builtin_amdgcn_s_sleep(1);
        if ((++sp & 255u) == 0u) { if (xb_ld(&bar[XB_TMO])) break; if (sp > XB_SPIN_CAP) { atomicAdd(&bar[XB_TMO], 1u); break; } }
    }
    nloc = mine > 0u ? mine : 1u; nx = cnt > 0u ? cnt : 1u;
}

__device__ __forceinline__ void xcd_barrier(const XcdBarrier& b, int tid) {
    asm volatile("s_waitcnt vmcnt(0)" ::: "memory");
    __syncthreads();
    if (tid == 0) {
        unsigned* bar = b.bar;
        __builtin_amdgcn_s_waitcnt(0);
        unsigned nloc = b.st[0], nx = b.st[1];
        if (nloc == 0u) { xcd_barrier_complete(bar, b.x, nloc, nx); b.st[0] = nloc; b.st[1] = nx; }
        const unsigned old = xb_add(&bar[XB_XSUB(b.x)], 1u);
        const unsigned gen = old / nloc;
        if (old + 1u == (gen + 1u) * nloc) {
            __builtin_amdgcn_fence(__ATOMIC_RELEASE, "agent");
            asm volatile("s_waitcnt vmcnt(0)" ::: "memory");
            const unsigned og = xb_add(&bar[XB_TOP], 1u);
            const unsigned tg = og / nx;
            if (og + 1u == (tg + 1u) * nx) xb_add(&bar[XB_TOPGEN], 1u);
            else XB_SPIN(xb_ld(&bar[XB_TOPGEN]) == tg, bar);
            __builtin_amdgcn_fence(__ATOMIC_ACQUIRE, "agent");
            xb_add(&bar[XB_XGEN(b.x)], 1u);
            asm volatile("s_waitcnt vmcnt(0)" ::: "memory");
        } else {
            XB_SPIN(xb_ld(&bar[XB_XGEN(b.x)]) == gen, bar);
            __builtin_amdgcn_fence(__ATOMIC_ACQUIRE, "agent");
            asm volatile("s_waitcnt vmcnt(0)" ::: "memory");
        }
    }
    __syncthreads();
}

constexpr int CW_BAR = 4096; constexpr size_t CTL_ZERO_BYTES = 65536; constexpr int MISC_OFF = 131072;
__device__ __forceinline__ void epi_tables(LAS unsigned char* L, const pg8::StaticOrder& S, const float* ssq, const float* bias, int bstride, int tid) {
    LAS int* tags = (LAS int*)(L + pg8::TAB_OFF); LAS float* rT = (LAS float*)(L + pg8::TAB_OFF + 64); LAS float* bT = rT + pg8::TAB_SLOTS * 256;
    for (int i = 0; i < pg8::TAB_SLOTS; ++i) { pg8::Unit u;
        if (!S.next(i, u)) { if (tid == 0) tags[i] = -1; continue; }
        if (tid == 0) tags[i] = (u.pm << 8) | u.pn;
        if (ssq) { const int row = tid >> 1, hf = tid & 1; const float* q = ssq + (size_t)(u.pm * 256 + row) * 32 + hf * 16;
            const f32x4 a = *(const f32x4*)q, b = *(const f32x4*)(q + 4), c = *(const f32x4*)(q + 8), d = *(const f32x4*)(q + 12);
            float t = (((a.x + a.y) + (a.z + a.w)) + ((b.x + b.y) + (b.z + b.w))) + (((c.x + c.y) + (c.z + c.w)) + ((d.x + d.y) + (d.z + d.w)));
            t += __shfl_xor(t, 1); if (hf == 0) rT[i * 256 + row] = 1.0f / sqrtf(t * (1.0f / DM) + EPS); }
        if (tid < 256) bT[i * 256 + tid] = bias[(size_t)(u.pm >> 4) * bstride + u.pn * 256 + tid]; }
    __syncthreads();
}
struct Args { const void* in[35]; float* out; unsigned char* ws; int lo, hi; };
__device__ __forceinline__ int lane_id() { int l; asm volatile("v_mbcnt_lo_u32_b32 %0, -1, 0\n\tv_mbcnt_hi_u32_b32 %0, -1, %0" : "=v"(l)); return l; }
#define lt_tid() (wave * 64 + lane_id())
typedef const __attribute__((address_space(4))) unsigned long long* kargp_t;
__device__ __forceinline__ const void* karg(int i) { return (const void*)(const GAS void*)(((kargp_t)__builtin_amdgcn_kernarg_segment_ptr())[i]); }
#define KP(i) karg(i)

template <int NR> __device__ __forceinline__ void rows_norm_mod(const float* X, const float* g1, const float* sh1, const float* sc1, hb* o1, int gw, int NGW, int lane) {
    const unsigned l4 = 4u * (unsigned)lane;
    for (int R0 = NR * gw; R0 < M; R0 += NR * NGW) {
        const int b = R0 >> 12;
        const float* scb = sc1 + (size_t)b * NMOD; const float* shb = sh1 + (size_t)b * NMOD;
        f32x4 v[NR][8], gm[8], hh[8];
#pragma unroll
        for (int r = 0; r < NR; ++r) { const float* xr = X + (size_t)(R0 + r) * DM;
#pragma unroll
            for (int j = 0; j < 8; ++j) v[r][j] = __builtin_nontemporal_load((const f32x4*)(xr + (l4 + 256u * j))); }
#pragma unroll
        for (int j = 0; j < 8; ++j) { const unsigned col = l4 + 256u * j; gm[j] = *(const f32x4*)(g1 + col) * (*(const f32x4*)(scb + col) + 1.0f); hh[j] = *(const f32x4*)(shb + col); }
        float rstd[NR];
#pragma unroll
        for (int r = 0; r < NR; ++r) { float ss = 0.f;
#pragma unroll
            for (int j = 0; j < 8; ++j) ss += (v[r][j].x * v[r][j].x + v[r][j].y * v[r][j].y) + (v[r][j].z * v[r][j].z + v[r][j].w * v[r][j].w);
            rstd[r] = 1.0f / sqrtf(wave_sum(ss) * (1.0f / DM) + EPS); }
#pragma unroll
        for (int r = 0; r < NR; ++r) {
#pragma unroll
            for (int j = 0; j < 8; ++j) { const f32x4 y = (v[r][j] * rstd[r]) * gm[j] + hh[j]; *(v2u*)(o1 + tidx(R0 + r, (int)(l4 + 256u * j), DM)) = (v2u){pk2(y.x, y.y), pk2(y.z, y.w)}; } }
    }
}

__device__ __forceinline__ void qk_norm_rope(const float* raw, const float* g, const float* rt, hb* out, int gw, int NGW, int lane) {
    const int h = lane >> 2, q = lane & 3;
    float ga[16], gb[16];
#pragma unroll
    for (int e = 0; e < 16; ++e) { ga[e] = g[q * 16 + e]; gb[e] = g[64 + q * 16 + e]; }
    for (int row = gw; row < M; row += NGW) {
        const int b = row >> 12, s = row & 4095;
        const float* p = raw + (size_t)row * DM + h * 128 + q * 16;
        f32x4 a[4], c[4], cs[8]; float ss = 0.f;
#pragma unroll
        for (int e = 0; e < 4; ++e) { a[e] = *(const f32x4*)(p + 4 * e); c[e] = *(const f32x4*)(p + 64 + 4 * e);
            ss += (a[e].x * a[e].x + a[e].y * a[e].y) + (a[e].z * a[e].z + a[e].w * a[e].w) + (c[e].x * c[e].x + c[e].y * c[e].y) + (c[e].z * c[e].z + c[e].w * c[e].w); }
        const float* t = rt + ((size_t)row * 64 + q * 16) * 2;
#pragma unroll
        for (int e = 0; e < 8; ++e) cs[e] = *(const f32x4*)(t + 4 * e);
        ss += __shfl_xor(ss, 1); ss += __shfl_xor(ss, 2);
        const float rstd = 1.0f / sqrtf(ss * (1.0f / 128.0f) + EPS);
        float o1[16], o2[16];
#pragma unroll
        for (int e = 0; e < 16; ++e) { const float x1 = a[e >> 2][e & 3] * rstd * ga[e], x2 = c[e >> 2][e & 3] * rstd * gb[e];
            const float co = cs[e >> 1][(e & 1) * 2], si = cs[e >> 1][(e & 1) * 2 + 1];
            o1[e] = x1 * co - x2 * si; o2[e] = x2 * co + x1 * si; }
        hb* op = out + ((size_t)(b * 16 + h) * SEQ + s) * 128 + q * 16;
        *(v4u*)(op) = (v4u){pk2(o1[0], o1[1]), pk2(o1[2], o1[3]), pk2(o1[4], o1[5]), pk2(o1[6], o1[7])};
        *(v4u*)(op + 8) = (v4u){pk2(o1[8], o1[9]), pk2(o1[10], o1[11]), pk2(o1[12], o1[13]), pk2(o1[14], o1[15])};
        *(v4u*)(op + 64) = (v4u){pk2(o2[0], o2[1]), pk2(o2[2], o2[3]), pk2(o2[4], o2[5]), pk2(o2[6], o2[7])};
        *(v4u*)(op + 72) = (v4u){pk2(o2[8], o2[9]), pk2(o2[10], o2[11]), pk2(o2[12], o2[13]), pk2(o2[14], o2[15])};
    }
}

__device__ __forceinline__ void attn_combine(const float* O, const float* sg, float lam, hb* A, int gw, int NGW, int lane) {
    const int h = lane >> 3, q = lane & 7, v = q >> 2, d0 = (q & 3) * 32;
    f32x4 gg[8];
#pragma unroll
    for (int e = 0; e < 8; ++e) gg[e] = *(const f32x4*)(sg + v * 128 + d0 + 4 * e);
    for (int R0 = 2 * gw; R0 < M; R0 += 2 * NGW) {
        const int b = R0 >> 12, s = R0 & 4095;
        const float* p1 = O + ((size_t)(b * 32 + 4 * h + v) * SEQ + s) * 128 + d0;
        const float* p2 = O + ((size_t)(b * 32 + 4 * h + 2 + v) * SEQ + s) * 128 + d0;
        f32x4 x1[2][8], x2[2][8];
#pragma unroll
        for (int r = 0; r < 2; ++r)
#pragma unroll
            for (int e = 0; e < 8; ++e) { x1[r][e] = *(const f32x4*)(p1 + r * 128 + 4 * e); x2[r][e] = *(const f32x4*)(p2 + r * 128 + 4 * e); }
#pragma unroll
        for (int r = 0; r < 2; ++r) { float ss = 0.f;
#pragma unroll
            for (int e = 0; e < 8; ++e) { x1[r][e] = x1[r][e] - lam * x2[r][e]; ss += (x1[r][e].x * x1[r][e].x + x1[r][e].y * x1[r][e].y) + (x1[r][e].z * x1[r][e].z + x1[r][e].w * x1[r][e].w); }
            ss += __shfl_xor(ss, 1); ss += __shfl_xor(ss, 2); ss += __shfl_xor(ss, 4);
            const float rstd = (1.0f - LAM_INIT) / sqrtf(ss * (1.0f / 256.0f) + EPS);
            hb* op = A + tidx(R0 + r, h * 256 + v * 128 + d0, DM);
#pragma unroll
            for (int e = 0; e < 8; e += 2) { const f32x4 y0 = x1[r][e] * rstd * gg[e], y1 = x1[r][e + 1] * rstd * gg[e + 1];
                *(v4u*)(op + 4 * e) = (v4u){pk2(y0.x, y0.y), pk2(y0.z, y0.w), pk2(y1.x, y1.y), pk2(y1.z, y1.w)}; } }
    }
}

__device__ __forceinline__ att::BlockRef<att::bf16, float> mkref(int Lx, int pass, const hb* Qb, const hb* Kb, const hb* Vb, float* Ob) {
    const int bh = Lx >> 3, xx = Lx & 7, qb = pass ? 15 - xx : xx; const int b = bh >> 5, r = bh & 31, hh = r >> 2, s = (r >> 1) & 1, v = r & 1;
    att::BlockRef<att::bf16, float> rr;
    rr.Q = (const att::bf16*)Qb + ((size_t)(b * 16 + 2 * hh + s) * SEQ + (size_t)qb * att::QB) * 128; rr.K = (const att::bf16*)Kb + (size_t)(b * 16 + 2 * hh + s) * SEQ * 128;
    rr.V = (const att::bf16*)Vb + (size_t)(b * 16 + 2 * hh + v) * SEQ * 128; rr.O = Ob + ((size_t)(b * 32 + r) * SEQ + (size_t)qb * att::QB) * 128; rr.P0 = qb * att::QB; return rr;
}
#define XIN ((const float*)KP(0))
#define cvec ((const float*)KP(1))
#define positions ((const int*)KP(2))
#define mods ((float*)(ws + WS_MODS))
#define gam ((float*)(ws + WS_GAM))
#define biasT ((float*)(ws + WS_BIAS))
#define SSQ ((float*)(ws + WS_SSQ))
#define rt ((float*)(ws + WS_RT))
#define stats ((float*)(ws + WS_STATS))
#define W_in ((hb*)(ws + WS_W_IN))
#define W_out ((hb*)(ws + WS_W_OUT))
#define W_fia ((hb*)(ws + WS_W_FIA))
#define W_foa ((hb*)(ws + WS_W_FOA))
#define W_kv ((hb*)(ws + WS_W_KV))
#define W_q ((hb*)(ws + WS_W_Q))
#define W_o ((hb*)(ws + WS_W_O))
#define W_fib ((hb*)(ws + WS_W_FIB))
#define W_fob ((hb*)(ws + WS_W_FOB))
#define XA ((float*)(ws + WS_XA))
#define XB ((float*)(ws + WS_XB))
#define XN ((hb*)(ws + WS_XN))
#define XQ ((hb*)(ws + WS_XQ))
#define A3 ((hb*)(ws + WS_A3))
#define Z ((hb*)(ws + WS_Z))
#define H ((hb*)(ws + WS_H))
#define KRAW ((float*)(ws + WS_KRAW))
#define QRAW ((float*)(ws + WS_QRAW))
#define OB ((float*)(ws + WS_O))
#define VB ((hb*)(ws + WS_VB))
#define KB ((hb*)(ws + WS_KB))
#define QB_ ((hb*)(ws + WS_QB))
__device__ __forceinline__ void bias_chunks(unsigned char* ws, int c_lo, int c_hi, int gw, int NGW, int lane) {
        for (int c = c_lo + gw; c < c_hi; c += NGW) { const int r0 = 16 * c; const hb* Wt; int sho;
            int rl;
            if (r0 < OFF_KV) { Wt = W_fia; rl = r0; sho = MOD_A + 6144; } else if (r0 < OFF_Q) { Wt = W_kv; rl = r0 - OFF_KV; sho = MOD_KV; }
            else if (r0 < OFF_FIB) { Wt = W_q; rl = r0 - OFF_Q; sho = MOD_B; } else { Wt = W_fib; rl = r0 - OFF_FIB; sho = MOD_B + 6144; }
            f32x4 s0[4][2], s1[4][2];
#pragma unroll
            for (int j = 0; j < 4; ++j)
#pragma unroll
                for (int e = 0; e < 2; ++e) { s0[j][e] = *(const f32x4*)(mods + sho + 8 * lane + 512 * j + 4 * e); s1[j][e] = *(const f32x4*)(mods + NMOD + sho + 8 * lane + 512 * j + 4 * e); }
            for (int hf = 0; hf < 4; ++hf) { v4u wv[4][4];
#pragma unroll
                for (int r = 0; r < 4; ++r)
#pragma unroll
                    for (int j = 0; j < 4; ++j) wv[r][j] = __builtin_nontemporal_load((const v4u*)(Wt + tidx(rl + 4 * hf + r, 8 * lane + 512 * j, DM)));
                float myb0 = 0.f, myb1 = 0.f;
#pragma unroll
                for (int r = 0; r < 4; ++r) { float a0 = 0.f, a1 = 0.f;
#pragma unroll
                    for (int j = 0; j < 4; ++j) { const v4u w = wv[r][j]; const f32x4 lo = {bflo(w.x), bfhi(w.x), bflo(w.y), bfhi(w.y)}, hi2 = {bflo(w.z), bfhi(w.z), bflo(w.w), bfhi(w.w)};
                        const f32x4 p0 = lo * s0[j][0] + hi2 * s0[j][1], p1 = lo * s1[j][0] + hi2 * s1[j][1]; a0 += (p0.x + p0.y) + (p0.z + p0.w); a1 += (p1.x + p1.y) + (p1.z + p1.w); }
                    a0 = wave_sum(a0); a1 = wave_sum(a1); if (lane == r) { myb0 = a0; myb1 = a1; } }
                if (lane < 4) { biasT[r0 + 4 * hf + lane] = myb0; biasT[pg8::NBIAS + r0 + 4 * hf + lane] = myb1; } }
        }
}
__global__ void __launch_bounds__(NWAVES * 64, 2) yoco_fwd(Args args) {
    extern __shared__ __attribute__((aligned(16))) unsigned char lds[];
    LAS unsigned char* L = (LAS unsigned char*)lds;
    const int wave = __builtin_amdgcn_readfirstlane((int)threadIdx.x >> 6);
#define PH_IDS const int tid = lt_tid(), lane = tid & 63
    volatile LAS unsigned* MISC = (volatile LAS unsigned*)(L + MISC_OFF);
    { const int t0 = lt_tid(); if (t0 < 16) MISC[t0] = 0u; }
    __syncthreads();
    const int G = gridDim.x, bx = blockIdx.x;
    const int gw = bx * NWAVES + wave, NGW = G * NWAVES;
    unsigned char* ws = (unsigned char*)KP(36);
    const unsigned long long lohi = ((kargp_t)__builtin_amdgcn_kernarg_segment_ptr())[37]; const int lo = (int)(unsigned)lohi, hi = (int)(unsigned)(lohi >> 32);
#ifndef PHM
#define PHM 0x1ffff
#endif
#define IN(k) (((PHM >> (k)) & 1) && lo <= (k) && (k) < hi)
    XcdBarrier xbar; xbar.bar = (unsigned*)ws + CW_BAR; xbar.x = 0; xbar.st = nullptr;
    if (hi - lo > 1) xbar = xcd_barrier_post((unsigned*)ws + CW_BAR, MISC + 8, lt_tid());
#define SEAM(k) do { if (IN(k) && IN((k) + 1)) { xcd_barrier(xbar, lt_tid()); } } while (0)
    if (lo < 0) cg::this_grid().sync();

    if (IN(0)) { PH_IDS;
        {
            LAS float* sc = (LAS float*)L; LAS float* red = (LAS float*)(L + 16384);
            for (int i = tid; i < 2 * DM; i += NWAVES * 64) { const float cv = cvec[i]; sc[i] = cv / (1.0f + __expf(-cv)); }
            __syncthreads();
            for (int it = bx; it < NMOD / 128; it += G) {
                const int gc = it * 128; const float* Wm; const float* bm; int N, c0;
                if (gc < MOD_KV) { Wm = (const float*)KP(3); bm = (const float*)KP(4); N = 12288; c0 = gc; }
                else if (gc < MOD_B) { Wm = (const float*)KP(16); bm = (const float*)KP(17); N = 4096; c0 = gc - MOD_KV; }
                else { Wm = (const float*)KP(21); bm = (const float*)KP(22); N = 12288; c0 = gc - MOD_B; }
                const float* wp = Wm + (size_t)(256 * wave) * N + c0 + 2 * lane;
                f32x2 a0 = {0.f, 0.f}, a1 = {0.f, 0.f};
#pragma unroll 16
                for (int kk = 0; kk < 256; ++kk) { const f32x2 wv = __builtin_nontemporal_load((const f32x2*)(wp + (size_t)kk * N)); const float s0 = sc[256 * wave + kk], s1 = sc[DM + 256 * wave + kk]; a0 += wv * s0; a1 += wv * s1; }
                red[(wave * 2 + 0) * 128 + 2 * lane] = a0.x; red[(wave * 2 + 0) * 128 + 2 * lane + 1] = a0.y;
                red[(wave * 2 + 1) * 128 + 2 * lane] = a1.x; red[(wave * 2 + 1) * 128 + 2 * lane + 1] = a1.y;
                __syncthreads();
                if (tid < 256) { const int b = tid >> 7, cc = tid & 127; float s = bm[c0 + cc];
#pragma unroll
                    for (int w = 0; w < 8; ++w) s += red[(w * 2 + b) * 128 + cc];
                    mods[(size_t)b * NMOD + gc + cc] = s; }
                __syncthreads();
            }
        }
        for (int idx = gw * 64 + lane; idx < M * 64; idx += NGW * 64) { const int row = idx >> 6, i = idx & 63;
            const float inv = 1.0f / exp2f((float)i * (13.287712379549449f / 64.0f)); const float ang = (float)positions[row] * inv;
            double rev = (double)ang * 0.15915494309189535; rev -= floor(rev); const float rf = (float)rev;
            *(f32x2*)(rt + (size_t)idx * 2) = (f32x2){__builtin_amdgcn_cosf(rf), __builtin_amdgcn_sinf(rf)}; }
        {
            LAS float* scr = (LAS float*)(L + wave * 16384);
            constexpr int I_IN = (DM / 64) * (2 * DM / 32), I_SQ = (DM / 64) * (DM / 32), I_FI = (DM / 64) * (2 * DFF / 32), I_FO = (DFF / 64) * (DM / 32);
            constexpr int NITEMS = 2 * I_IN + 3 * I_SQ + 2 * I_FI + 2 * I_FO;
#define TR_DECODE(T, itx) do { int r = (itx); \
                if (r < I_IN) { T.W = (const float*)KP(6); T.WT = W_in; T.K = DM; T.N = 2 * DM; T.mode = 0; T.lim = 0; } else { r -= I_IN; \
                if (r < I_SQ) { T.W = (const float*)KP(12); T.WT = W_out; T.K = DM; T.N = DM; T.mode = 0; T.lim = 0; } else { r -= I_SQ; \
                if (r < I_FI) { T.W = (const float*)KP(14); T.WT = W_fia; T.K = DM; T.N = 2 * DFF; T.mode = 1; T.lim = 0; } else { r -= I_FI; \
                if (r < I_FO) { T.W = (const float*)KP(15); T.WT = W_foa; T.K = DFF; T.N = DM; T.mode = 0; T.lim = 0; } else { r -= I_FO; \
                if (r < I_IN) { T.W = (const float*)KP(19); T.WT = W_kv; T.K = DM; T.N = 2 * DM; T.mode = 2; T.lim = DM; } else { r -= I_IN; \
                if (r < I_SQ) { T.W = (const float*)KP(24); T.WT = W_q; T.K = DM; T.N = DM; T.mode = 2; T.lim = DM; } else { r -= I_SQ; \
                if (r < I_SQ) { T.W = (const float*)KP(31); T.WT = W_o; T.K = DM; T.N = DM; T.mode = 0; T.lim = 0; } else { r -= I_SQ; \
                if (r < I_FI) { T.W = (const float*)KP(33); T.WT = W_fib; T.K = DM; T.N = 2 * DFF; T.mode = 1; T.lim = 0; } else { r -= I_FI; \
                                T.W = (const float*)KP(34); T.WT = W_fob; T.K = DFF; T.N = DM; T.mode = 0; T.lim = 0; } } } } } } } } \
                const int nblk_ = T.N / 32; T.k0 = 64 * (r / nblk_); T.n0 = 32 * (r % nblk_); } while (0)
            float tv[32]; TrItem cur, nxt;
            int it = gw;
            if (it < NITEMS) { TR_DECODE(cur, it); tr_load(cur, tv, lane); nxt = cur; }
            while (it < NITEMS) {
#pragma unroll
                for (int i = 0; i < 32; ++i) { const int kk = 2 * i + (lane >> 5); scr[kk * 33 + (lane & 31)] = tv[i]; }
                LDS_WAIT(); asm volatile("" ::: "memory");
                const int itn = it + NGW;
                if (itn < NITEMS) { TR_DECODE(nxt, itn); tr_load(nxt, tv, lane); }
                const int c = lane & 7;
#pragma unroll
                for (int j = 0; j < 4; ++j) { const int n = (lane >> 3) + 8 * j; const LAS float* sp = scr + (8 * c) * 33 + n;
                    v4u o; o.x = pk2(sp[0 * 33], sp[1 * 33]); o.y = pk2(sp[2 * 33], sp[3 * 33]); o.z = pk2(sp[4 * 33], sp[5 * 33]); o.w = pk2(sp[6 * 33], sp[7 * 33]);
                    __builtin_nontemporal_store(o, (GAS v4u*)(cur.WT + tidx(wt_rowmap(cur.n0 + n, cur.mode, cur.N, cur.lim), cur.k0 + 8 * c, cur.K))); }
                LDS_WAIT(); asm volatile("" ::: "memory");
                cur = nxt; it = itn;
            }
#undef TR_DECODE
        }
        __syncthreads();
    }
    SEAM(0);
    if (IN(1)) { PH_IDS;
        rows_norm_mod<2>(XIN, (const float*)KP(5), mods + MOD_A + 0, mods + MOD_A + 2048, XN, gw, NGW, lane); }
    if (IN(1)) { PH_IDS;
        for (int idx = gw * 64 + lane; idx < 4 * 2 * DM; idx += NGW * 64) { const int m = idx >> 12, b = (idx >> 11) & 1, col = idx & 2047;
            const float* gp = m == 0 ? (const float*)KP(13) : m == 1 ? (const float*)KP(18) : m == 2 ? (const float*)KP(23) : (const float*)KP(32);
            const int so = m == 0 ? MOD_A + 8192 : m == 1 ? MOD_KV + 2048 : m == 2 ? MOD_B + 2048 : MOD_B + 8192;
            gam[idx] = gp[col] * (1.0f + mods[(size_t)b * NMOD + so + col]); }
        bias_chunks(ws, 0, (G == 256) ? OFF_KV / 16 : pg8::NBIAS / 16, gw, NGW, lane);
    }
    SEAM(1);
    if (IN(2)) { pg8::Gemm g{XN, W_in, M, 2 * DM, DM}; pg8::StaticOrder S; S.init(M, 2 * DM, G, bx);
        epi_tables(L, S, nullptr, (const float*)KP(7), 0, lt_tid());
        pg8::EpiGeluStats E{Z, 2 * DM, L + pg8::TAB_OFF, stats};
        pg8::gemm_phase<pg8::EpiGeluStats, pg8::StaticOrder, false, true>(L, g, S, E, lt_tid()); }
    SEAM(2);
    if (IN(3)) { PH_IDS;
        LAS hb* vTb = (LAS hb*)L; LAS f32x2* st = (LAS f32x2*)(L + 73728);
        const float* lng = (const float*)KP(8); const float* lnb = (const float*)KP(9); const float* sw = (const float*)KP(10); const float* sb = (const float*)KP(11);
        const int tl = lane & 15, quad = lane >> 4; int cur_g = -1; bf16x8 wf[4]; int buf = 0;
        v4u zpre[4]; v2u upre[8];
#define ZULOAD(uu) do { const int g_ = (uu) & 15, R_ = ((uu) >> 4) * 128; _Pragma("unroll") for (int i = 0; i < 4; ++i) { const int qd = tid + 512 * i; \
            zpre[i] = *(const v4u*)(Z + (size_t)(R_ + (qd >> 4)) * (2 * DM) + DM + g_ * 128 + (qd & 15) * 8); } \
            _Pragma("unroll") for (int nt = 0; nt < 8; ++nt) upre[nt] = *(const v2u*)(Z + (size_t)(R_ + 16 * wave + tl) * (2 * DM) + g_ * 128 + 16 * nt + quad * 4); } while (0)
        for (int u0 = bx; u0 < 1024; u0 += 4 * G) {
            { const int j = tid >> 7, r = tid & 127, uj = u0 + j * G;
              if (uj < 1024) { const float* sp = stats + (size_t)((uj >> 4) * 128 + r) * 64; float s1 = 0.f, s2 = 0.f;
#pragma unroll
                for (int i = 0; i < 16; ++i) { const f32x4 p = *(const f32x4*)(sp + 4 * i); s1 += p.x + p.z; s2 += p.y + p.w; }
                const float mean = s1 * (1.0f / DM); const float var = fmaxf(s2 * (1.0f / DM) - mean * mean, 0.f); st[tid] = (f32x2){mean, 1.0f / sqrtf(var + EPS)}; } }
            ZULOAD(u0);
            __syncthreads();
            for (int j = 0; j < 4; ++j) { const int u = u0 + j * G; if (u >= 1024) break;
                const int g = u & 15, R0 = (u >> 4) * 128; LAS hb* vT = vTb + buf * (128 * 136);
                if (g != cur_g) { cur_g = g; const int t = 16 * wave + tl;
#pragma unroll
                    for (int ks = 0; ks < 4; ++ks) { const int s0 = 32 * ks + 8 * quad; const float* wp = sw + ((size_t)g * 128 + t) * 128 + s0;
                        const f32x4 w0 = *(const f32x4*)wp, w1 = *(const f32x4*)(wp + 4); float wv[8] = {w0.x, w0.y, w0.z, w0.w, w1.x, w1.y, w1.z, w1.w};
#pragma unroll
                        for (int jj = 0; jj < 8; ++jj) if (s0 + jj > t) wv[jj] = 0.f;
                        v4u pw = {pk2(wv[0], wv[1]), pk2(wv[2], wv[3]), pk2(wv[4], wv[5]), pk2(wv[6], wv[7])}; wf[ks] = __builtin_bit_cast(bf16x8, pw); } }
#pragma unroll
                for (int i = 0; i < 4; ++i) { const int qd = tid + 512 * i, s = qd >> 4, cc = (qd & 15) * 8;
                    const v4u zv = zpre[i]; const f32x2 ms = st[j * 128 + s];
                    const f32x4 g0 = *(const f32x4*)(lng + g * 128 + cc), g1 = *(const f32x4*)(lng + g * 128 + cc + 4), b0 = *(const f32x4*)(lnb + g * 128 + cc), b1 = *(const f32x4*)(lnb + g * 128 + cc + 4);
                    float y[8] = {bflo(zv.x), bfhi(zv.x), bflo(zv.y), bfhi(zv.y), bflo(zv.z), bfhi(zv.z), bflo(zv.w), bfhi(zv.w)};
                    const float gg[8] = {g0.x, g0.y, g0.z, g0.w, g1.x, g1.y, g1.z, g1.w}, bb[8] = {b0.x, b0.y, b0.z, b0.w, b1.x, b1.y, b1.z, b1.w};
#pragma unroll
                    for (int e = 0; e < 8; ++e) vT[(cc + e) * 136 + s] = (hb)f2bf((y[e] - ms.x) * ms.y * gg[e] + bb[e]); }
                v2u ucur[8];
#pragma unroll
                for (int nt = 0; nt < 8; ++nt) ucur[nt] = upre[nt];
                if (j < 3 && u + G < 1024) ZULOAD(u + G);
                __syncthreads();
                { const int t = 16 * wave + tl, row = R0 + t; const float bias = sb[g * 128 + t];
#pragma unroll
                  for (int nt = 0; nt < 8; ++nt) { f32x4 acc = {0.f, 0.f, 0.f, 0.f};
#pragma unroll
                    for (int ks = 0; ks < 4; ++ks) if (ks <= (wave >> 1)) { const bf16x8 bfr = *(const LAS bf16x8*)(vT + (16 * nt + tl) * 136 + 32 * ks + 8 * quad);
                        acc = __builtin_amdgcn_mfma_f32_16x16x32_bf16(bfr, wf[ks], acc, 0, 0, 0); }
                    const int col = g * 128 + 16 * nt + quad * 4; const v2u uv = ucur[nt];
                    const float y0 = bflo(uv.x) * (acc[0] + bias), y1 = bfhi(uv.x) * (acc[1] + bias), y2 = bflo(uv.y) * (acc[2] + bias), y3 = bfhi(uv.y) * (acc[3] + bias);
                    *(v2u*)(A3 + tidx(row, col, DM)) = (v2u){pk2(y0, y1), pk2(y2, y3)}; } }
                buf ^= 1;
            }
            __syncthreads();
        }
#undef ZULOAD
    }
    SEAM(3);
    if (IN(4)) { pg8::Gemm g{A3, W_out, M, DM, DM}; pg8::StaticOrder S; S.init(M, DM, G, bx);
        pg8::EpiResNorm<true> E{XIN, XA, mods + MOD_A + 4096, NMOD, DM, gam + 0 * 4096, XN, nullptr, nullptr, SSQ};
        pg8::gemm_phase<pg8::EpiResNorm<true>, pg8::StaticOrder, true, true>(L, g, S, E, lt_tid()); }
    SEAM(4);
    if (IN(6)) { pg8::Gemm g{XN, W_fia, M, 2 * DFF, DM}; pg8::StaticOrder S; S.init(M, 2 * DFF, G, bx);
        epi_tables(L, S, SSQ, biasT + OFF_FIA, pg8::NBIAS, lt_tid());
        pg8::EpiSwiGLU E{H, DFF, L + pg8::TAB_OFF};
        pg8::gemm_phase<pg8::EpiSwiGLU, pg8::StaticOrder, false, true>(L, g, S, E, lt_tid());
        if (G == 256 && bx >= 128) { PH_IDS; (void)tid; bias_chunks(ws, OFF_KV / 16, pg8::NBIAS / 16, (bx - 128) * NWAVES + wave, 128 * NWAVES, lane); }
    }
    SEAM(6);
    if (IN(7)) { pg8::Gemm g{H, W_foa, M, DM, DFF}; pg8::StaticOrder S; S.init(M, DM, G, bx);
        pg8::EpiResNorm<false> E{XA, XB, mods + MOD_A + 10240, NMOD, DM, gam + 1 * 4096, XN, gam + 2 * 4096, XQ, SSQ};
        pg8::gemm_phase<pg8::EpiResNorm<false>, pg8::StaticOrder, true, true>(L, g, S, E, lt_tid()); }
    SEAM(7);
    if (IN(9)) {
        { pg8::Gemm g{XN, W_kv, M, DM, DM}; pg8::StaticOrder S; S.init(M, DM, G, bx); pg8::EpiQKRope E{KB, (const float*)KP(20), rt, SSQ, biasT + OFF_KV};
          pg8::gemm_phase<pg8::EpiQKRope, pg8::StaticOrder, false, true>(L, g, S, E, lt_tid()); }
        { pg8::Gemm g{XN, W_kv + (size_t)DM * DM, M, DM, DM}; pg8::StaticOrder S; S.init(M, DM, G, bx); pg8::EpiVhead E{VB, SSQ, biasT + OFF_KV + DM};
          pg8::gemm_phase<pg8::EpiVhead, pg8::StaticOrder, true, true>(L, g, S, E, lt_tid()); }
        { pg8::Gemm g{XQ, W_q, M, DM, DM}; pg8::StaticOrder S; S.init(M, DM, G, bx); pg8::EpiQKRope E{QB_, (const float*)KP(25), rt, SSQ, biasT + OFF_Q};
          pg8::gemm_phase<pg8::EpiQKRope, pg8::StaticOrder, false, true>(L, g, S, E, lt_tid()); }
    }
    SEAM(9);
#define SKIP10 1
    if (IN(11)) {
        typedef att::BlockRef<att::bf16, float> BR;
        const int total = 8 * 64, stride = G;
        int Li = (G % 8 == 0) ? (bx % 8) * (G / 8) + bx / 8 : bx;
        if (Li < total) {
#define MKREF(Lx, pass) mkref((Lx), (pass), QB_, KB, VB, OB)
            int pass = 0; BR cur = MKREF(Li, 0);
            att::Seam<att::bf16> S;
            att::causal_swa_prime<att::bf16, float>(cur, SEQ, (char*)lds, S, lt_tid());
            for (;;) {
                const bool more_pass = pass == 0, more_item = Li + stride < total, last = !more_pass && !more_item;
                int passn = pass + 1, Ln = Li;
                if (!more_pass) { passn = 0; Ln = more_item ? Li + stride : Li; }
                const BR nxt = last ? cur : MKREF(Ln, passn);
                att::causal_swa_block<att::bf16, float>(cur, nxt, SEQ, SEQ, (char*)lds, S, lt_tid());
                if (last) break;
                cur = nxt; pass = passn; Li = Ln;
            }
#undef MKREF
        }
    }
    SEAM(11);
    if (IN(12)) { PH_IDS;
        const float* q1 = (const float*)KP(26); const float* k1 = (const float*)KP(27); const float* q2 = (const float*)KP(28); const float* k2 = (const float*)KP(29);
        const float d1 = wave_sum(q1[lane] * k1[lane] + q1[lane + 64] * k1[lane + 64]), d2 = wave_sum(q2[lane] * k2[lane] + q2[lane + 64] * k2[lane + 64]);
        const float lam = expf(d1) - expf(d2) + LAM_INIT;
        attn_combine(OB, (const float*)KP(30), lam, A3, gw, NGW, lane);
    }
    SEAM(12);
    if (IN(13)) { pg8::Gemm g{A3, W_o, M, DM, DM}; pg8::StaticOrder S; S.init(M, DM, G, bx);
        pg8::EpiResNorm<false> E{XB, XA, mods + MOD_B + 4096, NMOD, DM, gam + 3 * 4096, XN, nullptr, nullptr, SSQ};
        pg8::gemm_phase<pg8::EpiResNorm<false>, pg8::StaticOrder, true, true>(L, g, S, E, lt_tid()); }
    SEAM(13);
    if (IN(15)) { pg8::Gemm g{XN, W_fib, M, 2 * DFF, DM}; pg8::StaticOrder S; S.init(M, 2 * DFF, G, bx);
        epi_tables(L, S, SSQ, biasT + OFF_FIB, pg8::NBIAS, lt_tid());
        pg8::EpiSwiGLU E{H, DFF, L + pg8::TAB_OFF};
        pg8::gemm_phase<pg8::EpiSwiGLU, pg8::StaticOrder, false, true>(L, g, S, E, lt_tid()); }
    SEAM(15);
    if (IN(16)) { pg8::Gemm g{H, W_fob, M, DM, DFF}; pg8::StaticOrder S; S.init(M, DM, G, bx);
        pg8::EpiResNorm<false> E{XA, (float*)KP(35), mods + MOD_B + 10240, NMOD, DM, nullptr, nullptr, nullptr, nullptr, nullptr};
        pg8::gemm_phase<pg8::EpiResNorm<false>, pg8::StaticOrder, true, true>(L, g, S, E, lt_tid()); }
#undef IN
#undef SEAM
}
constexpr int NPHASES = 17;

extern "C" void kernel_launch(void* const* d_in, const int* in_sizes, int n_in, void* d_out, int out_size, void* d_ws, size_t ws_size, hipStream_t stream) {
    static int grid = 0;
    if (grid == 0) {
        if (n_in != 35 || in_sizes[0] != M * DM || out_size != M * DM || ws_size < WS_END) { fprintf(stderr, "kernel_launch: unexpected shapes: n_in %d in0 %d out %d ws %zu (need %zu)\n", n_in, n_in > 0 ? in_sizes[0] : -1, out_size, ws_size, (size_t)WS_END); grid = -1; return; }
        int dev = 0, cus = 0, per_cu = 0;
        if (hipGetDevice(&dev) != hipSuccess || hipDeviceGetAttribute(&cus, hipDeviceAttributeMultiprocessorCount, dev) != hipSuccess) { grid = -1; return; }
        if (hipFuncSetAttribute((const void*)yoco_fwd, hipFuncAttributeMaxDynamicSharedMemorySize, LDS_BYTES) != hipSuccess) { fprintf(stderr, "kernel_launch: hipFuncSetAttribute failed\n"); grid = -1; return; }
        if (hipOccupancyMaxActiveBlocksPerMultiprocessor(&per_cu, (const void*)yoco_fwd, NWAVES * 64, LDS_BYTES) != hipSuccess || per_cu < 1) { fprintf(stderr, "kernel_launch: occupancy query gives %d\n", per_cu); per_cu = 1; }
        (void)hipGetLastError();
        if (cus != 256) fprintf(stderr, "kernel_launch: built for a 256-CU device (one 256x256 unit per workgroup in the fused-epilogue GEMM phases); found %d CUs\n", cus);
        grid = cus;
    }
    if (grid < 0) return;
    if (hipMemsetAsync(d_ws, 0, CTL_ZERO_BYTES, stream) != hipSuccess) { fprintf(stderr, "kernel_launch: hipMemsetAsync failed\n"); return; }
    Args a{};
    for (int i = 0; i < 35; ++i) a.in[i] = d_in[i];
    a.out = (float*)d_out; a.ws = (unsigned char*)d_ws;
#if MK_N_LAUNCHES == 1
    a.lo = 0; a.hi = NPHASES;
    void* kargs[] = {&a};
    hipError_t e = hipLaunchCooperativeKernel((const void*)yoco_fwd, dim3(grid), dim3(NWAVES * 64), kargs, LDS_BYTES, stream);
    if (e != hipSuccess) fprintf(stderr, "kernel_launch: cooperative launch failed: %s (grid %d)\n", hipGetErrorString(e), grid);
#else
#ifndef DUP_MASK
#define DUP_MASK 0
#endif
    for (int p = 0; p < NPHASES; ++p) { a.lo = p; a.hi = p + 1; for (int r = 0; r < 1 + ((DUP_MASK >> p) & 1); ++r) hipLaunchKernelGGL(yoco_fwd, dim3(grid), dim3(NWAVES * 64), LDS_BYTES, stream, a); }
#endif
}
```

```cpp
#define MK_N_LAUNCHES 1
#include <hip/hip_runtime.h>
#include <hip/hip_bf16.h>
#include <cstdio>
#include <cstdint>
#include <cmath>
__host__ __device__ __forceinline__ size_t tidx(int r, int k, int K) { return ((size_t)(r >> 7) * (size_t)(K >> 6) + (size_t)(k >> 6)) * 8192 + (size_t)((r & 127) * 64 + (k & 63)); }
namespace pg8 {
#define PG8_LAS __attribute__((address_space(3)))
typedef unsigned short bf16_t;
typedef short bf16x8 __attribute__((ext_vector_type(8)));
typedef float f32x4 __attribute__((ext_vector_type(4)));
typedef unsigned u32x4 __attribute__((ext_vector_type(4)));
constexpr int BM = 256, BK = 64, HALF = 128, HTB = HALF * BK * 2  , STAGE_BYTES = 8 * HTB, NXCD = 8, WGM = 8;

__host__ __device__ __forceinline__ int lds_byte(int r, int c) { const int st = (r >> 4) * 2 + (c >> 5), rr = r & 15, cc = c & 31, ob = rr * 64 + cc * 2; return st * 1024 + (ob ^ (((ob >> 9) & 1) << 5)); }
__host__ __device__ __forceinline__ void stage_rc(int b, int& R, int& C) { const int st = b / 1024, sb = b % 1024, swz = sb ^ (((sb >> 9) & 1) << 5); R = (st >> 1) * 16 + swz / 64; C = (st & 1) * 32 + (swz % 64) / 2; }
__host__ __device__ __forceinline__ int perm32(int rho) { const int n = rho >> 4, i = rho & 15; return 8 * (i >> 2) + 4 * n + (i & 3); }

struct Unit { int pm, pn; };
struct Gemm { const bf16_t* A; const bf16_t* Bt; int M, N, K; };

struct StaticOrder {
    int nM, nN, nwg, G, c;
    __host__ __device__ void init(int M, int N, int G_, int c_) { nM = M / BM; nN = N / BM; nwg = nM * nN; G = G_; c = c_; }
    __host__ __device__ bool next(int i, Unit& u) const {
        const long L = (long)i * G + c; if (L >= nwg) return false;
        int wgid = (int)L; { const int q = nwg / NXCD, r = nwg % NXCD, xcd = wgid % NXCD, off = wgid / NXCD; wgid = (xcd < r ? xcd * (q + 1) : r * (q + 1) + (xcd - r) * q) + off; }
        const int nig = WGM * nN, gid = wgid / nig, fm = gid * WGM, gsz = (nM - fm) < WGM ? (nM - fm) : WGM;
        u.pm = fm + ((wgid % nig) % gsz); u.pn = (wgid % nig) / gsz; return true;
    }
    __device__ __forceinline__ void a_ready(const Unit&) const {}
    __device__ __forceinline__ void done(const Unit&) const {}
};

__device__ __forceinline__ unsigned cvt_pk_bf16(float lo, float hi) { unsigned r; asm volatile("v_cvt_pk_bf16_f32 %0, %1, %2" : "=v"(r) : "v"(lo), "v"(hi)); return r; }
typedef float f32x2 __attribute__((ext_vector_type(2)));
__device__ __forceinline__ f32x2 gelu_pk(f32x2 v) {
    const f32x2 av = __builtin_elementwise_abs(v), d = av * 0.2316418882f + 1.0f;
    f32x2 t; t.x = __builtin_amdgcn_rcpf(d.x); t.y = __builtin_amdgcn_rcpf(d.y);
    f32x2 q = t * 0.5307027145f + (-0.7265760135f); q = q * t + 0.7107068705f; q = q * t + (-0.142248368f); q = q * t + 0.127414796f; q = q * t;
    const f32x2 s = (v * v) * (-0.72134752044f);
    f32x2 e; e.x = __builtin_amdgcn_exp2f(s.x); e.y = __builtin_amdgcn_exp2f(s.y);
    const f32x2 m = v * (q * e), r = v - m;
    f32x2 o; o.x = v.x < 0.f ? m.x : r.x; o.y = v.y < 0.f ? m.y : r.y; return o;
}

template <int ACT  > struct EpiBf16 {
    static constexpr bool PERM = true, AFTER_DRAIN = false; static_assert(ACT == 0 || ACT == 1, "EpiBf16: ACT is 0 (none) or 1 (gelu_pk)");
    bf16_t* O; int ldc; const float* bias; int split_cols; size_t split_stride; float scale0;
    __device__ __forceinline__ void operator()(const f32x4 (&acc)[2][2][4][2], const Unit& u, int wr, int wc, int fr, int fq) const {
        const int row0 = u.pm * BM + wr * 64 + fr; int colt = u.pn * BM; bf16_t* base = O;
        float sc = 1.f; if (split_cols) { const int t = colt / split_cols; base += (size_t)t * split_stride; colt -= t * split_cols; if (t == 0) sc = scale0; }
        const int col0 = colt + wc * 32 + 8 * fq, bcol0 = u.pn * BM + wc * 32 + 8 * fq;
        f32x4 bv[2][2];
#pragma unroll
        for (int bj = 0; bj < 2; ++bj)
#pragma unroll
            for (int n = 0; n < 2; ++n) bv[bj][n] = bias ? *(const f32x4*)(bias + bcol0 + bj * HALF + 4 * n) : (f32x4){0.f, 0.f, 0.f, 0.f};
#pragma unroll
        for (int ai = 0; ai < 2; ++ai)
#pragma unroll
            for (int m = 0; m < 4; ++m) { bf16_t* rowp = base + (size_t)(row0 + ai * HALF + m * 16) * ldc + col0;
#pragma unroll
                for (int bj = 0; bj < 2; ++bj) { f32x4 v0 = acc[ai][bj][m][0] + bv[bj][0], v1 = acc[ai][bj][m][1] + bv[bj][1];
                    if (ACT == 1) { f32x2 a = gelu_pk((f32x2){v0[0], v0[1]}), b = gelu_pk((f32x2){v0[2], v0[3]}), c = gelu_pk((f32x2){v1[0], v1[1]}), d = gelu_pk((f32x2){v1[2], v1[3]});
                        v0 = (f32x4){a.x, a.y, b.x, b.y}; v1 = (f32x4){c.x, c.y, d.x, d.y}; }
                    v0 = v0 * sc; v1 = v1 * sc; u32x4 w; w.x = cvt_pk_bf16(v0[0], v0[1]); w.y = cvt_pk_bf16(v0[2], v0[3]); w.z = cvt_pk_bf16(v1[0], v1[1]); w.w = cvt_pk_bf16(v1[2], v1[3]);
                    *(u32x4*)(rowp + bj * HALF) = w; } }
    }
};
template <class Epi, class Sched, bool ALIGN_EPI = false, bool SP2 = false>
__device__ __forceinline__ void gemm_phase(PG8_LAS unsigned char* lds, const Gemm g, const Sched& S, const Epi& E, int tid_in) {
    const int tid = tid_in, wid = __builtin_amdgcn_readfirstlane(tid >> 6), lane = tid & 63, wr = wid >> 2, wc = wid & 3, fr = lane & 15, fq = lane >> 4;
    const int K = g.K, nt = K / BK;
    unsigned voffA[2], voffB[2];
#pragma unroll
    for (int i = 0; i < 2; ++i) { int R, C; stage_rc(tid * 16 + i * 8192, R, C); const int Rb = Epi::PERM ? ((R & ~31) + perm32(R & 31)) : R;
        voffA[i] = (unsigned)(R * BK + C) * 2u; voffB[i] = (unsigned)(Rb * BK + C) * 2u; }
    const size_t kstep = (size_t)(HALF * BK * 2);
    const size_t hstep = (size_t)HALF * K * 2;
    const size_t tstep = 2 * hstep;
    const unsigned ldsw = (unsigned)wid * 1024u;
    const int aoff = lds_byte(wr * 64 + fr, fq * 8), boff = lds_byte(wc * 32 + fr, fq * 8);
#define PG8_SA(b, h) (((b) * 2 + (h)) * HTB)
#define PG8_SB(b, h) ((4 + (b) * 2 + (h)) * HTB)
#define PG8_STAGE(bufoff, gbase, voff) do { _Pragma("unroll") for (int _i = 0; _i < 2; ++_i) \
        __builtin_amdgcn_global_load_lds((const unsigned*)((const char*)(gbase) + (voff)[_i]), (PG8_LAS unsigned*)(lds + (bufoff) + ldsw + _i * 8192), 16, 0, 0); } while (0)
#define PG8_LDA(dst, b, h) do { _Pragma("unroll") for (int m = 0; m < 4; ++m) _Pragma("unroll") for (int k = 0; k < 2; ++k) dst[m][k] = *(const PG8_LAS bf16x8*)(lds + PG8_SA(b, h) + aoff + m * 2048 + k * 1024); } while (0)
#define PG8_LDB(dst, b, h) do { _Pragma("unroll") for (int n = 0; n < 2; ++n) _Pragma("unroll") for (int k = 0; k < 2; ++k) dst[n][k] = *(const PG8_LAS bf16x8*)(lds + PG8_SB(b, h) + boff + n * 2048 + k * 1024); } while (0)
#define PG8_MMA(ai, bj, At, Bt) do { __builtin_amdgcn_s_setprio(1); _Pragma("unroll") for (int m = 0; m < 4; ++m) _Pragma("unroll") for (int n = 0; n < 2; ++n) _Pragma("unroll") for (int k = 0; k < 2; ++k) \
        acc[ai][bj][m][n] = __builtin_amdgcn_mfma_f32_16x16x32_bf16(Bt[n][k], At[m][k], acc[ai][bj][m][n], 0, 0, 0); __builtin_amdgcn_s_setprio(0); } while (0)
#define PG8_WAIT_V(n) asm volatile("s_waitcnt vmcnt(" #n ")" ::: "memory")
#define PG8_WAIT_L(n) asm volatile("s_waitcnt lgkmcnt(" #n ")" ::: "memory")
#define PG8_BAR __builtin_amdgcn_s_barrier()
#define PG8_SCHED __builtin_amdgcn_sched_barrier(0)
    Unit cur, nxt; int ui = 0;
    if (!S.next(0, cur)) return;
    f32x4 acc[2][2][4][2];
#pragma unroll
    for (int a = 0; a < 2; ++a)
#pragma unroll
        for (int b = 0; b < 2; ++b)
#pragma unroll
            for (int m = 0; m < 4; ++m)
#pragma unroll
                for (int n = 0; n < 2; ++n) acc[a][b][m][n] = (f32x4){0.f, 0.f, 0.f, 0.f};
    bf16x8 At[4][2], B0[2][2], B1[2][2];
    const char* cA = (const char*)g.A + (size_t)cur.pm * tstep; const char* cB = (const char*)g.Bt + (size_t)cur.pn * tstep;
    S.a_ready(cur);
    if constexpr (SP2) {
        PG8_STAGE(PG8_SB(0, 0), cB, voffB); PG8_STAGE(PG8_SB(0, 1), cB + hstep, voffB); PG8_STAGE(PG8_SA(0, 0), cA, voffA); PG8_STAGE(PG8_SA(0, 1), cA + hstep, voffA);
        if (wr == 1) PG8_BAR;
        PG8_WAIT_V(2); PG8_BAR;
        PG8_STAGE(PG8_SB(1, 0), cB + kstep, voffB); PG8_STAGE(PG8_SA(1, 0), cA + kstep, voffA); PG8_STAGE(PG8_SB(1, 1), cB + hstep + kstep, voffB);
        PG8_WAIT_V(6); PG8_BAR;
    } else {
        PG8_STAGE(PG8_SB(0, 0), cB, voffB); PG8_STAGE(PG8_SA(0, 0), cA, voffA); PG8_STAGE(PG8_SB(0, 1), cB + hstep, voffB); PG8_STAGE(PG8_SA(0, 1), cA + hstep, voffA);
        if (wr == 1) PG8_BAR;
        PG8_WAIT_V(4); PG8_BAR;
        PG8_STAGE(PG8_SB(1, 0), cB + kstep, voffB); PG8_STAGE(PG8_SA(1, 0), cA + kstep, voffA); PG8_STAGE(PG8_SB(1, 1), cB + hstep + kstep, voffB);
        PG8_WAIT_V(6); PG8_BAR;
    }
    for (;;) {
        const bool has_next = S.next(ui + 1, nxt);
        const char* nA = has_next ? (const char*)g.A + (size_t)nxt.pm * tstep : cA; const char* nB = has_next ? (const char*)g.Bt + (size_t)nxt.pn * tstep : cB;
        for (int t = 0; t < nt; t += 2) {
            const bool last = (t == nt - 2);
            const char* a1 = cA + (size_t)(t + 1) * kstep;
            const char* a2 = last ? nA : cA + (size_t)(t + 2) * kstep; const char* b2 = last ? nB : cB + (size_t)(t + 2) * kstep;
            const char* a3 = a2 + kstep; const char* b3 = b2 + kstep;
            if (last && has_next) S.a_ready(nxt);
            if constexpr (SP2) {
            PG8_LDB(B0, 0, 0); PG8_LDB(B1, 0, 1); PG8_SCHED; PG8_LDA(At, 0, 0); PG8_STAGE(PG8_SA(1, 1), a1 + hstep, voffA);
            PG8_WAIT_V(8); PG8_WAIT_L(0); PG8_BAR; PG8_MMA(0, 0, At, B0); PG8_MMA(0, 1, At, B1); PG8_BAR; PG8_SCHED;
            PG8_LDA(At, 0, 1); PG8_STAGE(PG8_SB(0, 0), b2, voffB); PG8_STAGE(PG8_SB(0, 1), b2 + hstep, voffB); PG8_STAGE(PG8_SA(0, 0), a2, voffA);
            PG8_WAIT_V(8); PG8_WAIT_L(0); PG8_BAR; PG8_MMA(1, 0, At, B0); PG8_MMA(1, 1, At, B1); PG8_BAR; PG8_SCHED;
            PG8_LDB(B0, 1, 0); PG8_LDB(B1, 1, 1); PG8_SCHED; PG8_LDA(At, 1, 0); PG8_STAGE(PG8_SA(0, 1), a2 + hstep, voffA);
            PG8_WAIT_V(8); PG8_WAIT_L(0); PG8_BAR; PG8_MMA(0, 0, At, B0); PG8_MMA(0, 1, At, B1); PG8_BAR; PG8_SCHED;
            PG8_LDA(At, 1, 1); PG8_STAGE(PG8_SB(1, 0), b3, voffB); PG8_STAGE(PG8_SB(1, 1), b3 + hstep, voffB); PG8_STAGE(PG8_SA(1, 0), a3, voffA);
            PG8_WAIT_V(8); PG8_WAIT_L(0); PG8_BAR; PG8_MMA(1, 0, At, B0); PG8_MMA(1, 1, At, B1); PG8_BAR; PG8_SCHED;
            } else {
            PG8_LDB(B0, 0, 0); PG8_SCHED; PG8_LDA(At, 0, 0); PG8_STAGE(PG8_SA(1, 1), a1 + hstep, voffA);
            PG8_WAIT_L(8); PG8_BAR; PG8_WAIT_L(0); PG8_MMA(0, 0, At, B0); PG8_BAR; PG8_SCHED;
            PG8_LDB(B1, 0, 1); PG8_STAGE(PG8_SB(0, 0), b2, voffB);
            PG8_BAR; PG8_WAIT_L(0); PG8_MMA(0, 1, At, B1); PG8_BAR;
            PG8_LDA(At, 0, 1); PG8_STAGE(PG8_SA(0, 0), a2, voffA);
            PG8_BAR; PG8_WAIT_L(0); PG8_MMA(1, 0, At, B0); PG8_BAR; PG8_SCHED;
            PG8_STAGE(PG8_SB(0, 1), b2 + hstep, voffB);
            PG8_WAIT_V(6); PG8_BAR; PG8_MMA(1, 1, At, B1); PG8_BAR;
            PG8_LDB(B0, 1, 0); PG8_SCHED; PG8_LDA(At, 1, 0); PG8_STAGE(PG8_SA(0, 1), a2 + hstep, voffA);
            PG8_WAIT_L(8); PG8_BAR; PG8_WAIT_L(0); PG8_MMA(0, 0, At, B0); PG8_BAR; PG8_SCHED;
            PG8_LDB(B1, 1, 1); PG8_STAGE(PG8_SB(1, 0), b3, voffB);
            PG8_BAR; PG8_WAIT_L(0); PG8_MMA(0, 1, At, B1); PG8_BAR;
            PG8_LDA(At, 1, 1); PG8_STAGE(PG8_SA(1, 0), a3, voffA);
            PG8_BAR; PG8_WAIT_L(0); PG8_MMA(1, 0, At, B0); PG8_BAR; PG8_SCHED;
            PG8_STAGE(PG8_SB(1, 1), b3 + hstep, voffB);
            PG8_WAIT_V(6); PG8_BAR; PG8_MMA(1, 1, At, B1); PG8_BAR;
            }
        }
        if constexpr (ALIGN_EPI) { if (wr == 0) PG8_BAR; }
        if constexpr (!Epi::AFTER_DRAIN) { E(acc, cur, wr, wc, fr, fq); S.done(cur); }
        if (!has_next) break;
#pragma unroll
        for (int a = 0; a < 2; ++a)
#pragma unroll
            for (int b = 0; b < 2; ++b)
#pragma unroll
                for (int m = 0; m < 4; ++m)
#pragma unroll
                    for (int n = 0; n < 2; ++n) acc[a][b][m][n] = (f32x4){0.f, 0.f, 0.f, 0.f};
        cur = nxt; cA = nA; cB = nB; ++ui;
        if constexpr (ALIGN_EPI) { if (wr == 1) PG8_BAR; }
    }
    PG8_WAIT_V(0);
    if constexpr (!ALIGN_EPI) { if (wr == 0) PG8_BAR; }
    PG8_BAR;
    if constexpr (Epi::AFTER_DRAIN) { E.fused(acc, cur, wr, wc, fr, fq, lds, wid, lane); S.done(cur); }
#undef PG8_SA
#undef PG8_SB
#undef PG8_STAGE
#undef PG8_LDA
#undef PG8_LDB
#undef PG8_MMA
#undef PG8_WAIT_V
#undef PG8_WAIT_L
#undef PG8_BAR
#undef PG8_SCHED
}
}
namespace pg8 {
constexpr int TAB_OFF = 131072 + 256, TAB_SLOTS = 6;
__device__ __forceinline__ int tab_slot(PG8_LAS const unsigned char* tab, const Unit& u) { const PG8_LAS int* tags = (const PG8_LAS int*)tab; const int tag = (u.pm << 8) | u.pn; int slot = 0;
#pragma unroll
    for (int i = 1; i < TAB_SLOTS; ++i) if (tags[i] == tag) slot = i;
    return slot; }
constexpr int NBIAS = 28672;
typedef unsigned u32x2 __attribute__((ext_vector_type(2)));
__device__ __forceinline__ float silu_f(float x) { return x * __builtin_amdgcn_rcpf(1.0f + __builtin_amdgcn_exp2f(-1.4426950408889634f * x)); }
__device__ __forceinline__ void row_rstd8(const float* ssq, int row0, int fq, float (&rstd)[2][4]) {
    f32x4 p[2][4][2];
#pragma unroll
    for (int ai = 0; ai < 2; ++ai)
#pragma unroll
        for (int m = 0; m < 4; ++m) { const float* q = ssq + (size_t)(row0 + ai * HALF + m * 16) * 32 + fq * 8; p[ai][m][0] = *(const f32x4*)q; p[ai][m][1] = *(const f32x4*)(q + 4); }
#pragma unroll
    for (int ai = 0; ai < 2; ++ai)
#pragma unroll
        for (int m = 0; m < 4; ++m) { float t = ((p[ai][m][0][0] + p[ai][m][0][1]) + (p[ai][m][0][2] + p[ai][m][0][3])) + ((p[ai][m][1][0] + p[ai][m][1][1]) + (p[ai][m][1][2] + p[ai][m][1][3]));
            t += __shfl_xor(t, 16); t += __shfl_xor(t, 32); rstd[ai][m] = 1.0f / sqrtf(t * (1.0f / 2048.0f) + 1e-6f); }
}
struct EpiGeluStats {
    static constexpr bool PERM = true, AFTER_DRAIN = false;
    bf16_t* O; int ldc; PG8_LAS const unsigned char* tab; float* stats;
    __device__ __forceinline__ void operator()(const f32x4 (&acc)[2][2][4][2], const Unit& u, int wr, int wc, int fr, int fq) const {
        const int row0 = u.pm * BM + wr * 64 + fr; const int col0 = u.pn * BM + wc * 32 + 8 * fq;
        const PG8_LAS float* bT = (const PG8_LAS float*)(tab + 64 + TAB_SLOTS * 1024) + tab_slot(tab, u) * 256;
        f32x4 bv[2][2];
#pragma unroll
        for (int bj = 0; bj < 2; ++bj)
#pragma unroll
            for (int n = 0; n < 2; ++n) bv[bj][n] = *(const PG8_LAS f32x4*)(bT + bj * HALF + wc * 32 + 8 * fq + 4 * n);
#pragma unroll
        for (int ai = 0; ai < 2; ++ai)
#pragma unroll
            for (int m = 0; m < 4; ++m) { const int row = row0 + ai * HALF + m * 16; bf16_t* rowp = O + (size_t)row * ldc + col0; float s1 = 0.f, s2 = 0.f;
#pragma unroll
                for (int bj = 0; bj < 2; ++bj) { f32x4 v0 = acc[ai][bj][m][0] + bv[bj][0], v1 = acc[ai][bj][m][1] + bv[bj][1];
                    f32x2 a = gelu_pk((f32x2){v0[0], v0[1]}), b = gelu_pk((f32x2){v0[2], v0[3]}), c = gelu_pk((f32x2){v1[0], v1[1]}), d = gelu_pk((f32x2){v1[2], v1[3]});
                    s1 += ((a.x + a.y) + (b.x + b.y)) + ((c.x + c.y) + (d.x + d.y));
                    s2 += ((a.x * a.x + a.y * a.y) + (b.x * b.x + b.y * b.y)) + ((c.x * c.x + c.y * c.y) + (d.x * d.x + d.y * d.y));
                    u32x4 w; w.x = cvt_pk_bf16(a.x, a.y); w.y = cvt_pk_bf16(b.x, b.y); w.z = cvt_pk_bf16(c.x, c.y); w.w = cvt_pk_bf16(d.x, d.y);
                    *(u32x4*)(rowp + bj * HALF) = w; }
                if (u.pn >= 8) { s1 += __shfl_xor(s1, 16); s1 += __shfl_xor(s1, 32); s2 += __shfl_xor(s2, 16); s2 += __shfl_xor(s2, 32);
                    if (fq == 0) *(f32x2*)(stats + ((size_t)row * 32 + (u.pn - 8) * 4 + wc) * 2) = (f32x2){s1, s2}; } }
    }
};
struct EpiSwiGLU {
    static constexpr bool PERM = true, AFTER_DRAIN = false;
    bf16_t* O; int ldc; PG8_LAS const unsigned char* tab;
    __device__ __forceinline__ void operator()(const f32x4 (&acc)[2][2][4][2], const Unit& u, int wr, int wc, int fr, int fq) const {
        const int row0 = u.pm * BM + wr * 64 + fr; const int col0 = u.pn * HALF + wc * 32 + 8 * fq;
        const int slot = tab_slot(tab, u);
        const PG8_LAS float* rT = (const PG8_LAS float*)(tab + 64) + slot * 256; const PG8_LAS float* bT = (const PG8_LAS float*)(tab + 64 + TAB_SLOTS * 1024) + slot * 256;
        float rstd[2][4];
#pragma unroll
        for (int ai = 0; ai < 2; ++ai)
#pragma unroll
            for (int m = 0; m < 4; ++m) rstd[ai][m] = rT[ai * HALF + wr * 64 + m * 16 + fr];
        f32x4 bv[2][2];
#pragma unroll
        for (int bj = 0; bj < 2; ++bj)
#pragma unroll
            for (int n = 0; n < 2; ++n) bv[bj][n] = *(const PG8_LAS f32x4*)(bT + bj * HALF + wc * 32 + 8 * fq + 4 * n);
#pragma unroll
        for (int ai = 0; ai < 2; ++ai)
#pragma unroll
            for (int m = 0; m < 4; ++m) { bf16_t* rowp = O + tidx(row0 + ai * HALF + m * 16, col0, ldc); const float rs = rstd[ai][m];
                const f32x4 g0 = acc[ai][0][m][0] * rs + bv[0][0], g1 = acc[ai][0][m][1] * rs + bv[0][1], u0 = acc[ai][1][m][0] * rs + bv[1][0], u1 = acc[ai][1][m][1] * rs + bv[1][1];
                u32x4 w; w.x = cvt_pk_bf16(silu_f(g0[0]) * u0[0], silu_f(g0[1]) * u0[1]); w.y = cvt_pk_bf16(silu_f(g0[2]) * u0[2], silu_f(g0[3]) * u0[3]);
                w.z = cvt_pk_bf16(silu_f(g1[0]) * u1[0], silu_f(g1[1]) * u1[1]); w.w = cvt_pk_bf16(silu_f(g1[2]) * u1[2], silu_f(g1[3]) * u1[3]);
                *(u32x4*)rowp = w; }
    }
};
template <bool NTB> struct EpiResNorm {
    static constexpr bool PERM = false, AFTER_DRAIN = false;
    const float* base; float* out; const float* gate; int gate_bstride; int ldc;
    const float* gam1; bf16_t* A1; const float* gam2; bf16_t* A2; float* ssq;
    __device__ __forceinline__ void operator()(f32x4 (&acc)[2][2][4][2], const Unit& u, int wr, int wc, int fr, int fq) const {
        const int row0 = u.pm * BM + wr * 64 + fr; const int col0 = u.pn * BM + wc * 32 + 4 * fq; const int b = u.pm >> 4;
        f32x4 gv[2][2], g1[2][2];
#pragma unroll
        for (int bj = 0; bj < 2; ++bj)
#pragma unroll
            for (int n = 0; n < 2; ++n) { gv[bj][n] = *(const f32x4*)(gate + (size_t)b * gate_bstride + col0 + bj * HALF + n * 16);
                g1[bj][n] = gam1 ? *(const f32x4*)(gam1 + (size_t)b * 2048 + col0 + bj * HALF + n * 16) : (f32x4){0.f, 0.f, 0.f, 0.f}; }
#pragma unroll
        for (int ai = 0; ai < 2; ++ai)
#pragma unroll
            for (int mh = 0; mh < 2; ++mh) { f32x4 t[2][2][2];
#pragma unroll
                for (int mm = 0; mm < 2; ++mm) { const size_t off = (size_t)(row0 + ai * HALF + (2 * mh + mm) * 16) * ldc + col0;
#pragma unroll
                    for (int bj = 0; bj < 2; ++bj)
#pragma unroll
                        for (int n = 0; n < 2; ++n) { if constexpr (NTB) t[mm][bj][n] = __builtin_nontemporal_load((const f32x4*)(base + off + bj * HALF + n * 16)); else t[mm][bj][n] = *(const f32x4*)(base + off + bj * HALF + n * 16); } }
#pragma unroll
                for (int mm = 0; mm < 2; ++mm) { const int m = 2 * mh + mm; const int row = row0 + ai * HALF + m * 16; const size_t off = (size_t)row * ldc + col0;
#pragma unroll
                    for (int bj = 0; bj < 2; ++bj)
#pragma unroll
                        for (int n = 0; n < 2; ++n) { acc[ai][bj][m][n] = t[mm][bj][n] + acc[ai][bj][m][n] * gv[bj][n]; *(f32x4*)(out + off + bj * HALF + n * 16) = acc[ai][bj][m][n]; }
                    if (gam1) { float ss = 0.f;
#pragma unroll
                        for (int bj = 0; bj < 2; ++bj)
#pragma unroll
                            for (int n = 0; n < 2; ++n) { const f32x4 x = acc[ai][bj][m][n]; ss += (x[0] * x[0] + x[1] * x[1]) + (x[2] * x[2] + x[3] * x[3]);
                                const f32x4 y = x * g1[bj][n]; u32x2 w; w.x = cvt_pk_bf16(y[0], y[1]); w.y = cvt_pk_bf16(y[2], y[3]); *(u32x2*)(A1 + tidx(row, col0 + bj * HALF + n * 16, 2048)) = w; }
                        ss += __shfl_xor(ss, 16); ss += __shfl_xor(ss, 32);
                        if (fq == 0) ssq[(size_t)row * 32 + u.pn * 4 + wc] = ss; } } }
        if (gam2) {
#pragma unroll
            for (int bj = 0; bj < 2; ++bj)
#pragma unroll
                for (int n = 0; n < 2; ++n) g1[bj][n] = *(const f32x4*)(gam2 + (size_t)b * 2048 + col0 + bj * HALF + n * 16);
#pragma unroll
            for (int ai = 0; ai < 2; ++ai)
#pragma unroll
                for (int m = 0; m < 4; ++m) { const int row = row0 + ai * HALF + m * 16;
#pragma unroll
                    for (int bj = 0; bj < 2; ++bj)
#pragma unroll
                        for (int n = 0; n < 2; ++n) { const f32x4 y = acc[ai][bj][m][n] * g1[bj][n]; u32x2 w; w.x = cvt_pk_bf16(y[0], y[1]); w.y = cvt_pk_bf16(y[2], y[3]); *(u32x2*)(A2 + tidx(row, col0 + bj * HALF + n * 16, 2048)) = w; } } }
    }
};
struct EpiQKRope {
    static constexpr bool PERM = false, AFTER_DRAIN = true;
    bf16_t* O; const float* g; const float* rt; const float* ssq; const float* bias;
    __device__ __forceinline__ void fused(f32x4 (&acc)[2][2][4][2], const Unit& u, int wr, int wc, int fr, int fq, PG8_LAS unsigned char* lds, int wid, int lane) const {
        PG8_LAS float* P = (PG8_LAS float*)lds;
        { float rstd[2][4]; row_rstd8(ssq, u.pm * BM + wr * 64 + fr, fq, rstd);
#pragma unroll
          for (int bj = 0; bj < 2; ++bj)
#pragma unroll
            for (int n = 0; n < 2; ++n) { const f32x4 bv = *(const f32x4*)(bias + (size_t)(u.pm >> 4) * NBIAS + u.pn * BM + bj * HALF + wc * 32 + 16 * n + 4 * fq);
#pragma unroll
                for (int ai = 0; ai < 2; ++ai)
#pragma unroll
                    for (int m = 0; m < 4; ++m) acc[ai][bj][m][n] = acc[ai][bj][m][n] * rstd[ai][m] + bv; } }
#pragma unroll
        for (int ai = 0; ai < 2; ++ai)
#pragma unroll
            for (int m = 0; m < 4; ++m)
#pragma unroll
                for (int bj = 0; bj < 2; ++bj) { const f32x4 a = acc[ai][bj][m][0], c = acc[ai][bj][m][1];
                    float ss = ((a[0] * a[0] + a[1] * a[1]) + (a[2] * a[2] + a[3] * a[3])) + ((c[0] * c[0] + c[1] * c[1]) + (c[2] * c[2] + c[3] * c[3]));
                    ss += __shfl_xor(ss, 16); ss += __shfl_xor(ss, 32);
                    if (fq == 0) P[((ai * HALF + wr * 64 + m * 16 + fr) * 2 + bj) * 4 + wc] = ss; }
        asm volatile("s_waitcnt lgkmcnt(0)" ::: "memory"); __builtin_amdgcn_s_barrier(); asm volatile("" ::: "memory");
        const int d = 16 * wc + 4 * fq; const f32x4 ga = *(const f32x4*)(g + d), gb = *(const f32x4*)(g + 64 + d);
#pragma unroll
        for (int ai = 0; ai < 2; ++ai)
#pragma unroll
            for (int m = 0; m < 4; ++m) { const int rl = ai * HALF + wr * 64 + m * 16 + fr, row = u.pm * BM + rl, b = row >> 12, s = row & 4095;
                const f32x4 cs0 = *(const f32x4*)(rt + ((size_t)row * 64 + d) * 2), cs1 = *(const f32x4*)(rt + ((size_t)row * 64 + d) * 2 + 4);
                const float co[4] = {cs0[0], cs0[2], cs1[0], cs1[2]}, si[4] = {cs0[1], cs0[3], cs1[1], cs1[3]};
#pragma unroll
                for (int bj = 0; bj < 2; ++bj) { const f32x4 pp = *(const PG8_LAS f32x4*)(P + (rl * 2 + bj) * 4);
                    const float rstd = 1.0f / sqrtf(((pp[0] + pp[1]) + (pp[2] + pp[3])) * (1.0f / 128.0f) + 1e-6f);
                    const f32x4 x1 = acc[ai][bj][m][0] * rstd * ga, x2 = acc[ai][bj][m][1] * rstd * gb; float o1[4], o2[4];
#pragma unroll
                    for (int i = 0; i < 4; ++i) { o1[i] = x1[i] * co[i] - x2[i] * si[i]; o2[i] = x2[i] * co[i] + x1[i] * si[i]; }
                    bf16_t* op = O + ((size_t)(b * 16 + 2 * u.pn + bj) * 4096 + s) * 128 + d;
                    u32x2 w1, w2; w1.x = cvt_pk_bf16(o1[0], o1[1]); w1.y = cvt_pk_bf16(o1[2], o1[3]); w2.x = cvt_pk_bf16(o2[0], o2[1]); w2.y = cvt_pk_bf16(o2[2], o2[3]);
                    *(u32x2*)op = w1; *(u32x2*)(op + 64) = w2; } }
        asm volatile("s_waitcnt lgkmcnt(0)" ::: "memory"); __builtin_amdgcn_s_barrier(); asm volatile("" ::: "memory");
    }
};
struct EpiVhead {
    static constexpr bool PERM = true, AFTER_DRAIN = false;
    bf16_t* O; const float* ssq; const float* bias;
    __device__ __forceinline__ void operator()(const f32x4 (&acc)[2][2][4][2], const Unit& u, int wr, int wc, int fr, int fq) const {
        const int row0 = u.pm * BM + wr * 64 + fr;
        float rstd[2][4]; row_rstd8(ssq, row0, fq, rstd);
        f32x4 bv[2][2];
#pragma unroll
        for (int bj = 0; bj < 2; ++bj)
#pragma unroll
            for (int n = 0; n < 2; ++n) bv[bj][n] = *(const f32x4*)(bias + (size_t)(u.pm >> 4) * NBIAS + u.pn * BM + bj * HALF + wc * 32 + 8 * fq + 4 * n);
#pragma unroll
        for (int ai = 0; ai < 2; ++ai)
#pragma unroll
            for (int m = 0; m < 4; ++m) { const int row = row0 + ai * HALF + m * 16, b = row >> 12, s = row & 4095; const float rs = rstd[ai][m];
#pragma unroll
                for (int bj = 0; bj < 2; ++bj) { bf16_t* p = O + ((size_t)(b * 16 + 2 * u.pn + bj) * 4096 + s) * 128 + wc * 32 + 8 * fq;
                    const f32x4 v0 = acc[ai][bj][m][0] * rs + bv[bj][0], v1 = acc[ai][bj][m][1] * rs + bv[bj][1];
                    u32x4 w; w.x = cvt_pk_bf16(v0[0], v0[1]); w.y = cvt_pk_bf16(v0[2], v0[3]); w.z = cvt_pk_bf16(v1[0], v1[1]); w.w = cvt_pk_bf16(v1[2], v1[3]);
                    *(u32x4*)p = w; } }
    }
};
}
namespace att {
constexpr int D = 128; constexpr float THR = 8.f; constexpr bool WSKIP = false;
constexpr float SCALE = 0.08838834764831845f;
constexpr int NW = 8, QBLK = 32, KVBLK = 64, QB = NW * QBLK;
constexpr int SHM_V = KVBLK * D * 2, SHM_K = KVBLK * D * 2;
constexpr int LDS_BYTES = 2 * SHM_V + 2 * SHM_K + NW * 64 * 4;
using bf16 = __hip_bfloat16;
typedef short bf16x8 __attribute__((ext_vector_type(8)));
typedef short s16x4 __attribute__((ext_vector_type(4)));
typedef float f32x16 __attribute__((ext_vector_type(16)));
typedef float f32x4 __attribute__((ext_vector_type(4)));
typedef unsigned u32x4 __attribute__((ext_vector_type(4)));
template <class A, class Bt> struct same_t { static constexpr bool v = false; };
template <class A> struct same_t<A, A> { static constexpr bool v = true; };

#define KSWZ(row, colB) ((row) * 256 + ((colB) ^ (((row) & 7) << 4)))
#define SBAR() __builtin_amdgcn_sched_barrier(0)
__device__ __forceinline__ int v_st(int k, int c) { const int kk = (k & ~0xC) | ((k & 4) << 1) | ((k & 8) >> 1); return ((kk >> 3) * 4 + (c >> 5)) * 512 + ((kk & 7) * 32 + (c & 31)) * 2; }
__device__ __forceinline__ int v_rd_base(int lane) { return ((lane & 3) << 3) | (((lane >> 2) & 3) << 6) | (((lane >> 4) & 1) << 5) | (((lane >> 5) & 1) << 8); }
constexpr int v_rd_off(int d0, int ks, int half) { return d0 * 512 + ks * 4096 + half * 2048; }
__device__ __forceinline__ int crow(int r, int hi) { return (r & 3) + 8 * (r >> 2) + 4 * hi; }
__device__ __forceinline__ unsigned cvtpk(float lo, float hi) {
    unsigned r; asm volatile("v_cvt_pk_bf16_f32 %0, %1, %2" : "=v"(r) : "v"(lo), "v"(hi)); return r;
}
__device__ __forceinline__ bf16x8 pack8(f32x4 a, f32x4 b) {
    u32x4 w = {cvtpk(a[0], a[1]), cvtpk(a[2], a[3]), cvtpk(b[0], b[1]), cvtpk(b[2], b[3])};
    return *reinterpret_cast<bf16x8*>(&w);
}
template <class T> __device__ __forceinline__ bf16x8 load8(const T* p) {
    if constexpr (same_t<T, float>::v) { return pack8(*(const f32x4*)p, *(const f32x4*)(p + 4)); }
    else { return *reinterpret_cast<const bf16x8*>(p); }
}
__device__ __forceinline__ void mask_tile(f32x16& p0, f32x16& p1, int dq, unsigned W) {
    const float NEG = -__builtin_inff();
#pragma unroll
    for (int r = 0; r < 16; ++r) {
        const int c = (r & 3) + 8 * (r >> 2);
        if ((unsigned)(dq - c) >= W) p0[r] = NEG;
        if ((unsigned)(dq - c - 32) >= W) p1[r] = NEG;
    }
}
__device__ __forceinline__ void partialSM(f32x16& p0, f32x16& p1, float& m_reg, float& mn, float& alpha) {
    float pmax = p0[0]; for (int r = 1; r < 16; ++r) pmax = fmaxf(pmax, p0[r]); for (int r = 0; r < 16; ++r) pmax = fmaxf(pmax, p1[r]);
    { auto rr = __builtin_amdgcn_permlane32_swap(__float_as_uint(pmax), __float_as_uint(pmax), false, false);
      pmax = fmaxf(__uint_as_float(rr[0]), __uint_as_float(rr[1])); }
    constexpr float C2 = 1.4426950408889634f * SCALE;
    if (__builtin_expect(__all((pmax - m_reg) * SCALE <= THR), 1)) { mn = m_reg; alpha = 1.f; }
    else { mn = fmaxf(m_reg, pmax); alpha = __builtin_amdgcn_exp2f((m_reg - mn) * C2); m_reg = mn; }
    const float mnL = -mn * C2;
    for (int r = 0; r < 16; ++r) p0[r] = fmaf(p0[r], C2, mnL); for (int r = 0; r < 16; ++r) p1[r] = fmaf(p1[r], C2, mnL);
    for (int r = 0; r < 16; ++r) p0[r] = __builtin_amdgcn_exp2f(p0[r]);
}
__device__ __forceinline__ void finishSM(f32x16& p0, f32x16& p1, float alpha, float& l_reg, bf16x8& pa0, bf16x8& pa1, bf16x8& pa2, bf16x8& pa3) {
    for (int r = 0; r < 16; ++r) p1[r] = __builtin_amdgcn_exp2f(p1[r]);
    float ps = 0; for (int r = 0; r < 16; ++r) ps += p0[r]; for (int r = 0; r < 16; ++r) ps += p1[r];
    { auto rr = __builtin_amdgcn_permlane32_swap(__float_as_uint(ps), __float_as_uint(ps), false, false);
      ps = __uint_as_float(rr[0]) + __uint_as_float(rr[1]); }
    l_reg = l_reg * alpha + ps;
#define PK4(P, B_, OUT) do { unsigned a0 = cvtpk(P[B_+0], P[B_+1]), a1 = cvtpk(P[B_+2], P[B_+3]);                          \
        unsigned b0 = cvtpk(P[B_+4], P[B_+5]), b1 = cvtpk(P[B_+6], P[B_+7]);                                             \
        auto r0 = __builtin_amdgcn_permlane32_swap(a0, b0, false, false); auto r1 = __builtin_amdgcn_permlane32_swap(a1, b1, false, false); \
        u32x4 w = {r0[0], r1[0], r0[1], r1[1]}; OUT = *reinterpret_cast<bf16x8*>(&w); } while (0)
    PK4(p0, 0, pa0); PK4(p0, 8, pa1); PK4(p1, 0, pa2); PK4(p1, 8, pa3);
#undef PK4
}
template <int KB, bool SK>
__device__ __forceinline__ void qkt(f32x16& p0, f32x16& p1, const char* K_lds, int r32, int hi, const bf16x8* qr, bool act) {
    if (SK && !act) { const float NEG = -__builtin_inff();
#pragma unroll
        for (int r = 0; r < 16; ++r) { p0[r] = NEG; p1[r] = NEG; } return; }
    p0 = f32x16{}; p1 = f32x16{};
    const char* kb[4];
#pragma unroll
    for (int dd = 0; dd < 4; ++dd) kb[dd] = K_lds + KB * SHM_K + KSWZ(r32, (dd * 16 + hi * 8) * 2);
#pragma unroll
    for (int d0 = 0; d0 < 8; ++d0) { const char* a = kb[d0 & 3] + (d0 >> 2) * 128;
        bf16x8 b0 = *reinterpret_cast<const bf16x8*>(a);
        bf16x8 b1 = *reinterpret_cast<const bf16x8*>(a + 32 * 256);
        p0 = __builtin_amdgcn_mfma_f32_32x32x16_bf16(b0, qr[d0], p0, 0, 0, 0);
        p1 = __builtin_amdgcn_mfma_f32_32x32x16_bf16(b1, qr[d0], p1, 0, 0, 0); }
}
template <int VB, bool SK>
__device__ __forceinline__ void pv_tile(f32x16* o, int vb0, bf16x8 pa0, bf16x8 pa1, bf16x8 pa2, bf16x8 pa3, bool act) {
    if (SK && !act) return;
#define TRRD(dst, off) asm volatile("ds_read_b64_tr_b16 %0, %1 offset:%2" : "=&v"(dst) : "v"(vb0), "i"(off) : "memory")
#define PV_D0(d0) do { s16x4 l0, l1, l2, l3, h0, h1, h2, h3; constexpr int b_ = VB * SHM_V + v_rd_off(d0, 0, 0);     \
        TRRD(l0, b_); TRRD(h0, b_ + 2048); TRRD(l1, b_ + 4096); TRRD(h1, b_ + 6144); TRRD(l2, b_ + 8192); TRRD(h2, b_ + 10240); TRRD(l3, b_ + 12288); TRRD(h3, b_ + 14336); \
        asm volatile("s_waitcnt lgkmcnt(0)" ::: "memory"); SBAR();                 \
        o[d0] = __builtin_amdgcn_mfma_f32_32x32x16_bf16(pa0, (bf16x8){l0[0], l0[1], l0[2], l0[3], h0[0], h0[1], h0[2], h0[3]}, o[d0], 0, 0, 0);   \
        o[d0] = __builtin_amdgcn_mfma_f32_32x32x16_bf16(pa1, (bf16x8){l1[0], l1[1], l1[2], l1[3], h1[0], h1[1], h1[2], h1[3]}, o[d0], 0, 0, 0);   \
        o[d0] = __builtin_amdgcn_mfma_f32_32x32x16_bf16(pa2, (bf16x8){l2[0], l2[1], l2[2], l2[3], h2[0], h2[1], h2[2], h2[3]}, o[d0], 0, 0, 0);   \
        o[d0] = __builtin_amdgcn_mfma_f32_32x32x16_bf16(pa3, (bf16x8){l3[0], l3[1], l3[2], l3[3], h3[0], h3[1], h3[2], h3[3]}, o[d0], 0, 0, 0); } while (0)
    PV_D0(0); PV_D0(1); PV_D0(2); PV_D0(3);
#undef PV_D0
#undef TRRD
}

template <class TIn, class TOut> struct BlockRef { const TIn* Q; const TIn* K; const TIn* V; TOut* O; int P0; };
template <class TIn> struct Seam {
    bf16x8 qr[8];
    bf16x8 st_v0, st_v1, st_k0, st_k1; f32x4 sf0, sf1, sf2, sf3;
    f32x4 tq[16];
};
__device__ __forceinline__ int swa_jlo(int P0, int W) { const int lowk = P0 - W + 1; return lowk > 0 ? lowk / KVBLK : 0; }
#define ROW(p, k0, rr) ((p) + (size_t)((k0) + (rr)) * D + sc)
#define VMW() asm volatile("s_waitcnt vmcnt(0)" ::: "memory")
#define VMWN(n) asm volatile("s_waitcnt vmcnt(%0)" :: "i"(n) : "memory")
#define SLOAD_H(Kp, Vp, k0) do { S.st_v0 = load8<TIn>(ROW(Vp, k0, sr)); S.st_v1 = load8<TIn>(ROW(Vp, k0, 32 + sr));              \
                         S.st_k0 = load8<TIn>(ROW(Kp, k0, sr)); S.st_k1 = load8<TIn>(ROW(Kp, k0, 32 + sr)); } while (0)
#define SWRITE_HK(bf) do { *(bf16x8*)(K_lds + (bf) * SHM_K + kws) = S.st_k0; *(bf16x8*)(K_lds + (bf) * SHM_K + kws + 32 * 256) = S.st_k1; } while (0)
#define SWRITE_HV(bf) do { *(bf16x8*)(V_lds + (bf) * SHM_V + vst0) = S.st_v0; *(bf16x8*)(V_lds + (bf) * SHM_V + vst1) = S.st_v1; } while (0)
#define SWRITE_H(bf) do { SWRITE_HV(bf); SWRITE_HK(bf); } while (0)
#define SLOAD_F(p, k0) do { S.sf0 = *(const f32x4*)ROW(p, k0, sr); S.sf1 = *(const f32x4*)(ROW(p, k0, sr) + 4);                \
                            S.sf2 = *(const f32x4*)ROW(p, k0, 32 + sr); S.sf3 = *(const f32x4*)(ROW(p, k0, 32 + sr) + 4); } while (0)
#define SWRITE_KF(bf) do { *(bf16x8*)(K_lds + (bf) * SHM_K + kws) = pack8(S.sf0, S.sf1); *(bf16x8*)(K_lds + (bf) * SHM_K + kws + 32 * 256) = pack8(S.sf2, S.sf3); } while (0)
#define SWRITE_VF(bf) do { *(bf16x8*)(V_lds + (bf) * SHM_V + vst0) = pack8(S.sf0, S.sf1); *(bf16x8*)(V_lds + (bf) * SHM_V + vst1) = pack8(S.sf2, S.sf3); } while (0)
template <class TIn, class TOut>
__device__ __forceinline__ void causal_swa_prime(const BlockRef<TIn, TOut>& cur, int W, char* lds, Seam<TIn>& S, int tid_in) {
    constexpr bool F32 = same_t<TIn, float>::v;
    const int tid = tid_in, wid = __builtin_amdgcn_readfirstlane(tid >> 6), lane = tid & 63, r32 = lane & 31, hi = lane >> 5;
    const int sr = tid >> 4, sc = (tid & 15) * 8, kws = KSWZ(sr, sc * 2); char* K_lds = lds + 2 * SHM_V;
    const int kb0 = swa_jlo(cur.P0, W) * KVBLK;
    for (int d0 = 0; d0 < 8; ++d0) S.qr[d0] = load8<TIn>(cur.Q + (size_t)(wid * QBLK + r32) * D + d0 * 16 + hi * 8);
    if constexpr (F32) { SLOAD_F((const float*)cur.K, kb0); VMW(); SWRITE_KF(0); SBAR(); SLOAD_F((const float*)cur.V, kb0); }
    else { SLOAD_H(cur.K, cur.V, kb0); VMW(); SWRITE_HK(0); }
    __syncthreads();
}
template <class TIn, class TOut>
__device__ __forceinline__ void causal_swa_block(const BlockRef<TIn, TOut>& cur, const BlockRef<TIn, TOut>& nxt, int skv, int W, char* lds, Seam<TIn>& S, int tid_in) {
    constexpr bool F32 = same_t<TIn, float>::v;
    const int tid = tid_in, wid = __builtin_amdgcn_readfirstlane(tid >> 6), lane = tid & 63, r32 = lane & 31, hi = lane >> 5;
    const int j_lo = swa_jlo(cur.P0, W);
    int j_hi = (cur.P0 + QB - 1) / KVBLK + 1; if (j_hi > skv / KVBLK) j_hi = skv / KVBLK;
    const int NT = j_hi - j_lo;
    const int kbn = swa_jlo(nxt.P0, W) * KVBLK;
    const int qlo = cur.P0 + wid * QBLK, qm = qlo + r32 - 4 * hi;
    char* V_lds = lds; char* K_lds = lds + 2 * SHM_V;
    float* ws = (float*)(lds + 2 * SHM_V + 2 * SHM_K) + wid * 64; float* li_l = ws, * al_l = ws + 32;
    float m_reg = -1e30f, l_reg = 0; f32x16 o[4] = {};
    const int sr = tid >> 4, sc = (tid & 15) * 8, vst0 = v_st(sr, sc), vst1 = v_st(32 + sr, sc), kws = KSWZ(sr, sc * 2);
    const int vb0 = (int)(uintptr_t)V_lds + v_rd_base(lane);
    const TIn* Kh = cur.K; const TIn* Vh = cur.V;
#define RESC(a) do { if (__any((a) < 1.f)) { if (hi == 0) al_l[r32] = (a); asm volatile("s_waitcnt lgkmcnt(0)" ::: "memory");              \
                     for (int d_ = 0; d_ < 4; ++d_) for (int r = 0; r < 16; ++r) o[d_][r] *= al_l[crow(r, hi)]; } } while (0)
#define KBASE(t) ((j_lo + (t)) * KVBLK)
#define ACT(t) (KBASE(t) <= qlo + QBLK - 1 && KBASE(t) + KVBLK - 1 >= qlo - W + 1)
#define MASKT(P0_, P1_, t) do { const int kb_ = KBASE(t); if ((!SK || ACT(t)) && (kb_ + KVBLK - 1 > qlo || kb_ <= qlo + QBLK - 1 - W)) mask_tile(P0_, P1_, qm - kb_, (unsigned)W); } while (0)
    constexpr int NQL = F32 ? 16 : 8;
    constexpr bool SK = WSKIP && !F32;
#define SEAM_K0() do { VMWN(NQL); if constexpr (F32) { SWRITE_KF(0); SBAR(); SLOAD_F((const float*)nxt.V, kbn); } else { SWRITE_HK(0); } SBAR(); } while (0)
    f32x16 pA0, pA1, pB0, pB1; float mnA, mnB, alA, alB; bf16x8 pa0, pa1, pa2, pa3;
    if constexpr (F32) { VMW(); SWRITE_VF(0); SBAR(); } else { SWRITE_HV(0); SBAR(); }
    if (NT > 1) { if constexpr (F32) SLOAD_F((const float*)Kh, KBASE(1)); else SLOAD_H(Kh, Vh, KBASE(1)); }
    SBAR(); qkt<0, SK>(pA0, pA1, K_lds, r32, hi, S.qr, ACT(0));
    if constexpr (F32) { if (NT > 1) { VMW(); SWRITE_KF(1); SBAR(); SLOAD_F((const float*)Vh, KBASE(1)); } }
    MASKT(pA0, pA1, 0); partialSM(pA0, pA1, m_reg, mnA, alA);
    if (NT > 1) { VMW(); if constexpr (F32) { SWRITE_VF(1); SBAR(); if (NT > 2) SLOAD_F((const float*)Kh, KBASE(2)); } else SWRITE_H(1); }
    __syncthreads();
#define HALF_STEP(PX0, PX1, mnX, alX, PY0, PY1, alY, t, KB, VB, SB) do {                                                      \
        SBAR(); qkt<KB, SK>(PX0, PX1, K_lds, r32, hi, S.qr, ACT(t));                                             \
        finishSM(PY0, PY1, alY, l_reg, pa0, pa1, pa2, pa3); SBAR();                                                           \
        if ((t) + 1 < NT) { if constexpr (F32) { VMW(); SWRITE_KF(SB); SBAR(); SLOAD_F((const float*)Vh, KBASE((t) + 1)); }  \
                            else { SLOAD_H(Kh, Vh, KBASE((t) + 1)); } SBAR(); }                                               \
        pv_tile<VB, SK>(o, vb0, pa0, pa1, pa2, pa3, ACT((t) - 1)); MASKT(PX0, PX1, (t)); partialSM(PX0, PX1, m_reg, mnX, alX);                                        \
        __syncthreads();                                                                                                      \
        if ((t) + 1 < NT) { VMW(); if constexpr (F32) { SWRITE_VF(SB); SBAR(); if ((t) + 2 < NT) SLOAD_F((const float*)Kh, KBASE((t) + 2)); } \
                            else { SWRITE_H(SB); } }                                                                          \
        RESC(alX); __syncthreads(); } while (0)
    for (int t = 1; t + 1 < NT; t += 2) {
        HALF_STEP(pB0, pB1, mnB, alB, pA0, pA1, alA, t, 1, 0, 0);
        HALF_STEP(pA0, pA1, mnA, alA, pB0, pB1, alB, t + 1, 0, 1, 1);
    }
    const bool even = (NT & 1) == 0;
    if (even) { SBAR(); qkt<1, SK>(pB0, pB1, K_lds, r32, hi, S.qr, ACT(NT - 1)); SBAR(); }
#define QROW(e) (nxt.Q + (size_t)(wid * QBLK + r32) * D + ((e) >> 1) * 16 + hi * 8 + ((e) & 1) * 4)
    if constexpr (F32) { SLOAD_F((const float*)nxt.K, kbn); SBAR();
#pragma unroll
        for (int e = 0; e < 8; ++e) S.tq[e] = *(const f32x4*)QROW(e); }
    else { SLOAD_H(nxt.K, nxt.V, kbn); SBAR();
#pragma unroll
        for (int d0 = 0; d0 < 8; ++d0) S.qr[d0] = load8<TIn>(nxt.Q + (size_t)(wid * QBLK + r32) * D + d0 * 16 + hi * 8); }
    SBAR();
    finishSM(pA0, pA1, alA, l_reg, pa0, pa1, pa2, pa3); SBAR();
    if constexpr (F32) {
#pragma unroll
        for (int e = 8; e < 16; ++e) S.tq[e] = *(const f32x4*)QROW(e); SBAR(); }
#undef QROW
    pv_tile<0, SK>(o, vb0, pa0, pa1, pa2, pa3, ACT(even ? NT - 2 : NT - 1));
    if (even) { MASKT(pB0, pB1, NT - 1); partialSM(pB0, pB1, m_reg, mnB, alB); __syncthreads(); RESC(alB);
        finishSM(pB0, pB1, alB, l_reg, pa0, pa1, pa2, pa3); SBAR(); pv_tile<1, SK>(o, vb0, pa0, pa1, pa2, pa3, ACT(NT - 1)); }
    SBAR(); SEAM_K0();
    if (hi == 0) li_l[r32] = l_reg; asm volatile("s_waitcnt lgkmcnt(0)" ::: "memory");
    float rli[16];
#pragma unroll
    for (int r = 0; r < 16; ++r) rli[r] = __builtin_amdgcn_rcpf(li_l[crow(r, hi)]);
    TOut* Ow = cur.O + (size_t)(wid * QBLK) * D;
#pragma unroll
    for (int r = 0; r < 16; ++r) { const int orow = crow(r, hi);
#pragma unroll
        for (int d0 = 0; d0 < 4; ++d0) { const float v = o[d0][r] * rli[r];
            if constexpr (same_t<TOut, float>::v) { Ow[(size_t)orow * D + d0 * 32 + r32] = v; }
            else { const float vn = __shfl_xor(v, 1);
                   if ((r32 & 1) == 0) *(unsigned*)(Ow + (size_t)orow * D + d0 * 32 + r32) = cvtpk(v, vn); } } }
    if constexpr (F32) {
#pragma unroll
        for (int d0 = 0; d0 < 8; ++d0) S.qr[d0] = pack8(S.tq[2 * d0], S.tq[2 * d0 + 1]); }
    __syncthreads();
#undef RESC
#undef KBASE
#undef ACT
#undef MASKT
#undef SEAM_K0
#undef HALF_STEP
}
#undef ROW
#undef VMW
#undef VMWN
#undef SLOAD_H
#undef SWRITE_HK
#undef SWRITE_HV
#undef SWRITE_H
#undef SLOAD_F
#undef SWRITE_KF
#undef SWRITE_VF
}
#include <hip/hip_cooperative_groups.h>
namespace cg = cooperative_groups;
#ifndef MK_N_LAUNCHES
#define MK_N_LAUNCHES 1
#endif
constexpr int NWAVES = 8;
constexpr int BATCH = 2, SEQ = 4096, DM = 2048, M = BATCH * SEQ, DFF = 5632, NMOD = 28672;
constexpr int MOD_A = 0, MOD_KV = 12288, MOD_B = 16384;
constexpr float EPS = 1e-6f;
constexpr float LAM_INIT = 0.35550906759f;
constexpr size_t MiB = 1u << 20;
constexpr size_t WS_MODS = 1 * MiB, WS_RT = 2 * MiB, WS_STATS = 6 * MiB;
constexpr size_t WS_W_IN = 8 * MiB, WS_W_OUT = 24 * MiB, WS_W_FIA = 32 * MiB, WS_W_FOA = 76 * MiB, WS_W_KV = 98 * MiB, WS_W_Q = 114 * MiB, WS_W_O = 122 * MiB, WS_W_FIB = 130 * MiB, WS_W_FOB = 174 * MiB;
constexpr size_t WS_XA = 196 * MiB, WS_XB = 260 * MiB, WS_XN = 324 * MiB, WS_XQ = 356 * MiB, WS_A3 = 388 * MiB, WS_Z = 420 * MiB, WS_QRAW = 420 * MiB, WS_H = 484 * MiB, WS_KRAW = 484 * MiB;
constexpr size_t WS_O = 420 * MiB, WS_VB = 548 * MiB, WS_KB = 580 * MiB, WS_QB = 612 * MiB, WS_SSQ = 644 * MiB, WS_END = 646 * MiB;
constexpr size_t WS_GAM = WS_MODS + 256 * 1024, WS_BIAS = WS_MODS + 512 * 1024;
constexpr int OFF_FIA = 0, OFF_KV = 11264, OFF_Q = 15360, OFF_FIB = 17408;
constexpr int LDS_BYTES = 147456;

#define GAS __attribute__((address_space(1)))
#define LAS __attribute__((address_space(3)))
typedef unsigned short hb;
typedef unsigned v4u __attribute__((ext_vector_type(4)));
typedef unsigned v2u __attribute__((ext_vector_type(2)));
typedef float f32x4 __attribute__((ext_vector_type(4)));
typedef float f32x2 __attribute__((ext_vector_type(2)));
typedef short bf16x8 __attribute__((ext_vector_type(8)));
#define LDS_WAIT() asm volatile("s_waitcnt lgkmcnt(0)" ::: "memory")
__device__ __forceinline__ unsigned f2bf(float f) { unsigned u = __builtin_bit_cast(unsigned, f); return (u + 0x7fffu + ((u >> 16) & 1u)) >> 16; }
__device__ __forceinline__ unsigned pk2(float lo, float hi) { typedef float f2_t __attribute__((ext_vector_type(2))); typedef __bf16 b2_t __attribute__((ext_vector_type(2))); f2_t v = {lo, hi}; return __builtin_bit_cast(unsigned, __builtin_convertvector(v, b2_t)); }
__device__ __forceinline__ float bflo(unsigned w) { return __builtin_bit_cast(float, w << 16); }
__device__ __forceinline__ float bfhi(unsigned w) { return __builtin_bit_cast(float, w & 0xffff0000u); }
__device__ __forceinline__ float wave_sum(float v) {
#pragma unroll
    for (int o = 1; o < 64; o <<= 1) v += __shfl_xor(v, o);
    return v;
}

__device__ __forceinline__ int wt_rowmap(int n, int mode, int N, int rope_lim) {
    if (mode == 1) { const int half = N / 2; const int mm = n < half ? n : n - half; return 256 * (mm / 128) + (mm % 128) + (n < half ? 0 : 128); }
    if (mode == 2 && n < rope_lim) { const int d = n & 127; return (n & ~127) + 32 * ((d & 63) >> 4) + 16 * (d >> 6) + 4 * ((d & 15) >> 2) + (d & 3); }
    return n;
}
struct TrItem { const float* W; hb* WT; int K, N, mode, lim, k0, n0; };
__device__ __forceinline__ void tr_load(const TrItem& t, float (&tv)[32], int lane) {
#pragma unroll
    for (int i = 0; i < 32; ++i) { const int kk = 2 * i + (lane >> 5); tv[i] = __builtin_nontemporal_load(t.W + (size_t)(t.k0 + kk) * t.N + t.n0 + (lane & 31)); }
}

#define XB_TMO      128
#define XB_XCNT(j)  (256  + 64 * (j))
#define XB_XSUB(j)  (1280 + 64 * (j))
#define XB_XGEN(j)  (2304 + 64 * (j))
#define XB_TOP      3328
#define XB_TOPGEN   3392
#define XCD_BAR_WORDS 3456
#define XB_SPIN_CAP (1u << 18)

__device__ __forceinline__ unsigned xb_ld(unsigned* p)              { return __hip_atomic_load(p, __ATOMIC_RELAXED, __HIP_MEMORY_SCOPE_AGENT); }
__device__ __forceinline__ unsigned xb_add(unsigned* p, unsigned v) { return __hip_atomic_fetch_add(p, v, __ATOMIC_RELAXED, __HIP_MEMORY_SCOPE_AGENT); }
__device__ __forceinline__ unsigned xb_xcc_id() { return (unsigned)__builtin_amdgcn_s_getreg((3 << 11) | 20) & 0xFu; }
#define XB_SPIN(cond, bar) do { unsigned _sp = 0; while (cond) { __builtin_amdgcn_s_sleep(1); \
    if ((++_sp & 255u) == 0u) { if (xb_ld(&(bar)[XB_TMO])) break; if (_sp > XB_SPIN_CAP) { atomicAdd(&(bar)[XB_TMO], 1u); break; } } } } while (0)

struct XcdBarrier {
    unsigned* bar; unsigned x;
    volatile LAS unsigned* st;
};

__device__ __forceinline__ XcdBarrier xcd_barrier_post(unsigned* bar, volatile LAS unsigned* st, int tid) {
    XcdBarrier b; b.bar = bar; b.x = xb_xcc_id(); b.st = st;
    if (tid == 0) (void)xb_add(&bar[XB_XCNT(b.x)], 1u);
    return b;
}
__device__ __forceinline__ void xcd_barrier_complete(unsigned* bar, unsigned x, unsigned& nloc, unsigned& nx) {
    const unsigned G = gridDim.x * gridDim.y * gridDim.z;
    unsigned sum, cnt, mine, sp = 0u;
    for (;;) {
        sum = 0u; cnt = 0u; mine = 0u;
#pragma unroll
        for (unsigned j = 0; j < 16; ++j) { const unsigned c = xb_ld(&bar[XB_XCNT(j)]); sum += c; cnt += (c > 0u) ? 1u : 0u; mine = (j == x) ? c : mine; }
        if (sum == G) break;
        __builtin_amdgcn_s_sleep(1);
        if ((++sp & 255u) == 0u) { if (xb_ld(&bar[XB_TMO])) break; if (sp > XB_SPIN_CAP) { atomicAdd(&bar[XB_TMO], 1u); break; } }
    }
    nloc = mine > 0u ? mine : 1u; nx = cnt > 0u ? cnt : 1u;
}

__device__ __forceinline__ void xcd_barrier(const XcdBarrier& b, int tid) {
    asm volatile("s_waitcnt vmcnt(0)" ::: "memory");
    __syncthreads();
    if (tid == 0) {
        unsigned* bar = b.bar;
        __builtin_amdgcn_s_waitcnt(0);
        unsigned nloc = b.st[0], nx = b.st[1];
        if (nloc == 0u) { xcd_barrier_complete(bar, b.x, nloc, nx); b.st[0] = nloc; b.st[1] = nx; }
        const unsigned old = xb_add(&bar[XB_XSUB(b.x)], 1u);
        const unsigned gen = old / nloc;
        if (old + 1u == (gen + 1u) * nloc) {
            __builtin_amdgcn_fence(__ATOMIC_RELEASE, "agent");
            asm volatile("s_waitcnt vmcnt(0)" ::: "memory");
            const unsigned og = xb_add(&bar[XB_TOP], 1u);
            const unsigned tg = og / nx;
            if (og + 1u == (tg + 1u) * nx) xb_add(&bar[XB_TOPGEN], 1u);
            else XB_SPIN(xb_ld(&bar[XB_TOPGEN]) == tg, bar);
            __builtin_amdgcn_fence(__ATOMIC_ACQUIRE, "agent");
            xb_add(&bar[XB_XGEN(b.x)], 1u);
            asm volatile("s_waitcnt vmcnt(0)" ::: "memory");
        } else {
            XB_SPIN(xb_ld(&bar[XB_XGEN(b.x)]) == gen, bar);
            __builtin_amdgcn_fence(__ATOMIC_ACQUIRE, "agent");
            asm volatile("s_waitcnt vmcnt(0)" ::: "memory");
        }
    }
    __syncthreads();
}

constexpr int CW_BAR = 4096; constexpr size_t CTL_ZERO_BYTES = 65536; constexpr int MISC_OFF = 131072;
__device__ __forceinline__ void epi_tables(LAS unsigned char* L, const pg8::StaticOrder& S, const float* ssq, const float* bias, int bstride, int tid) {
    LAS int* tags = (LAS int*)(L + pg8::TAB_OFF); LAS float* rT = (LAS float*)(L + pg8::TAB_OFF + 64); LAS float* bT = rT + pg8::TAB_SLOTS * 256;
    for (int i = 0; i < pg8::TAB_SLOTS; ++i) { pg8::Unit u;
        if (!S.next(i, u)) { if (tid == 0) tags[i] = -1; continue; }
        if (tid == 0) tags[i] = (u.pm << 8) | u.pn;
        if (ssq) { const int row = tid >> 1, hf = tid & 1; const float* q = ssq + (size_t)(u.pm * 256 + row) * 32 + hf * 16;
            const f32x4 a = *(const f32x4*)q, b = *(const f32x4*)(q + 4), c = *(const f32x4*)(q + 8), d = *(const f32x4*)(q + 12);
            float t = (((a.x + a.y) + (a.z + a.w)) + ((b.x + b.y) + (b.z + b.w))) + (((c.x + c.y) + (c.z + c.w)) + ((d.x + d.y) + (d.z + d.w)));
            t += __shfl_xor(t, 1); if (hf == 0) rT[i * 256 + row] = 1.0f / sqrtf(t * (1.0f / DM) + EPS); }
        if (tid < 256) bT[i * 256 + tid] = bias[(size_t)(u.pm >> 4) * bstride + u.pn * 256 + tid]; }
    __syncthreads();
}
struct Args { const void* in[35]; float* out; unsigned char* ws; int lo, hi; };
__device__ __forceinline__ int lane_id() { int l; asm volatile("v_mbcnt_lo_u32_b32 %0, -1, 0\n\tv_mbcnt_hi_u32_b32 %0, -1, %0" : "=v"(l)); return l; }
#define lt_tid() (wave * 64 + lane_id())
typedef const __attribute__((address_space(4))) unsigned long long* kargp_t;
__device__ __forceinline__ const void* karg(int i) { return (const void*)(const GAS void*)(((kargp_t)__builtin_amdgcn_kernarg_segment_ptr())[i]); }
#define KP(i) karg(i)

template <int NR> __device__ __forceinline__ void rows_norm_mod(const float* X, const float* g1, const float* sh1, const float* sc1, hb* o1, int gw, int NGW, int lane) {
    const unsigned l4 = 4u * (unsigned)lane;
    for (int R0 = NR * gw; R0 < M; R0 += NR * NGW) {
        const int b = R0 >> 12;
        const float* scb = sc1 + (size_t)b * NMOD; const float* shb = sh1 + (size_t)b * NMOD;
        f32x4 v[NR][8], gm[8], hh[8];
#pragma unroll
        for (int r = 0; r < NR; ++r) { const float* xr = X + (size_t)(R0 + r) * DM;
#pragma unroll
            for (int j = 0; j < 8; ++j) v[r][j] = __builtin_nontemporal_load((const f32x4*)(xr + (l4 + 256u * j))); }
#pragma unroll
        for (int j = 0; j < 8; ++j) { const unsigned col = l4 + 256u * j; gm[j] = *(const f32x4*)(g1 + col) * (*(const f32x4*)(scb + col) + 1.0f); hh[j] = *(const f32x4*)(shb + col); }
        float rstd[NR];
#pragma unroll
        for (int r = 0; r < NR; ++r) { float ss = 0.f;
#pragma unroll
            for (int j = 0; j < 8; ++j) ss += (v[r][j].x * v[r][j].x + v[r][j].y * v[r][j].y) + (v[r][j].z * v[r][j].z + v[r][j].w * v[r][j].w);
            rstd[r] = 1.0f / sqrtf(wave_sum(ss) * (1.0f / DM) + EPS); }
#pragma unroll
        for (int r = 0; r < NR; ++r) {
#pragma unroll
            for (int j = 0; j < 8; ++j) { const f32x4 y = (v[r][j] * rstd[r]) * gm[j] + hh[j]; *(v2u*)(o1 + tidx(R0 + r, (int)(l4 + 256u * j), DM)) = (v2u){pk2(y.x, y.y), pk2(y.z, y.w)}; } }
    }
}

__device__ __forceinline__ void qk_norm_rope(const float* raw, const float* g, const float* rt, hb* out, int gw, int NGW, int lane) {
    const int h = lane >> 2, q = lane & 3;
    float ga[16], gb[16];
#pragma unroll
    for (int e = 0; e < 16; ++e) { ga[e] = g[q * 16 + e]; gb[e] = g[64 + q * 16 + e]; }
    for (int row = gw; row < M; row += NGW) {
        const int b = row >> 12, s = row & 4095;
        const float* p = raw + (size_t)row * DM + h * 128 + q * 16;
        f32x4 a[4], c[4], cs[8]; float ss = 0.f;
#pragma unroll
        for (int e = 0; e < 4; ++e) { a[e] = *(const f32x4*)(p + 4 * e); c[e] = *(const f32x4*)(p + 64 + 4 * e);
            ss += (a[e].x * a[e].x + a[e].y * a[e].y) + (a[e].z * a[e].z + a[e].w * a[e].w) + (c[e].x * c[e].x + c[e].y * c[e].y) + (c[e].z * c[e].z + c[e].w * c[e].w); }
        const float* t = rt + ((size_t)row * 64 + q * 16) * 2;
#pragma unroll
        for (int e = 0; e < 8; ++e) cs[e] = *(const f32x4*)(t + 4 * e);
        ss += __shfl_xor(ss, 1); ss += __shfl_xor(ss, 2);
        const float rstd = 1.0f / sqrtf(ss * (1.0f / 128.0f) + EPS);
        float o1[16], o2[16];
#pragma unroll
        for (int e = 0; e < 16; ++e) { const float x1 = a[e >> 2][e & 3] * rstd * ga[e], x2 = c[e >> 2][e & 3] * rstd * gb[e];
            const float co = cs[e >> 1][(e & 1) * 2], si = cs[e >> 1][(e & 1) * 2 + 1];
            o1[e] = x1 * co - x2 * si; o2[e] = x2 * co + x1 * si; }
        hb* op = out + ((size_t)(b * 16 + h) * SEQ + s) * 128 + q * 16;
        *(v4u*)(op) = (v4u){pk2(o1[0], o1[1]), pk2(o1[2], o1[3]), pk2(o1[4], o1[5]), pk2(o1[6], o1[7])};
        *(v4u*)(op + 8) = (v4u){pk2(o1[8], o1[9]), pk2(o1[10], o1[11]), pk2(o1[12], o1[13]), pk2(o1[14], o1[15])};
        *(v4u*)(op + 64) = (v4u){pk2(o2[0], o2[1]), pk2(o2[2], o2[3]), pk2(o2[4], o2[5]), pk2(o2[6], o2[7])};
        *(v4u*)(op + 72) = (v4u){pk2(o2[8], o2[9]), pk2(o2[10], o2[11]), pk2(o2[12], o2[13]), pk2(o2[14], o2[15])};
    }
}

__device__ __forceinline__ void attn_combine(const float* O, const float* sg, float lam, hb* A, int gw, int NGW, int lane) {
    const int h = lane >> 3, q = lane & 7, v = q >> 2, d0 = (q & 3) * 32;
    f32x4 gg[8];
#pragma unroll
    for (int e = 0; e < 8; ++e) gg[e] = *(const f32x4*)(sg + v * 128 + d0 + 4 * e);
    for (int R0 = 2 * gw; R0 < M; R0 += 2 * NGW) {
        const int b = R0 >> 12, s = R0 & 4095;
        const float* p1 = O + ((size_t)(b * 32 + 4 * h + v) * SEQ + s) * 128 + d0;
        const float* p2 = O + ((size_t)(b * 32 + 4 * h + 2 + v) * SEQ + s) * 128 + d0;
        f32x4 x1[2][8], x2[2][8];
#pragma unroll
        for (int r = 0; r < 2; ++r)
#pragma unroll
            for (int e = 0; e < 8; ++e) { x1[r][e] = *(const f32x4*)(p1 + r * 128 + 4 * e); x2[r][e] = *(const f32x4*)(p2 + r * 128 + 4 * e); }
#pragma unroll
        for (int r = 0; r < 2; ++r) { float ss = 0.f;
#pragma unroll
            for (int e = 0; e < 8; ++e) { x1[r][e] = x1[r][e] - lam * x2[r][e]; ss += (x1[r][e].x * x1[r][e].x + x1[r][e].y * x1[r][e].y) + (x1[r][e].z * x1[r][e].z + x1[r][e].w * x1[r][e].w); }
            ss += __shfl_xor(ss, 1); ss += __shfl_xor(ss, 2); ss += __shfl_xor(ss, 4);
            const float rstd = (1.0f - LAM_INIT) / sqrtf(ss * (1.0f / 256.0f) + EPS);
            hb* op = A + tidx(R0 + r, h * 256 + v * 128 + d0, DM);
#pragma unroll
            for (int e = 0; e < 8; e += 2) { const f32x4 y0 = x1[r][e] * rstd * gg[e], y1 = x1[r][e + 1] * rstd * gg[e + 1];
                *(v4u*)(op + 4 * e) = (v4u){pk2(y0.x, y0.y), pk2(y0.z, y0.w), pk2(y1.x, y1.y), pk2(y1.z, y1.w)}; } }
    }
}

__device__ __forceinline__ att::BlockRef<att::bf16, float> mkref(int Lx, int pass, const hb* Qb, const hb* Kb, const hb* Vb, float* Ob) {
    const int bh = Lx >> 3, xx = Lx & 7, qb = pass ? 15 - xx : xx; const int b = bh >> 5, r = bh & 31, hh = r >> 2, s = (r >> 1) & 1, v = r & 1;
    att::BlockRef<att::bf16, float> rr;
    rr.Q = (const att::bf16*)Qb + ((size_t)(b * 16 + 2 * hh + s) * SEQ + (size_t)qb * att::QB) * 128; rr.K = (const att::bf16*)Kb + (size_t)(b * 16 + 2 * hh + s) * SEQ * 128;
    rr.V = (const att::bf16*)Vb + (size_t)(b * 16 + 2 * hh + v) * SEQ * 128; rr.O = Ob + ((size_t)(b * 32 + r) * SEQ + (size_t)qb * att::QB) * 128; rr.P0 = qb * att::QB; return rr;
}
#define XIN ((const float*)KP(0))
#define cvec ((const float*)KP(1))
#define positions ((const int*)KP(2))
#define mods ((float*)(ws + WS_MODS))
#define gam ((float*)(ws + WS_GAM))
#define biasT ((float*)(ws + WS_BIAS))
#define SSQ ((float*)(ws + WS_SSQ))
#define rt ((float*)(ws + WS_RT))
#define stats ((float*)(ws + WS_STATS))
#define W_in ((hb*)(ws + WS_W_IN))
#define W_out ((hb*)(ws + WS_W_OUT))
#define W_fia ((hb*)(ws + WS_W_FIA))
#define W_foa ((hb*)(ws + WS_W_FOA))
#define W_kv ((hb*)(ws + WS_W_KV))
#define W_q ((hb*)(ws + WS_W_Q))
#define W_o ((hb*)(ws + WS_W_O))
#define W_fib ((hb*)(ws + WS_W_FIB))
#define W_fob ((hb*)(ws + WS_W_FOB))
#define XA ((float*)(ws + WS_XA))
#define XB ((float*)(ws + WS_XB))
#define XN ((hb*)(ws + WS_XN))
#define XQ ((hb*)(ws + WS_XQ))
#define A3 ((hb*)(ws + WS_A3))
#define Z ((hb*)(ws + WS_Z))
#define H ((hb*)(ws + WS_H))
#define KRAW ((float*)(ws + WS_KRAW))
#define QRAW ((float*)(ws + WS_QRAW))
#define OB ((float*)(ws + WS_O))
#define VB ((hb*)(ws + WS_VB))
#define KB ((hb*)(ws + WS_KB))
#define QB_ ((hb*)(ws + WS_QB))
__device__ __forceinline__ void bias_chunks(unsigned char* ws, int c_lo, int c_hi, int gw, int NGW, int lane) {
        for (int c = c_lo + gw; c < c_hi; c += NGW) { const int r0 = 16 * c; const hb* Wt; int sho;
            int rl;
            if (r0 < OFF_KV) { Wt = W_fia; rl = r0; sho = MOD_A + 6144; } else if (r0 < OFF_Q) { Wt = W_kv; rl = r0 - OFF_KV; sho = MOD_KV; }
            else if (r0 < OFF_FIB) { Wt = W_q; rl = r0 - OFF_Q; sho = MOD_B; } else { Wt = W_fib; rl = r0 - OFF_FIB; sho = MOD_B + 6144; }
            f32x4 s0[4][2], s1[4][2];
#pragma unroll
            for (int j = 0; j < 4; ++j)
#pragma unroll
                for (int e = 0; e < 2; ++e) { s0[j][e] = *(const f32x4*)(mods + sho + 8 * lane + 512 * j + 4 * e); s1[j][e] = *(const f32x4*)(mods + NMOD + sho + 8 * lane + 512 * j + 4 * e); }
            for (int hf = 0; hf < 4; ++hf) { v4u wv[4][4];
#pragma unroll
                for (int r = 0; r < 4; ++r)
#pragma unroll
                    for (int j = 0; j < 4; ++j) wv[r][j] = __builtin_nontemporal_load((const v4u*)(Wt + tidx(rl + 4 * hf + r, 8 * lane + 512 * j, DM)));
                float myb0 = 0.f, myb1 = 0.f;
#pragma unroll
                for (int r = 0; r < 4; ++r) { float a0 = 0.f, a1 = 0.f;
#pragma unroll
                    for (int j = 0; j < 4; ++j) { const v4u w = wv[r][j]; const f32x4 lo = {bflo(w.x), bfhi(w.x), bflo(w.y), bfhi(w.y)}, hi2 = {bflo(w.z), bfhi(w.z), bflo(w.w), bfhi(w.w)};
                        const f32x4 p0 = lo * s0[j][0] + hi2 * s0[j][1], p1 = lo * s1[j][0] + hi2 * s1[j][1]; a0 += (p0.x + p0.y) + (p0.z + p0.w); a1 += (p1.x + p1.y) + (p1.z + p1.w); }
                    a0 = wave_sum(a0); a1 = wave_sum(a1); if (lane == r) { myb0 = a0; myb1 = a1; } }
                if (lane < 4) { biasT[r0 + 4 * hf + lane] = myb0; biasT[pg8::NBIAS + r0 + 4 * hf + lane] = myb1; } }
        }
}
__global__ void __launch_bounds__(NWAVES * 64, 2) yoco_fwd(Args args) {
    extern __shared__ __attribute__((aligned(16))) unsigned char lds[];
    LAS unsigned char* L = (LAS unsigned char*)lds;
    const int wave = __builtin_amdgcn_readfirstlane((int)threadIdx.x >> 6);
#define PH_IDS const int tid = lt_tid(), lane = tid & 63
    volatile LAS unsigned* MISC = (volatile LAS unsigned*)(L + MISC_OFF);
    { const int t0 = lt_tid(); if (t0 < 16) MISC[t0] = 0u; }
    __syncthreads();
    const int G = gridDim.x, bx = blockIdx.x;
    const int gw = bx * NWAVES + wave, NGW = G * NWAVES;
    unsigned char* ws = (unsigned char*)KP(36);
    const unsigned long long lohi = ((kargp_t)__builtin_amdgcn_kernarg_segment_ptr())[37]; const int lo = (int)(unsigned)lohi, hi = (int)(unsigned)(lohi >> 32);
#ifndef PHM
#define PHM 0x1ffff
#endif
#define IN(k) (((PHM >> (k)) & 1) && lo <= (k) && (k) < hi)
    XcdBarrier xbar; xbar.bar = (unsigned*)ws + CW_BAR; xbar.x = 0; xbar.st = nullptr;
    if (hi - lo > 1) xbar = xcd_barrier_post((unsigned*)ws + CW_BAR, MISC + 8, lt_tid());
#define SEAM(k) do { if (IN(k) && IN((k) + 1)) { xcd_barrier(xbar, lt_tid()); } } while (0)
    if (lo < 0) cg::this_grid().sync();

    if (IN(0)) { PH_IDS;
        {
            LAS float* sc = (LAS float*)L; LAS float* red = (LAS float*)(L + 16384);
            for (int i = tid; i < 2 * DM; i += NWAVES * 64) { const float cv = cvec[i]; sc[i] = cv / (1.0f + __expf(-cv)); }
            __syncthreads();
            for (int it = bx; it < NMOD / 128; it += G) {
                const int gc = it * 128; const float* Wm; const float* bm; int N, c0;
                if (gc < MOD_KV) { Wm = (const float*)KP(3); bm = (const float*)KP(4); N = 12288; c0 = gc; }
                else if (gc < MOD_B) { Wm = (const float*)KP(16); bm = (const float*)KP(17); N = 4096; c0 = gc - MOD_KV; }
                else { Wm = (const float*)KP(21); bm = (const float*)KP(22); N = 12288; c0 = gc - MOD_B; }
                const float* wp = Wm + (size_t)(256 * wave) * N + c0 + 2 * lane;
                f32x2 a0 = {0.f, 0.f}, a1 = {0.f, 0.f};
#pragma unroll 16
                for (int kk = 0; kk < 256; ++kk) { const f32x2 wv = __builtin_nontemporal_load((const f32x2*)(wp + (size_t)kk * N)); const float s0 = sc[256 * wave + kk], s1 = sc[DM + 256 * wave + kk]; a0 += wv * s0; a1 += wv * s1; }
                red[(wave * 2 + 0) * 128 + 2 * lane] = a0.x; red[(wave * 2 + 0) * 128 + 2 * lane + 1] = a0.y;
                red[(wave * 2 + 1) * 128 + 2 * lane] = a1.x; red[(wave * 2 + 1) * 128 + 2 * lane + 1] = a1.y;
                __syncthreads();
                if (tid < 256) { const int b = tid >> 7, cc = tid & 127; float s = bm[c0 + cc];
#pragma unroll
                    for (int w = 0; w < 8; ++w) s += red[(w * 2 + b) * 128 + cc];
                    mods[(size_t)b * NMOD + gc + cc] = s; }
                __syncthreads();
            }
        }
        for (int idx = gw * 64 + lane; idx < M * 64; idx += NGW * 64) { const int row = idx >> 6, i = idx & 63;
            const float inv = 1.0f / exp2f((float)i * (13.287712379549449f / 64.0f)); const float ang = (float)positions[row] * inv;
            double rev = (double)ang * 0.15915494309189535; rev -= floor(rev); const float rf = (float)rev;
            *(f32x2*)(rt + (size_t)idx * 2) = (f32x2){__builtin_amdgcn_cosf(rf), __builtin_amdgcn_sinf(rf)}; }
        {
            LAS float* scr = (LAS float*)(L + wave * 16384);
            constexpr int I_IN = (DM / 64) * (2 * DM / 32), I_SQ = (DM / 64) * (DM / 32), I_FI = (DM / 64) * (2 * DFF / 32), I_FO = (DFF / 64) * (DM / 32);
            constexpr int NITEMS = 2 * I_IN + 3 * I_SQ + 2 * I_FI + 2 * I_FO;
#define TR_DECODE(T, itx) do { int r = (itx); \
                if (r < I_IN) { T.W = (const float*)KP(6); T.WT = W_in; T.K = DM; T.N = 2 * DM; T.mode = 0; T.lim = 0; } else { r -= I_IN; \
                if (r < I_SQ) { T.W = (const float*)KP(12); T.WT = W_out; T.K = DM; T.N = DM; T.mode = 0; T.lim = 0; } else { r -= I_SQ; \
                if (r < I_FI) { T.W = (const float*)KP(14); T.WT = W_fia; T.K = DM; T.N = 2 * DFF; T.mode = 1; T.lim = 0; } else { r -= I_FI; \
                if (r < I_FO) { T.W = (const float*)KP(15); T.WT = W_foa; T.K = DFF; T.N = DM; T.mode = 0; T.lim = 0; } else { r -= I_FO; \
                if (r < I_IN) { T.W = (const float*)KP(19); T.WT = W_kv; T.K = DM; T.N = 2 * DM; T.mode = 2; T.lim = DM; } else { r -= I_IN; \
                if (r < I_SQ) { T.W = (const float*)KP(24); T.WT = W_q; T.K = DM; T.N = DM; T.mode = 2; T.lim = DM; } else { r -= I_SQ; \
                if (r < I_SQ) { T.W = (const float*)KP(31); T.WT = W_o; T.K = DM; T.N = DM; T.mode = 0; T.lim = 0; } else { r -= I_SQ; \
                if (r < I_FI) { T.W = (const float*)KP(33); T.WT = W_fib; T.K = DM; T.N = 2 * DFF; T.mode = 1; T.lim = 0; } else { r -= I_FI; \
                                T.W = (const float*)KP(34); T.WT = W_fob; T.K = DFF; T.N = DM; T.mode = 0; T.lim = 0; } } } } } } } } \
                const int nblk_ = T.N / 32; T.k0 = 64 * (r / nblk_); T.n0 = 32 * (r % nblk_); } while (0)
            float tv[32]; TrItem cur, nxt;
            int it = gw;
            if (it < NITEMS) { TR_DECODE(cur, it); tr_load(cur, tv, lane); nxt = cur; }
            while (it < NITEMS) {
#pragma unroll
                for (int i = 0; i < 32; ++i) { const int kk = 2 * i + (lane >> 5); scr[kk * 33 + (lane & 31)] = tv[i]; }
                LDS_WAIT(); asm volatile("" ::: "memory");
                const int itn = it + NGW;
                if (itn < NITEMS) { TR_DECODE(nxt, itn); tr_load(nxt, tv, lane); }
                const int c = lane & 7;
#pragma unroll
                for (int j = 0; j < 4; ++j) { const int n = (lane >> 3) + 8 * j; const LAS float* sp = scr + (8 * c) * 33 + n;
                    v4u o; o.x = pk2(sp[0 * 33], sp[1 * 33]); o.y = pk2(sp[2 * 33], sp[3 * 33]); o.z = pk2(sp[4 * 33], sp[5 * 33]); o.w = pk2(sp[6 * 33], sp[7 * 33]);
                    __builtin_nontemporal_store(o, (GAS v4u*)(cur.WT + tidx(wt_rowmap(cur.n0 + n, cur.mode, cur.N, cur.lim), cur.k0 + 8 * c, cur.K))); }
                LDS_WAIT(); asm volatile("" ::: "memory");
                cur = nxt; it = itn;
            }
#undef TR_DECODE
        }
        __syncthreads();
    }
    SEAM(0);
    if (IN(1)) { PH_IDS;
        rows_norm_mod<2>(XIN, (const float*)KP(5), mods + MOD_A + 0, mods + MOD_A + 2048, XN, gw, NGW, lane); }
    if (IN(1)) { PH_IDS;
        for (int idx = gw * 64 + lane; idx < 4 * 2 * DM; idx += NGW * 64) { const int m = idx >> 12, b = (idx >> 11) & 1, col = idx & 2047;
            const float* gp = m == 0 ? (const float*)KP(13) : m == 1 ? (const float*)KP(18) : m == 2 ? (const float*)KP(23) : (const float*)KP(32);
            const int so = m == 0 ? MOD_A + 8192 : m == 1 ? MOD_KV + 2048 : m == 2 ? MOD_B + 2048 : MOD_B + 8192;
            gam[idx] = gp[col] * (1.0f + mods[(size_t)b * NMOD + so + col]); }
        bias_chunks(ws, 0, (G == 256) ? OFF_KV / 16 : pg8::NBIAS / 16, gw, NGW, lane);
    }
    SEAM(1);
    if (IN(2)) { pg8::Gemm g{XN, W_in, M, 2 * DM, DM}; pg8::StaticOrder S; S.init(M, 2 * DM, G, bx);
        epi_tables(L, S, nullptr, (const float*)KP(7), 0, lt_tid());
        pg8::EpiGeluStats E{Z, 2 * DM, L + pg8::TAB_OFF, stats};
        pg8::gemm_phase<pg8::EpiGeluStats, pg8::StaticOrder, true, true>(L, g, S, E, lt_tid()); }
    SEAM(2);
    if (IN(3)) { PH_IDS;
        LAS hb* vTb = (LAS hb*)L; LAS f32x2* st = (LAS f32x2*)(L + 73728);
        const float* lng = (const float*)KP(8); const float* lnb = (const float*)KP(9); const float* sw = (const float*)KP(10); const float* sb = (const float*)KP(11);
        const int tl = lane & 15, quad = lane >> 4; int cur_g = -1; bf16x8 wf[4]; int buf = 0;
        v4u zpre[4]; v2u upre[8];
#define ZULOAD(uu) do { const int g_ = (uu) & 15, R_ = ((uu) >> 4) * 128; _Pragma("unroll") for (int i = 0; i < 4; ++i) { const int qd = tid + 512 * i; \
            zpre[i] = *(const v4u*)(Z + (size_t)(R_ + (qd >> 4)) * (2 * DM) + DM + g_ * 128 + (qd & 15) * 8); } \
            _Pragma("unroll") for (int nt = 0; nt < 8; ++nt) upre[nt] = *(const v2u*)(Z + (size_t)(R_ + 16 * wave + tl) * (2 * DM) + g_ * 128 + 16 * nt + quad * 4); } while (0)
        for (int u0 = bx; u0 < 1024; u0 += 4 * G) {
            { const int j = tid >> 7, r = tid & 127, uj = u0 + j * G;
              if (uj < 1024) { const float* sp = stats + (size_t)((uj >> 4) * 128 + r) * 64; float s1 = 0.f, s2 = 0.f;
#pragma unroll
                for (int i = 0; i < 16; ++i) { const f32x4 p = *(const f32x4*)(sp + 4 * i); s1 += p.x + p.z; s2 += p.y + p.w; }
                const float mean = s1 * (1.0f / DM); const float var = fmaxf(s2 * (1.0f / DM) - mean * mean, 0.f); st[tid] = (f32x2){mean, 1.0f / sqrtf(var + EPS)}; } }
            ZULOAD(u0);
            __syncthreads();
            for (int j = 0; j < 4; ++j) { const int u = u0 + j * G; if (u >= 1024) break;
                const int g = u & 15, R0 = (u >> 4) * 128; LAS hb* vT = vTb + buf * (128 * 136);
                if (g != cur_g) { cur_g = g; const int t = 16 * wave + tl;
#pragma unroll
                    for (int ks = 0; ks < 4; ++ks) { const int s0 = 32 * ks + 8 * quad; const float* wp = sw + ((size_t)g * 128 + t) * 128 + s0;
                        const f32x4 w0 = *(const f32x4*)wp, w1 = *(const f32x4*)(wp + 4); float wv[8] = {w0.x, w0.y, w0.z, w0.w, w1.x, w1.y, w1.z, w1.w};
#pragma unroll
                        for (int jj = 0; jj < 8; ++jj) if (s0 + jj > t) wv[jj] = 0.f;
                        v4u pw = {pk2(wv[0], wv[1]), pk2(wv[2], wv[3]), pk2(wv[4], wv[5]), pk2(wv[6], wv[7])}; wf[ks] = __builtin_bit_cast(bf16x8, pw); } }
#pragma unroll
                for (int i = 0; i < 4; ++i) { const int qd = tid + 512 * i, s = qd >> 4, cc = (qd & 15) * 8;
                    const v4u zv = zpre[i]; const f32x2 ms = st[j * 128 + s];
                    const f32x4 g0 = *(const f32x4*)(lng + g * 128 + cc), g1 = *(const f32x4*)(lng + g * 128 + cc + 4), b0 = *(const f32x4*)(lnb + g * 128 + cc), b1 = *(const f32x4*)(lnb + g * 128 + cc + 4);
                    float y[8] = {bflo(zv.x), bfhi(zv.x), bflo(zv.y), bfhi(zv.y), bflo(zv.z), bfhi(zv.z), bflo(zv.w), bfhi(zv.w)};
                    const float gg[8] = {g0.x, g0.y, g0.z, g0.w, g1.x, g1.y, g1.z, g1.w}, bb[8] = {b0.x, b0.y, b0.z, b0.w, b1.x, b1.y, b1.z, b1.w};
#pragma unroll
                    for (int e = 0; e < 8; ++e) vT[(cc + e) * 136 + s] = (hb)f2bf((y[e] - ms.x) * ms.y * gg[e] + bb[e]); }
                v2u ucur[8];
#pragma unroll
                for (int nt = 0; nt < 8; ++nt) ucur[nt] = upre[nt];
                if (j < 3 && u + G < 1024) ZULOAD(u + G);
                __syncthreads();
                { const int t = 16 * wave + tl, row = R0 + t; const float bias = sb[g * 128 + t];
#pragma unroll
                  for (int nt = 0; nt < 8; ++nt) { f32x4 acc = {0.f, 0.f, 0.f, 0.f};
#pragma unroll
                    for (int ks = 0; ks < 4; ++ks) if (ks <= (wave >> 1)) { const bf16x8 bfr = *(const LAS bf16x8*)(vT + (16 * nt + tl) * 136 + 32 * ks + 8 * quad);
                        acc = __builtin_amdgcn_mfma_f32_16x16x32_bf16(bfr, wf[ks], acc, 0, 0, 0); }
                    const int col = g * 128 + 16 * nt + quad * 4; const v2u uv = ucur[nt];
                    const float y0 = bflo(uv.x) * (acc[0] + bias), y1 = bfhi(uv.x) * (acc[1] + bias), y2 = bflo(uv.y) * (acc[2] + bias), y3 = bfhi(uv.y) * (acc[3] + bias);
                    *(v2u*)(A3 + tidx(row, col, DM)) = (v2u){pk2(y0, y1), pk2(y2, y3)}; } }
                buf ^= 1;
            }
            __syncthreads();
        }
#undef ZULOAD
    }
    SEAM(3);
    if (IN(4)) { pg8::Gemm g{A3, W_out, M, DM, DM}; pg8::StaticOrder S; S.init(M, DM, G, bx);
        pg8::EpiResNorm<true> E{XIN, XA, mods + MOD_A + 4096, NMOD, DM, gam + 0 * 4096, XN, nullptr, nullptr, SSQ};
        pg8::gemm_phase<pg8::EpiResNorm<true>, pg8::StaticOrder, true, true>(L, g, S, E, lt_tid()); }
    SEAM(4);
    if (IN(6)) { pg8::Gemm g{XN, W_fia, M, 2 * DFF, DM}; pg8::StaticOrder S; S.init(M, 2 * DFF, G, bx);
        epi_tables(L, S, SSQ, biasT + OFF_FIA, pg8::NBIAS, lt_tid());
        pg8::EpiSwiGLU E{H, DFF, L + pg8::TAB_OFF};
        pg8::gemm_phase<pg8::EpiSwiGLU, pg8::StaticOrder, true, true>(L, g, S, E, lt_tid());
        if (G == 256 && bx >= 128) { PH_IDS; (void)tid; bias_chunks(ws, OFF_KV / 16, pg8::NBIAS / 16, (bx - 128) * NWAVES + wave, 128 * NWAVES, lane); }
    }
    SEAM(6);
    if (IN(7)) { pg8::Gemm g{H, W_foa, M, DM, DFF}; pg8::StaticOrder S; S.init(M, DM, G, bx);
        pg8::EpiResNorm<false> E{XA, XB, mods + MOD_A + 10240, NMOD, DM, gam + 1 * 4096, XN, gam + 2 * 4096, XQ, SSQ};
        pg8::gemm_phase<pg8::EpiResNorm<false>, pg8::StaticOrder, true, true>(L, g, S, E, lt_tid()); }
    SEAM(7);
    if (IN(9)) {
        { pg8::Gemm g{XN, W_kv, M, DM, DM}; pg8::StaticOrder S; S.init(M, DM, G, bx); pg8::EpiQKRope E{KB, (const float*)KP(20), rt, SSQ, biasT + OFF_KV};
          pg8::gemm_phase<pg8::EpiQKRope, pg8::StaticOrder, false, true>(L, g, S, E, lt_tid()); }
        { pg8::Gemm g{XN, W_kv + (size_t)DM * DM, M, DM, DM}; pg8::StaticOrder S; S.init(M, DM, G, bx); pg8::EpiVhead E{VB, SSQ, biasT + OFF_KV + DM};
          pg8::gemm_phase<pg8::EpiVhead, pg8::StaticOrder, true, true>(L, g, S, E, lt_tid()); }
        { pg8::Gemm g{XQ, W_q, M, DM, DM}; pg8::StaticOrder S; S.init(M, DM, G, bx); pg8::EpiQKRope E{QB_, (const float*)KP(25), rt, SSQ, biasT + OFF_Q};
          pg8::gemm_phase<pg8::EpiQKRope, pg8::StaticOrder, false, true>(L, g, S, E, lt_tid()); }
    }
    SEAM(9);
#define SKIP10 1
    if (IN(11)) {
        typedef att::BlockRef<att::bf16, float> BR;
        const int total = 8 * 64, stride = G;
        int Li = (G % 8 == 0) ? (bx % 8) * (G / 8) + bx / 8 : bx;
        if (Li < total) {
#define MKREF(Lx, pass) mkref((Lx), (pass), QB_, KB, VB, OB)
            int pass = 0; BR cur = MKREF(Li, 0);
            att::Seam<att::bf16> S;
            att::causal_swa_prime<att::bf16, float>(cur, SEQ, (char*)lds, S, lt_tid());
            for (;;) {
                const bool more_pass = pass == 0, more_item = Li + stride < total, last = !more_pass && !more_item;
                int passn = pass + 1, Ln = Li;
                if (!more_pass) { passn = 0; Ln = more_item ? Li + stride : Li; }
                const BR nxt = last ? cur : MKREF(Ln, passn);
                att::causal_swa_block<att::bf16, float>(cur, nxt, SEQ, SEQ, (char*)lds, S, lt_tid());
                if (last) break;
                cur = nxt; pass = passn; Li = Ln;
            }
#undef MKREF
        }
    }
    SEAM(11);
    if (IN(12)) { PH_IDS;
        const float* q1 = (const float*)KP(26); const float* k1 = (const float*)KP(27); const float* q2 = (const float*)KP(28); const float* k2 = (const float*)KP(29);
        const float d1 = wave_sum(q1[lane] * k1[lane] + q1[lane + 64] * k1[lane + 64]), d2 = wave_sum(q2[lane] * k2[lane] + q2[lane + 64] * k2[lane + 64]);
        const float lam = expf(d1) - expf(d2) + LAM_INIT;
        attn_combine(OB, (const float*)KP(30), lam, A3, gw, NGW, lane);
    }
    SEAM(12);
    if (IN(13)) { pg8::Gemm g{A3, W_o, M, DM, DM}; pg8::StaticOrder S; S.init(M, DM, G, bx);
        pg8::EpiResNorm<false> E{XB, XA, mods + MOD_B + 4096, NMOD, DM, gam + 3 * 4096, XN, nullptr, nullptr, SSQ};
        pg8::gemm_phase<pg8::EpiResNorm<false>, pg8::StaticOrder, true, true>(L, g, S, E, lt_tid()); }
    SEAM(13);
    if (IN(15)) { pg8::Gemm g{XN, W_fib, M, 2 * DFF, DM}; pg8::StaticOrder S; S.init(M, 2 * DFF, G, bx);
        epi_tables(L, S, SSQ, biasT + OFF_FIB, pg8::NBIAS, lt_tid());
        pg8::EpiSwiGLU E{H, DFF, L + pg8::TAB_OFF};
        pg8::gemm_phase<pg8::EpiSwiGLU, pg8::StaticOrder, true, true>(L, g, S, E, lt_tid()); }
    SEAM(15);
    if (IN(16)) { pg8::Gemm g{H, W_fob, M, DM, DFF}; pg8::StaticOrder S; S.init(M, DM, G, bx);
        pg8::EpiResNorm<false> E{XA, (float*)KP(35), mods + MOD_B + 10240, NMOD, DM, nullptr, nullptr, nullptr, nullptr, nullptr};
        pg8::gemm_phase<pg8::EpiResNorm<false>, pg8::StaticOrder, true, true>(L, g, S, E, lt_tid()); }
#undef IN
#undef SEAM
}
constexpr int NPHASES = 17;

extern "C" void kernel_launch(void* const* d_in, const int* in_sizes, int n_in, void* d_out, int out_size, void* d_ws, size_t ws_size, hipStream_t stream) {
    static int grid = 0;
    if (grid == 0) {
        if (n_in != 35 || in_sizes[0] != M * DM || out_size != M * DM || ws_size < WS_END) { fprintf(stderr, "kernel_launch: unexpected shapes: n_in %d in0 %d out %d ws %zu (need %zu)\n", n_in, n_in > 0 ? in_sizes[0] : -1, out_size, ws_size, (size_t)WS_END); grid = -1; return; }
        int dev = 0, cus = 0, per_cu = 0;
        if (hipGetDevice(&dev) != hipSuccess || hipDeviceGetAttribute(&cus, hipDeviceAttributeMultiprocessorCount, dev) != hipSuccess) { grid = -1; return; }
        if (hipFuncSetAttribute((const void*)yoco_fwd, hipFuncAttributeMaxDynamicSharedMemorySize, LDS_BYTES) != hipSuccess) { fprintf(stderr, "kernel_launch: hipFuncSetAttribute failed\n"); grid = -1; return; }
        if (hipOccupancyMaxActiveBlocksPerMultiprocessor(&per_cu, (const void*)yoco_fwd, NWAVES * 64, LDS_BYTES) != hipSuccess || per_cu < 1) { fprintf(stderr, "kernel_launch: occupancy query gives %d\n", per_cu); per_cu = 1; }
        (void)hipGetLastError();
        if (cus != 256) fprintf(stderr, "kernel_launch: built for a 256-CU device (one 256x256 unit per workgroup in the fused-epilogue GEMM phases); found %d CUs\n", cus);
        grid = cus;
    }
    if (grid < 0) return;
    if (hipMemsetAsync(d_ws, 0, CTL_ZERO_BYTES, stream) != hipSuccess) { fprintf(stderr, "kernel_launch: hipMemsetAsync failed\n"); return; }
    Args a{};
    for (int i = 0; i < 35; ++i) a.in[i] = d_in[i];
    a.out = (float*)d_out; a.ws = (unsigned char*)d_ws;
#if MK_N_LAUNCHES == 1
    a.lo = 0; a.hi = NPHASES;
    void* kargs[] = {&a};
    hipError_t e = hipLaunchCooperativeKernel((const void*)yoco_fwd, dim3(grid), dim3(NWAVES * 64), kargs, LDS_BYTES, stream);
    if (e != hipSuccess) fprintf(stderr, "kernel_launch: cooperative launch failed: %s (grid %d)\n", hipGetErrorString(e), grid);
#else
#ifndef DUP_MASK
#define DUP_MASK 0
#endif
    for (int p = 0; p < NPHASES; ++p) { a.lo = p; a.hi = p + 1; for (int r = 0; r < 1 + ((DUP_MASK >> p) & 1); ++r) hipLaunchKernelGGL(yoco_fwd, dim3(grid), dim3(NWAVES * 64), LDS_BYTES, stream, a); }
#endif
}
```

```cpp
#define MK_N_LAUNCHES 1
#include <hip/hip_runtime.h>
#include <hip/hip_bf16.h>
#include <cstdio>
#include <cstdint>
#include <cmath>
__host__ __device__ __forceinline__ size_t tidx(int r, int k, int K) { return ((size_t)(r >> 7) * (size_t)(K >> 6) + (size_t)(k >> 6)) * 8192 + (size_t)((r & 127) * 64 + (k & 63)); }
namespace pg8 {
#define PG8_LAS __attribute__((address_space(3)))
typedef unsigned short bf16_t;
typedef short bf16x8 __attribute__((ext_vector_type(8)));
typedef float f32x4 __attribute__((ext_vector_type(4)));
typedef unsigned u32x4 __attribute__((ext_vector_type(4)));
constexpr int BM = 256, BK = 64, HALF = 128, HTB = HALF * BK * 2  , STAGE_BYTES = 8 * HTB, NXCD = 8, WGM = 4;

__host__ __device__ __forceinline__ int lds_byte(int r, int c) { const int st = (r >> 4) * 2 + (c >> 5), rr = r & 15, cc = c & 31, ob = rr * 64 + cc * 2; return st * 1024 + (ob ^ (((ob >> 9) & 1) << 5)); }
__host__ __device__ __forceinline__ void stage_rc(int b, int& R, int& C) { const int st = b / 1024, sb = b % 1024, swz = sb ^ (((sb >> 9) & 1) << 5); R = (st >> 1) * 16 + swz / 64; C = (st & 1) * 32 + (swz % 64) / 2; }
__host__ __device__ __forceinline__ int perm32(int rho) { const int n = rho >> 4, i = rho & 15; return 8 * (i >> 2) + 4 * n + (i & 3); }

struct Unit { int pm, pn; };
struct Gemm { const bf16_t* A; const bf16_t* Bt; int M, N, K; };

struct StaticOrder {
    int nM, nN, nwg, G, c;
    __host__ __device__ void init(int M, int N, int G_, int c_) { nM = M / BM; nN = N / BM; nwg = nM * nN; G = G_; c = c_; }
    __host__ __device__ bool next(int i, Unit& u) const {
        const long L = (long)i * G + c; if (L >= nwg) return false;
        int wgid = (int)L; { const int q = nwg / NXCD, r = nwg % NXCD, xcd = wgid % NXCD, off = wgid / NXCD; wgid = (xcd < r ? xcd * (q + 1) : r * (q + 1) + (xcd - r) * q) + off; }
        const int nig = WGM * nN, gid = wgid / nig, fm = gid * WGM, gsz = (nM - fm) < WGM ? (nM - fm) : WGM;
        u.pm = fm + ((wgid % nig) % gsz); u.pn = (wgid % nig) / gsz; return true;
    }
    __device__ __forceinline__ void a_ready(const Unit&) const {}
    __device__ __forceinline__ void done(const Unit&) const {}
};

__device__ __forceinline__ unsigned cvt_pk_bf16(float lo, float hi) { unsigned r; asm volatile("v_cvt_pk_bf16_f32 %0, %1, %2" : "=v"(r) : "v"(lo), "v"(hi)); return r; }
typedef float f32x2 __attribute__((ext_vector_type(2)));
__device__ __forceinline__ f32x2 gelu_pk(f32x2 v) {
    const f32x2 av = __builtin_elementwise_abs(v), d = av * 0.2316418882f + 1.0f;
    f32x2 t; t.x = __builtin_amdgcn_rcpf(d.x); t.y = __builtin_amdgcn_rcpf(d.y);
    f32x2 q = t * 0.5307027145f + (-0.7265760135f); q = q * t + 0.7107068705f; q = q * t + (-0.142248368f); q = q * t + 0.127414796f; q = q * t;
    const f32x2 s = (v * v) * (-0.72134752044f);
    f32x2 e; e.x = __builtin_amdgcn_exp2f(s.x); e.y = __builtin_amdgcn_exp2f(s.y);
    const f32x2 m = v * (q * e), r = v - m;
    f32x2 o; o.x = v.x < 0.f ? m.x : r.x; o.y = v.y < 0.f ? m.y : r.y; return o;
}

template <int ACT  > struct EpiBf16 {
    static constexpr bool PERM = true, AFTER_DRAIN = false; static_assert(ACT == 0 || ACT == 1, "EpiBf16: ACT is 0 (none) or 1 (gelu_pk)");
    bf16_t* O; int ldc; const float* bias; int split_cols; size_t split_stride; float scale0;
    __device__ __forceinline__ void operator()(const f32x4 (&acc)[2][2][4][2], const Unit& u, int wr, int wc, int fr, int fq) const {
        const int row0 = u.pm * BM + wr * 64 + fr; int colt = u.pn * BM; bf16_t* base = O;
        float sc = 1.f; if (split_cols) { const int t = colt / split_cols; base += (size_t)t * split_stride; colt -= t * split_cols; if (t == 0) sc = scale0; }
        const int col0 = colt + wc * 32 + 8 * fq, bcol0 = u.pn * BM + wc * 32 + 8 * fq;
        f32x4 bv[2][2];
#pragma unroll
        for (int bj = 0; bj < 2; ++bj)
#pragma unroll
            for (int n = 0; n < 2; ++n) bv[bj][n] = bias ? *(const f32x4*)(bias + bcol0 + bj * HALF + 4 * n) : (f32x4){0.f, 0.f, 0.f, 0.f};
#pragma unroll
        for (int ai = 0; ai < 2; ++ai)
#pragma unroll
            for (int m = 0; m < 4; ++m) { bf16_t* rowp = base + (size_t)(row0 + ai * HALF + m * 16) * ldc + col0;
#pragma unroll
                for (int bj = 0; bj < 2; ++bj) { f32x4 v0 = acc[ai][bj][m][0] + bv[bj][0], v1 = acc[ai][bj][m][1] + bv[bj][1];
                    if (ACT == 1) { f32x2 a = gelu_pk((f32x2){v0[0], v0[1]}), b = gelu_pk((f32x2){v0[2], v0[3]}), c = gelu_pk((f32x2){v1[0], v1[1]}), d = gelu_pk((f32x2){v1[2], v1[3]});
                        v0 = (f32x4){a.x, a.y, b.x, b.y}; v1 = (f32x4){c.x, c.y, d.x, d.y}; }
                    v0 = v0 * sc; v1 = v1 * sc; u32x4 w; w.x = cvt_pk_bf16(v0[0], v0[1]); w.y = cvt_pk_bf16(v0[2], v0[3]); w.z = cvt_pk_bf16(v1[0], v1[1]); w.w = cvt_pk_bf16(v1[2], v1[3]);
                    *(u32x4*)(rowp + bj * HALF) = w; } }
    }
};
template <class Epi, class Sched, bool ALIGN_EPI = false, bool SP2 = false>
__device__ __forceinline__ void gemm_phase(PG8_LAS unsigned char* lds, const Gemm g, const Sched& S, const Epi& E, int tid_in) {
    const int tid = tid_in, wid = __builtin_amdgcn_readfirstlane(tid >> 6), lane = tid & 63, wr = wid >> 2, wc = wid & 3, fr = lane & 15, fq = lane >> 4;
    const int K = g.K, nt = K / BK;
    unsigned voffA[2], voffB[2];
#pragma unroll
    for (int i = 0; i < 2; ++i) { int R, C; stage_rc(tid * 16 + i * 8192, R, C); const int Rb = Epi::PERM ? ((R & ~31) + perm32(R & 31)) : R;
        voffA[i] = (unsigned)(R * BK + C) * 2u; voffB[i] = (unsigned)(Rb * BK + C) * 2u; }
    const size_t kstep = (size_t)(HALF * BK * 2);
    const size_t hstep = (size_t)HALF * K * 2;
    const size_t tstep = 2 * hstep;
    const unsigned ldsw = (unsigned)wid * 1024u;
    const int aoff = lds_byte(wr * 64 + fr, fq * 8), boff = lds_byte(wc * 32 + fr, fq * 8);
#define PG8_SA(b, h) (((b) * 2 + (h)) * HTB)
#define PG8_SB(b, h) ((4 + (b) * 2 + (h)) * HTB)
#define PG8_STAGE(bufoff, gbase, voff) do { _Pragma("unroll") for (int _i = 0; _i < 2; ++_i) \
        __builtin_amdgcn_global_load_lds((const unsigned*)((const char*)(gbase) + (voff)[_i]), (PG8_LAS unsigned*)(lds + (bufoff) + ldsw + _i * 8192), 16, 0, 0); } while (0)
#define PG8_LDA(dst, b, h) do { _Pragma("unroll") for (int m = 0; m < 4; ++m) _Pragma("unroll") for (int k = 0; k < 2; ++k) dst[m][k] = *(const PG8_LAS bf16x8*)(lds + PG8_SA(b, h) + aoff + m * 2048 + k * 1024); } while (0)
#define PG8_LDB(dst, b, h) do { _Pragma("unroll") for (int n = 0; n < 2; ++n) _Pragma("unroll") for (int k = 0; k < 2; ++k) dst[n][k] = *(const PG8_LAS bf16x8*)(lds + PG8_SB(b, h) + boff + n * 2048 + k * 1024); } while (0)
#define PG8_MMA(ai, bj, At, Bt) do { __builtin_amdgcn_s_setprio(1); _Pragma("unroll") for (int m = 0; m < 4; ++m) _Pragma("unroll") for (int n = 0; n < 2; ++n) _Pragma("unroll") for (int k = 0; k < 2; ++k) \
        acc[ai][bj][m][n] = __builtin_amdgcn_mfma_f32_16x16x32_bf16(Bt[n][k], At[m][k], acc[ai][bj][m][n], 0, 0, 0); __builtin_amdgcn_s_setprio(0); } while (0)
#define PG8_WAIT_V(n) asm volatile("s_waitcnt vmcnt(" #n ")" ::: "memory")
#define PG8_WAIT_L(n) asm volatile("s_waitcnt lgkmcnt(" #n ")" ::: "memory")
#define PG8_BAR __builtin_amdgcn_s_barrier()
#define PG8_SCHED __builtin_amdgcn_sched_barrier(0)
    Unit cur, nxt; int ui = 0;
    if (!S.next(0, cur)) return;
    f32x4 acc[2][2][4][2];
#pragma unroll
    for (int a = 0; a < 2; ++a)
#pragma unroll
        for (int b = 0; b < 2; ++b)
#pragma unroll
            for (int m = 0; m < 4; ++m)
#pragma unroll
                for (int n = 0; n < 2; ++n) acc[a][b][m][n] = (f32x4){0.f, 0.f, 0.f, 0.f};
    bf16x8 At[4][2], B0[2][2], B1[2][2];
    const char* cA = (const char*)g.A + (size_t)cur.pm * tstep; const char* cB = (const char*)g.Bt + (size_t)cur.pn * tstep;
    S.a_ready(cur);
    if constexpr (SP2) {
        PG8_STAGE(PG8_SB(0, 0), cB, voffB); PG8_STAGE(PG8_SB(0, 1), cB + hstep, voffB); PG8_STAGE(PG8_SA(0, 0), cA, voffA); PG8_STAGE(PG8_SA(0, 1), cA + hstep, voffA);
        if (wr == 1) PG8_BAR;
        PG8_WAIT_V(2); PG8_BAR;
        PG8_STAGE(PG8_SB(1, 0), cB + kstep, voffB); PG8_STAGE(PG8_SA(1, 0), cA + kstep, voffA); PG8_STAGE(PG8_SB(1, 1), cB + hstep + kstep, voffB);
        PG8_WAIT_V(6); PG8_BAR;
    } else {
        PG8_STAGE(PG8_SB(0, 0), cB, voffB); PG8_STAGE(PG8_SA(0, 0), cA, voffA); PG8_STAGE(PG8_SB(0, 1), cB + hstep, voffB); PG8_STAGE(PG8_SA(0, 1), cA + hstep, voffA);
        if (wr == 1) PG8_BAR;
        PG8_WAIT_V(4); PG8_BAR;
        PG8_STAGE(PG8_SB(1, 0), cB + kstep, voffB); PG8_STAGE(PG8_SA(1, 0), cA + kstep, voffA); PG8_STAGE(PG8_SB(1, 1), cB + hstep + kstep, voffB);
        PG8_WAIT_V(6); PG8_BAR;
    }
    for (;;) {
        const bool has_next = S.next(ui + 1, nxt);
        const char* nA = has_next ? (const char*)g.A + (size_t)nxt.pm * tstep : cA; const char* nB = has_next ? (const char*)g.Bt + (size_t)nxt.pn * tstep : cB;
        for (int t = 0; t < nt; t += 2) {
            const bool last = (t == nt - 2);
            const char* a1 = cA + (size_t)(t + 1) * kstep;
            const char* a2 = last ? nA : cA + (size_t)(t + 2) * kstep; const char* b2 = last ? nB : cB + (size_t)(t + 2) * kstep;
            const char* a3 = a2 + kstep; const char* b3 = b2 + kstep;
            if (last && has_next) S.a_ready(nxt);
            if constexpr (SP2) {
            PG8_LDB(B0, 0, 0); PG8_LDB(B1, 0, 1); PG8_SCHED; PG8_LDA(At, 0, 0); PG8_STAGE(PG8_SA(1, 1), a1 + hstep, voffA);
            PG8_WAIT_V(8); PG8_WAIT_L(0); PG8_BAR; PG8_MMA(0, 0, At, B0); PG8_MMA(0, 1, At, B1); PG8_BAR; PG8_SCHED;
            PG8_LDA(At, 0, 1); PG8_STAGE(PG8_SB(0, 0), b2, voffB); PG8_STAGE(PG8_SB(0, 1), b2 + hstep, voffB); PG8_STAGE(PG8_SA(0, 0), a2, voffA);
            PG8_WAIT_V(8); PG8_WAIT_L(0); PG8_BAR; PG8_MMA(1, 0, At, B0); PG8_MMA(1, 1, At, B1); PG8_BAR; PG8_SCHED;
            PG8_LDB(B0, 1, 0); PG8_LDB(B1, 1, 1); PG8_SCHED; PG8_LDA(At, 1, 0); PG8_STAGE(PG8_SA(0, 1), a2 + hstep, voffA);
            PG8_WAIT_V(8); PG8_WAIT_L(0); PG8_BAR; PG8_MMA(0, 0, At, B0); PG8_MMA(0, 1, At, B1); PG8_BAR; PG8_SCHED;
            PG8_LDA(At, 1, 1); PG8_STAGE(PG8_SB(1, 0), b3, voffB); PG8_STAGE(PG8_SB(1, 1), b3 + hstep, voffB); PG8_STAGE(PG8_SA(1, 0), a3, voffA);
            PG8_WAIT_V(8); PG8_WAIT_L(0); PG8_BAR; PG8_MMA(1, 0, At, B0); PG8_MMA(1, 1, At, B1); PG8_BAR; PG8_SCHED;
            } else {
            PG8_LDB(B0, 0, 0); PG8_SCHED; PG8_LDA(At, 0, 0); PG8_STAGE(PG8_SA(1, 1), a1 + hstep, voffA);
            PG8_WAIT_L(8); PG8_BAR; PG8_WAIT_L(0); PG8_MMA(0, 0, At, B0); PG8_BAR; PG8_SCHED;
            PG8_LDB(B1, 0, 1); PG8_STAGE(PG8_SB(0, 0), b2, voffB);
            PG8_BAR; PG8_WAIT_L(0); PG8_MMA(0, 1, At, B1); PG8_BAR;
            PG8_LDA(At, 0, 1); PG8_STAGE(PG8_SA(0, 0), a2, voffA);
            PG8_BAR; PG8_WAIT_L(0); PG8_MMA(1, 0, At, B0); PG8_BAR; PG8_SCHED;
            PG8_STAGE(PG8_SB(0, 1), b2 + hstep, voffB);
            PG8_WAIT_V(6); PG8_BAR; PG8_MMA(1, 1, At, B1); PG8_BAR;
            PG8_LDB(B0, 1, 0); PG8_SCHED; PG8_LDA(At, 1, 0); PG8_STAGE(PG8_SA(0, 1), a2 + hstep, voffA);
            PG8_WAIT_L(8); PG8_BAR; PG8_WAIT_L(0); PG8_MMA(0, 0, At, B0); PG8_BAR; PG8_SCHED;
            PG8_LDB(B1, 1, 1); PG8_STAGE(PG8_SB(1, 0), b3, voffB);
            PG8_BAR; PG8_WAIT_L(0); PG8_MMA(0, 1, At, B1); PG8_BAR;
            PG8_LDA(At, 1, 1); PG8_STAGE(PG8_SA(1, 0), a3, voffA);
            PG8_BAR; PG8_WAIT_L(0); PG8_MMA(1, 0, At, B0); PG8_BAR; PG8_SCHED;
            PG8_STAGE(PG8_SB(1, 1), b3 + hstep, voffB);
            PG8_WAIT_V(6); PG8_BAR; PG8_MMA(1, 1, At, B1); PG8_BAR;
            }
        }
        if constexpr (ALIGN_EPI) { if (wr == 0) PG8_BAR; }
        if constexpr (!Epi::AFTER_DRAIN) { E(acc, cur, wr, wc, fr, fq); S.done(cur); }
        if (!has_next) break;
#pragma unroll
        for (int a = 0; a < 2; ++a)
#pragma unroll
            for (int b = 0; b < 2; ++b)
#pragma unroll
                for (int m = 0; m < 4; ++m)
#pragma unroll
                    for (int n = 0; n < 2; ++n) acc[a][b][m][n] = (f32x4){0.f, 0.f, 0.f, 0.f};
        cur = nxt; cA = nA; cB = nB; ++ui;
        if constexpr (ALIGN_EPI) { if (wr == 1) PG8_BAR; }
    }
    PG8_WAIT_V(0);
    if constexpr (!ALIGN_EPI) { if (wr == 0) PG8_BAR; }
    PG8_BAR;
    if constexpr (Epi::AFTER_DRAIN) { E.fused(acc, cur, wr, wc, fr, fq, lds, wid, lane); S.done(cur); }
#undef PG8_SA
#undef PG8_SB
#undef PG8_STAGE
#undef PG8_LDA
#undef PG8_LDB
#undef PG8_MMA
#undef PG8_WAIT_V
#undef PG8_WAIT_L
#undef PG8_BAR
#undef PG8_SCHED
}
}
namespace pg8 {
constexpr int TAB_OFF = 131072 + 256, TAB_SLOTS = 6;
__device__ __forceinline__ int tab_slot(PG8_LAS const unsigned char* tab, const Unit& u) { const PG8_LAS int* tags = (const PG8_LAS int*)tab; const int tag = (u.pm << 8) | u.pn; int slot = 0;
#pragma unroll
    for (int i = 1; i < TAB_SLOTS; ++i) if (tags[i] == tag) slot = i;
    return slot; }
constexpr int NBIAS = 28672;
typedef unsigned u32x2 __attribute__((ext_vector_type(2)));
__device__ __forceinline__ float silu_f(float x) { return x * __builtin_amdgcn_rcpf(1.0f + __builtin_amdgcn_exp2f(-1.4426950408889634f * x)); }
__device__ __forceinline__ void row_rstd8(const float* ssq, int row0, int fq, float (&rstd)[2][4]) {
    f32x4 p[2][4][2];
#pragma unroll
    for (int ai = 0; ai < 2; ++ai)
#pragma unroll
        for (int m = 0; m < 4; ++m) { const float* q = ssq + (size_t)(row0 + ai * HALF + m * 16) * 32 + fq * 8; p[ai][m][0] = *(const f32x4*)q; p[ai][m][1] = *(const f32x4*)(q + 4); }
#pragma unroll
    for (int ai = 0; ai < 2; ++ai)
#pragma unroll
        for (int m = 0; m < 4; ++m) { float t = ((p[ai][m][0][0] + p[ai][m][0][1]) + (p[ai][m][0][2] + p[ai][m][0][3])) + ((p[ai][m][1][0] + p[ai][m][1][1]) + (p[ai][m][1][2] + p[ai][m][1][3]));
            t += __shfl_xor(t, 16); t += __shfl_xor(t, 32); rstd[ai][m] = 1.0f / sqrtf(t * (1.0f / 2048.0f) + 1e-6f); }
}
struct EpiGeluStats {
    static constexpr bool PERM = true, AFTER_DRAIN = false;
    bf16_t* O; int ldc; PG8_LAS const unsigned char* tab; float* stats;
    __device__ __forceinline__ void operator()(const f32x4 (&acc)[2][2][4][2], const Unit& u, int wr, int wc, int fr, int fq) const {
        const int row0 = u.pm * BM + wr * 64 + fr; const int col0 = u.pn * BM + wc * 32 + 8 * fq;
        const PG8_LAS float* bT = (const PG8_LAS float*)(tab + 64 + TAB_SLOTS * 1024) + tab_slot(tab, u) * 256;
        f32x4 bv[2][2];
#pragma unroll
        for (int bj = 0; bj < 2; ++bj)
#pragma unroll
            for (int n = 0; n < 2; ++n) bv[bj][n] = *(const PG8_LAS f32x4*)(bT + bj * HALF + wc * 32 + 8 * fq + 4 * n);
#pragma unroll
        for (int ai = 0; ai < 2; ++ai)
#pragma unroll
            for (int m = 0; m < 4; ++m) { const int row = row0 + ai * HALF + m * 16; bf16_t* rowp = O + (size_t)row * ldc + col0; float s1 = 0.f, s2 = 0.f;
#pragma unroll
                for (int bj = 0; bj < 2; ++bj) { f32x4 v0 = acc[ai][bj][m][0] + bv[bj][0], v1 = acc[ai][bj][m][1] + bv[bj][1];
                    f32x2 a = gelu_pk((f32x2){v0[0], v0[1]}), b = gelu_pk((f32x2){v0[2], v0[3]}), c = gelu_pk((f32x2){v1[0], v1[1]}), d = gelu_pk((f32x2){v1[2], v1[3]});
                    s1 += ((a.x + a.y) + (b.x + b.y)) + ((c.x + c.y) + (d.x + d.y));
                    s2 += ((a.x * a.x + a.y * a.y) + (b.x * b.x + b.y * b.y)) + ((c.x * c.x + c.y * c.y) + (d.x * d.x + d.y * d.y));
                    u32x4 w; w.x = cvt_pk_bf16(a.x, a.y); w.y = cvt_pk_bf16(b.x, b.y); w.z = cvt_pk_bf16(c.x, c.y); w.w = cvt_pk_bf16(d.x, d.y);
                    *(u32x4*)(rowp + bj * HALF) = w; }
                if (u.pn >= 8) { s1 += __shfl_xor(s1, 16); s1 += __shfl_xor(s1, 32); s2 += __shfl_xor(s2, 16); s2 += __shfl_xor(s2, 32);
                    if (fq == 0) *(f32x2*)(stats + ((size_t)row * 32 + (u.pn - 8) * 4 + wc) * 2) = (f32x2){s1, s2}; } }
    }
};
struct EpiSwiGLU {
    static constexpr bool PERM = true, AFTER_DRAIN = false;
    bf16_t* O; int ldc; PG8_LAS const unsigned char* tab;
    __device__ __forceinline__ void operator()(const f32x4 (&acc)[2][2][4][2], const Unit& u, int wr, int wc, int fr, int fq) const {
        const int row0 = u.pm * BM + wr * 64 + fr; const int col0 = u.pn * HALF + wc * 32 + 8 * fq;
        const int slot = tab_slot(tab, u);
        const PG8_LAS float* rT = (const PG8_LAS float*)(tab + 64) + slot * 256; const PG8_LAS float* bT = (const PG8_LAS float*)(tab + 64 + TAB_SLOTS * 1024) + slot * 256;
        float rstd[2][4];
#pragma unroll
        for (int ai = 0; ai < 2; ++ai)
#pragma unroll
            for (int m = 0; m < 4; ++m) rstd[ai][m] = rT[ai * HALF + wr * 64 + m * 16 + fr];
        f32x4 bv[2][2];
#pragma unroll
        for (int bj = 0; bj < 2; ++bj)
#pragma unroll
            for (int n = 0; n < 2; ++n) bv[bj][n] = *(const PG8_LAS f32x4*)(bT + bj * HALF + wc * 32 + 8 * fq + 4 * n);
#pragma unroll
        for (int ai = 0; ai < 2; ++ai)
#pragma unroll
            for (int m = 0; m < 4; ++m) { bf16_t* rowp = O + tidx(row0 + ai * HALF + m * 16, col0, ldc); const float rs = rstd[ai][m];
                const f32x4 g0 = acc[ai][0][m][0] * rs + bv[0][0], g1 = acc[ai][0][m][1] * rs + bv[0][1], u0 = acc[ai][1][m][0] * rs + bv[1][0], u1 = acc[ai][1][m][1] * rs + bv[1][1];
                u32x4 w; w.x = cvt_pk_bf16(silu_f(g0[0]) * u0[0], silu_f(g0[1]) * u0[1]); w.y = cvt_pk_bf16(silu_f(g0[2]) * u0[2], silu_f(g0[3]) * u0[3]);
                w.z = cvt_pk_bf16(silu_f(g1[0]) * u1[0], silu_f(g1[1]) * u1[1]); w.w = cvt_pk_bf16(silu_f(g1[2]) * u1[2], silu_f(g1[3]) * u1[3]);
                *(u32x4*)rowp = w; }
    }
};
template <bool NTB> struct EpiResNorm {
    static constexpr bool PERM = false, AFTER_DRAIN = false;
    const float* base; float* out; const float* gate; int gate_bstride; int ldc;
    const float* gam1; bf16_t* A1; const float* gam2; bf16_t* A2; float* ssq;
    __device__ __forceinline__ void operator()(f32x4 (&acc)[2][2][4][2], const Unit& u, int wr, int wc, int fr, int fq) const {
        const int row0 = u.pm * BM + wr * 64 + fr; const int col0 = u.pn * BM + wc * 32 + 4 * fq; const int b = u.pm >> 4;
        f32x4 gv[2][2], g1[2][2];
#pragma unroll
        for (int bj = 0; bj < 2; ++bj)
#pragma unroll
            for (int n = 0; n < 2; ++n) { gv[bj][n] = *(const f32x4*)(gate + (size_t)b * gate_bstride + col0 + bj * HALF + n * 16);
                g1[bj][n] = gam1 ? *(const f32x4*)(gam1 + (size_t)b * 2048 + col0 + bj * HALF + n * 16) : (f32x4){0.f, 0.f, 0.f, 0.f}; }
#pragma unroll
        for (int ai = 0; ai < 2; ++ai)
#pragma unroll
            for (int mh = 0; mh < 2; ++mh) { f32x4 t[2][2][2];
#pragma unroll
                for (int mm = 0; mm < 2; ++mm) { const size_t off = (size_t)(row0 + ai * HALF + (2 * mh + mm) * 16) * ldc + col0;
#pragma unroll
                    for (int bj = 0; bj < 2; ++bj)
#pragma unroll
                        for (int n = 0; n < 2; ++n) { if constexpr (NTB) t[mm][bj][n] = __builtin_nontemporal_load((const f32x4*)(base + off + bj * HALF + n * 16)); else t[mm][bj][n] = *(const f32x4*)(base + off + bj * HALF + n * 16); } }
#pragma unroll
                for (int mm = 0; mm < 2; ++mm) { const int m = 2 * mh + mm; const int row = row0 + ai * HALF + m * 16; const size_t off = (size_t)row * ldc + col0;
#pragma unroll
                    for (int bj = 0; bj < 2; ++bj)
#pragma unroll
                        for (int n = 0; n < 2; ++n) { acc[ai][bj][m][n] = t[mm][bj][n] + acc[ai][bj][m][n] * gv[bj][n]; *(f32x4*)(out + off + bj * HALF + n * 16) = acc[ai][bj][m][n]; }
                    if (gam1) { float ss = 0.f;
#pragma unroll
                        for (int bj = 0; bj < 2; ++bj)
#pragma unroll
                            for (int n = 0; n < 2; ++n) { const f32x4 x = acc[ai][bj][m][n]; ss += (x[0] * x[0] + x[1] * x[1]) + (x[2] * x[2] + x[3] * x[3]);
                                const f32x4 y = x * g1[bj][n]; u32x2 w; w.x = cvt_pk_bf16(y[0], y[1]); w.y = cvt_pk_bf16(y[2], y[3]); *(u32x2*)(A1 + tidx(row, col0 + bj * HALF + n * 16, 2048)) = w; }
                        ss += __shfl_xor(ss, 16); ss += __shfl_xor(ss, 32);
                        if (fq == 0) ssq[(size_t)row * 32 + u.pn * 4 + wc] = ss; } } }
        if (gam2) {
#pragma unroll
            for (int bj = 0; bj < 2; ++bj)
#pragma unroll
                for (int n = 0; n < 2; ++n) g1[bj][n] = *(const f32x4*)(gam2 + (size_t)b * 2048 + col0 + bj * HALF + n * 16);
#pragma unroll
            for (int ai = 0; ai < 2; ++ai)
#pragma unroll
                for (int m = 0; m < 4; ++m) { const int row = row0 + ai * HALF + m * 16;
#pragma unroll
                    for (int bj = 0; bj < 2; ++bj)
#pragma unroll
                        for (int n = 0; n < 2; ++n) { const f32x4 y = acc[ai][bj][m][n] * g1[bj][n]; u32x2 w; w.x = cvt_pk_bf16(y[0], y[1]); w.y = cvt_pk_bf16(y[2], y[3]); *(u32x2*)(A2 + tidx(row, col0 + bj * HALF + n * 16, 2048)) = w; } } }
    }
};
struct EpiQKRope {
    static constexpr bool PERM = false, AFTER_DRAIN = true;
    bf16_t* O; const float* g; const float* rt; const float* ssq; const float* bias;
    __device__ __forceinline__ void fused(f32x4 (&acc)[2][2][4][2], const Unit& u, int wr, int wc, int fr, int fq, PG8_LAS unsigned char* lds, int wid, int lane) const {
        PG8_LAS float* P = (PG8_LAS float*)lds;
        { float rstd[2][4]; row_rstd8(ssq, u.pm * BM + wr * 64 + fr, fq, rstd);
#pragma unroll
          for (int bj = 0; bj < 2; ++bj)
#pragma unroll
            for (int n = 0; n < 2; ++n) { const f32x4 bv = *(const f32x4*)(bias + (size_t)(u.pm >> 4) * NBIAS + u.pn * BM + bj * HALF + wc * 32 + 16 * n + 4 * fq);
#pragma unroll
                for (int ai = 0; ai < 2; ++ai)
#pragma unroll
                    for (int m = 0; m < 4; ++m) acc[ai][bj][m][n] = acc[ai][bj][m][n] * rstd[ai][m] + bv; } }
#pragma unroll
        for (int ai = 0; ai < 2; ++ai)
#pragma unroll
            for (int m = 0; m < 4; ++m)
#pragma unroll
                for (int bj = 0; bj < 2; ++bj) { const f32x4 a = acc[ai][bj][m][0], c = acc[ai][bj][m][1];
                    float ss = ((a[0] * a[0] + a[1] * a[1]) + (a[2] * a[2] + a[3] * a[3])) + ((c[0] * c[0] + c[1] * c[1]) + (c[2] * c[2] + c[3] * c[3]));
                    ss += __shfl_xor(ss, 16); ss += __shfl_xor(ss, 32);
                    if (fq == 0) P[((ai * HALF + wr * 64 + m * 16 + fr) * 2 + bj) * 4 + wc] = ss; }
        asm volatile("s_waitcnt lgkmcnt(0)" ::: "memory"); __builtin_amdgcn_s_barrier(); asm volatile("" ::: "memory");
        const int d = 16 * wc + 4 * fq; const f32x4 ga = *(const f32x4*)(g + d), gb = *(const f32x4*)(g + 64 + d);
#pragma unroll
        for (int ai = 0; ai < 2; ++ai)
#pragma unroll
            for (int m = 0; m < 4; ++m) { const int rl = ai * HALF + wr * 64 + m * 16 + fr, row = u.pm * BM + rl, b = row >> 12, s = row & 4095;
                const f32x4 cs0 = *(const f32x4*)(rt + ((size_t)row * 64 + d) * 2), cs1 = *(const f32x4*)(rt + ((size_t)row * 64 + d) * 2 + 4);
                const float co[4] = {cs0[0], cs0[2], cs1[0], cs1[2]}, si[4] = {cs0[1], cs0[3], cs1[1], cs1[3]};
#pragma unroll
                for (int bj = 0; bj < 2; ++bj) { const f32x4 pp = *(const PG8_LAS f32x4*)(P + (rl * 2 + bj) * 4);
                    const float rstd = 1.0f / sqrtf(((pp[0] + pp[1]) + (pp[2] + pp[3])) * (1.0f / 128.0f) + 1e-6f);
                    const f32x4 x1 = acc[ai][bj][m][0] * rstd * ga, x2 = acc[ai][bj][m][1] * rstd * gb; float o1[4], o2[4];
#pragma unroll
                    for (int i = 0; i < 4; ++i) { o1[i] = x1[i] * co[i] - x2[i] * si[i]; o2[i] = x2[i] * co[i] + x1[i] * si[i]; }
                    bf16_t* op = O + ((size_t)(b * 16 + 2 * u.pn + bj) * 4096 + s) * 128 + d;
                    u32x2 w1, w2; w1.x = cvt_pk_bf16(o1[0], o1[1]); w1.y = cvt_pk_bf16(o1[2], o1[3]); w2.x = cvt_pk_bf16(o2[0], o2[1]); w2.y = cvt_pk_bf16(o2[2], o2[3]);
                    *(u32x2*)op = w1; *(u32x2*)(op + 64) = w2; } }
        asm volatile("s_waitcnt lgkmcnt(0)" ::: "memory"); __builtin_amdgcn_s_barrier(); asm volatile("" ::: "memory");
    }
};
struct EpiVhead {
    static constexpr bool PERM = true, AFTER_DRAIN = false;
    bf16_t* O; const float* ssq; const float* bias;
    __device__ __forceinline__ void operator()(const f32x4 (&acc)[2][2][4][2], const Unit& u, int wr, int wc, int fr, int fq) const {
        const int row0 = u.pm * BM + wr * 64 + fr;
        float rstd[2][4]; row_rstd8(ssq, row0, fq, rstd);
        f32x4 bv[2][2];
#pragma unroll
        for (int bj = 0; bj < 2; ++bj)
#pragma unroll
            for (int n = 0; n < 2; ++n) bv[bj][n] = *(const f32x4*)(bias + (size_t)(u.pm >> 4) * NBIAS + u.pn * BM + bj * HALF + wc * 32 + 8 * fq + 4 * n);
#pragma unroll
        for (int ai = 0; ai < 2; ++ai)
#pragma unroll
            for (int m = 0; m < 4; ++m) { const int row = row0 + ai * HALF + m * 16, b = row >> 12, s = row & 4095; const float rs = rstd[ai][m];
#pragma unroll
                for (int bj = 0; bj < 2; ++bj) { bf16_t* p = O + ((size_t)(b * 16 + 2 * u.pn + bj) * 4096 + s) * 128 + wc * 32 + 8 * fq;
                    const f32x4 v0 = acc[ai][bj][m][0] * rs + bv[bj][0], v1 = acc[ai][bj][m][1] * rs + bv[bj][1];
                    u32x4 w; w.x = cvt_pk_bf16(v0[0], v0[1]); w.y = cvt_pk_bf16(v0[2], v0[3]); w.z = cvt_pk_bf16(v1[0], v1[1]); w.w = cvt_pk_bf16(v1[2], v1[3]);
                    *(u32x4*)p = w; } }
    }
};
}
namespace att {
constexpr int D = 128; constexpr float THR = 8.f; constexpr bool WSKIP = false;
constexpr float SCALE = 0.08838834764831845f;
constexpr int NW = 8, QBLK = 32, KVBLK = 64, QB = NW * QBLK;
constexpr int SHM_V = KVBLK * D * 2, SHM_K = KVBLK * D * 2;
constexpr int LDS_BYTES = 2 * SHM_V + 2 * SHM_K + NW * 64 * 4;
using bf16 = __hip_bfloat16;
typedef short bf16x8 __attribute__((ext_vector_type(8)));
typedef short s16x4 __attribute__((ext_vector_type(4)));
typedef float f32x16 __attribute__((ext_vector_type(16)));
typedef float f32x4 __attribute__((ext_vector_type(4)));
typedef unsigned u32x4 __attribute__((ext_vector_type(4)));
template <class A, class Bt> struct same_t { static constexpr bool v = false; };
template <class A> struct same_t<A, A> { static constexpr bool v = true; };

#define KSWZ(row, colB) ((row) * 256 + ((colB) ^ (((row) & 7) << 4)))
#define SBAR() __builtin_amdgcn_sched_barrier(0)
__device__ __forceinline__ int v_st(int k, int c) { const int kk = (k & ~0xC) | ((k & 4) << 1) | ((k & 8) >> 1); return ((kk >> 3) * 4 + (c >> 5)) * 512 + ((kk & 7) * 32 + (c & 31)) * 2; }
__device__ __forceinline__ int v_rd_base(int lane) { return ((lane & 3) << 3) | (((lane >> 2) & 3) << 6) | (((lane >> 4) & 1) << 5) | (((lane >> 5) & 1) << 8); }
constexpr int v_rd_off(int d0, int ks, int half) { return d0 * 512 + ks * 4096 + half * 2048; }
__device__ __forceinline__ int crow(int r, int hi) { return (r & 3) + 8 * (r >> 2) + 4 * hi; }
__device__ __forceinline__ unsigned cvtpk(float lo, float hi) {
    unsigned r; asm volatile("v_cvt_pk_bf16_f32 %0, %1, %2" : "=v"(r) : "v"(lo), "v"(hi)); return r;
}
__device__ __forceinline__ bf16x8 pack8(f32x4 a, f32x4 b) {
    u32x4 w = {cvtpk(a[0], a[1]), cvtpk(a[2], a[3]), cvtpk(b[0], b[1]), cvtpk(b[2], b[3])};
    return *reinterpret_cast<bf16x8*>(&w);
}
template <class T> __device__ __forceinline__ bf16x8 load8(const T* p) {
    if constexpr (same_t<T, float>::v) { return pack8(*(const f32x4*)p, *(const f32x4*)(p + 4)); }
    else { return *reinterpret_cast<const bf16x8*>(p); }
}
__device__ __forceinline__ void mask_tile(f32x16& p0, f32x16& p1, int dq, unsigned W) {
    const float NEG = -__builtin_inff();
#pragma unroll
    for (int r = 0; r < 16; ++r) {
        const int c = (r & 3) + 8 * (r >> 2);
        if ((unsigned)(dq - c) >= W) p0[r] = NEG;
        if ((unsigned)(dq - c - 32) >= W) p1[r] = NEG;
    }
}
__device__ __forceinline__ void partialSM(f32x16& p0, f32x16& p1, float& m_reg, float& mn, float& alpha) {
    float pmax = p0[0]; for (int r = 1; r < 16; ++r) pmax = fmaxf(pmax, p0[r]); for (int r = 0; r < 16; ++r) pmax = fmaxf(pmax, p1[r]);
    { auto rr = __builtin_amdgcn_permlane32_swap(__float_as_uint(pmax), __float_as_uint(pmax), false, false);
      pmax = fmaxf(__uint_as_float(rr[0]), __uint_as_float(rr[1])); }
    constexpr float C2 = 1.4426950408889634f * SCALE;
    if (__builtin_expect(__all((pmax - m_reg) * SCALE <= THR), 1)) { mn = m_reg; alpha = 1.f; }
    else { mn = fmaxf(m_reg, pmax); alpha = __builtin_amdgcn_exp2f((m_reg - mn) * C2); m_reg = mn; }
    const float mnL = -mn * C2;
    for (int r = 0; r < 16; ++r) p0[r] = fmaf(p0[r], C2, mnL); for (int r = 0; r < 16; ++r) p1[r] = fmaf(p1[r], C2, mnL);
    for (int r = 0; r < 16; ++r) p0[r] = __builtin_amdgcn_exp2f(p0[r]);
}
__device__ __forceinline__ void finishSM(f32x16& p0, f32x16& p1, float alpha, float& l_reg, bf16x8& pa0, bf16x8& pa1, bf16x8& pa2, bf16x8& pa3) {
    for (int r = 0; r < 16; ++r) p1[r] = __builtin_amdgcn_exp2f(p1[r]);
    float ps = 0; for (int r = 0; r < 16; ++r) ps += p0[r]; for (int r = 0; r < 16; ++r) ps += p1[r];
    { auto rr = __builtin_amdgcn_permlane32_swap(__float_as_uint(ps), __float_as_uint(ps), false, false);
      ps = __uint_as_float(rr[0]) + __uint_as_float(rr[1]); }
    l_reg = l_reg * alpha + ps;
#define PK4(P, B_, OUT) do { unsigned a0 = cvtpk(P[B_+0], P[B_+1]), a1 = cvtpk(P[B_+2], P[B_+3]);                          \
        unsigned b0 = cvtpk(P[B_+4], P[B_+5]), b1 = cvtpk(P[B_+6], P[B_+7]);                                             \
        auto r0 = __builtin_amdgcn_permlane32_swap(a0, b0, false, false); auto r1 = __builtin_amdgcn_permlane32_swap(a1, b1, false, false); \
        u32x4 w = {r0[0], r1[0], r0[1], r1[1]}; OUT = *reinterpret_cast<bf16x8*>(&w); } while (0)
    PK4(p0, 0, pa0); PK4(p0, 8, pa1); PK4(p1, 0, pa2); PK4(p1, 8, pa3);
#undef PK4
}
template <int KB, bool SK>
__device__ __forceinline__ void qkt(f32x16& p0, f32x16& p1, const char* K_lds, int r32, int hi, const bf16x8* qr, bool act) {
    if (SK && !act) { const float NEG = -__builtin_inff();
#pragma unroll
        for (int r = 0; r < 16; ++r) { p0[r] = NEG; p1[r] = NEG; } return; }
    p0 = f32x16{}; p1 = f32x16{};
    const char* kb[4];
#pragma unroll
    for (int dd = 0; dd < 4; ++dd) kb[dd] = K_lds + KB * SHM_K + KSWZ(r32, (dd * 16 + hi * 8) * 2);
#pragma unroll
    for (int d0 = 0; d0 < 8; ++d0) { const char* a = kb[d0 & 3] + (d0 >> 2) * 128;
        bf16x8 b0 = *reinterpret_cast<const bf16x8*>(a);
        bf16x8 b1 = *reinterpret_cast<const bf16x8*>(a + 32 * 256);
        p0 = __builtin_amdgcn_mfma_f32_32x32x16_bf16(b0, qr[d0], p0, 0, 0, 0);
        p1 = __builtin_amdgcn_mfma_f32_32x32x16_bf16(b1, qr[d0], p1, 0, 0, 0); }
}
template <int VB, bool SK>
__device__ __forceinline__ void pv_tile(f32x16* o, int vb0, bf16x8 pa0, bf16x8 pa1, bf16x8 pa2, bf16x8 pa3, bool act) {
    if (SK && !act) return;
#define TRRD(dst, off) asm volatile("ds_read_b64_tr_b16 %0, %1 offset:%2" : "=&v"(dst) : "v"(vb0), "i"(off) : "memory")
#define PV_D0(d0) do { s16x4 l0, l1, l2, l3, h0, h1, h2, h3; constexpr int b_ = VB * SHM_V + v_rd_off(d0, 0, 0);     \
        TRRD(l0, b_); TRRD(h0, b_ + 2048); TRRD(l1, b_ + 4096); TRRD(h1, b_ + 6144); TRRD(l2, b_ + 8192); TRRD(h2, b_ + 10240); TRRD(l3, b_ + 12288); TRRD(h3, b_ + 14336); \
        asm volatile("s_waitcnt lgkmcnt(0)" ::: "memory"); SBAR();                 \
        o[d0] = __builtin_amdgcn_mfma_f32_32x32x16_bf16(pa0, (bf16x8){l0[0], l0[1], l0[2], l0[3], h0[0], h0[1], h0[2], h0[3]}, o[d0], 0, 0, 0);   \
        o[d0] = __builtin_amdgcn_mfma_f32_32x32x16_bf16(pa1, (bf16x8){l1[0], l1[1], l1[2], l1[3], h1[0], h1[1], h1[2], h1[3]}, o[d0], 0, 0, 0);   \
        o[d0] = __builtin_amdgcn_mfma_f32_32x32x16_bf16(pa2, (bf16x8){l2[0], l2[1], l2[2], l2[3], h2[0], h2[1], h2[2], h2[3]}, o[d0], 0, 0, 0);   \
        o[d0] = __builtin_amdgcn_mfma_f32_32x32x16_bf16(pa3, (bf16x8){l3[0], l3[1], l3[2], l3[3], h3[0], h3[1], h3[2], h3[3]}, o[d0], 0, 0, 0); } while (0)
    PV_D0(0); PV_D0(1); PV_D0(2); PV_D0(3);
#undef PV_D0
#undef TRRD
}

template <class TIn, class TOut> struct BlockRef { const TIn* Q; const TIn* K; const TIn* V; TOut* O; int P0; };
template <class TIn> struct Seam {
    bf16x8 qr[8];
    bf16x8 st_v0, st_v1, st_k0, st_k1; f32x4 sf0, sf1, sf2, sf3;
    f32x4 tq[16];
};
__device__ __forceinline__ int swa_jlo(int P0, int W) { const int lowk = P0 - W + 1; return lowk > 0 ? lowk / KVBLK : 0; }
#define ROW(p, k0, rr) ((p) + (size_t)((k0) + (rr)) * D + sc)
#define VMW() asm volatile("s_waitcnt vmcnt(0)" ::: "memory")
#define VMWN(n) asm volatile("s_waitcnt vmcnt(%0)" :: "i"(n) : "memory")
#define SLOAD_H(Kp, Vp, k0) do { S.st_v0 = load8<TIn>(ROW(Vp, k0, sr)); S.st_v1 = load8<TIn>(ROW(Vp, k0, 32 + sr));              \
                         S.st_k0 = load8<TIn>(ROW(Kp, k0, sr)); S.st_k1 = load8<TIn>(ROW(Kp, k0, 32 + sr)); } while (0)
#define SWRITE_HK(bf) do { *(bf16x8*)(K_lds + (bf) * SHM_K + kws) = S.st_k0; *(bf16x8*)(K_lds + (bf) * SHM_K + kws + 32 * 256) = S.st_k1; } while (0)
#define SWRITE_HV(bf) do { *(bf16x8*)(V_lds + (bf) * SHM_V + vst0) = S.st_v0; *(bf16x8*)(V_lds + (bf) * SHM_V + vst1) = S.st_v1; } while (0)
#define SWRITE_H(bf) do { SWRITE_HV(bf); SWRITE_HK(bf); } while (0)
#define SLOAD_F(p, k0) do { S.sf0 = *(const f32x4*)ROW(p, k0, sr); S.sf1 = *(const f32x4*)(ROW(p, k0, sr) + 4);                \
                            S.sf2 = *(const f32x4*)ROW(p, k0, 32 + sr); S.sf3 = *(const f32x4*)(ROW(p, k0, 32 + sr) + 4); } while (0)
#define SWRITE_KF(bf) do { *(bf16x8*)(K_lds + (bf) * SHM_K + kws) = pack8(S.sf0, S.sf1); *(bf16x8*)(K_lds + (bf) * SHM_K + kws + 32 * 256) = pack8(S.sf2, S.sf3); } while (0)
#define SWRITE_VF(bf) do { *(bf16x8*)(V_lds + (bf) * SHM_V + vst0) = pack8(S.sf0, S.sf1); *(bf16x8*)(V_lds + (bf) * SHM_V + vst1) = pack8(S.sf2, S.sf3); } while (0)
template <class TIn, class TOut>
__device__ __forceinline__ void causal_swa_prime(const BlockRef<TIn, TOut>& cur, int W, char* lds, Seam<TIn>& S, int tid_in) {
    constexpr bool F32 = same_t<TIn, float>::v;
    const int tid = tid_in, wid = __builtin_amdgcn_readfirstlane(tid >> 6), lane = tid & 63, r32 = lane & 31, hi = lane >> 5;
    const int sr = tid >> 4, sc = (tid & 15) * 8, kws = KSWZ(sr, sc * 2); char* K_lds = lds + 2 * SHM_V;
    const int kb0 = swa_jlo(cur.P0, W) * KVBLK;
    for (int d0 = 0; d0 < 8; ++d0) S.qr[d0] = load8<TIn>(cur.Q + (size_t)(wid * QBLK + r32) * D + d0 * 16 + hi * 8);
    if constexpr (F32) { SLOAD_F((const float*)cur.K, kb0); VMW(); SWRITE_KF(0); SBAR(); SLOAD_F((const float*)cur.V, kb0); }
    else { SLOAD_H(cur.K, cur.V, kb0); VMW(); SWRITE_HK(0); }
    __syncthreads();
}
template <class TIn, class TOut>
__device__ __forceinline__ void causal_swa_block(const BlockRef<TIn, TOut>& cur, const BlockRef<TIn, TOut>& nxt, int skv, int W, char* lds, Seam<TIn>& S, int tid_in) {
    constexpr bool F32 = same_t<TIn, float>::v;
    const int tid = tid_in, wid = __builtin_amdgcn_readfirstlane(tid >> 6), lane = tid & 63, r32 = lane & 31, hi = lane >> 5;
    const int j_lo = swa_jlo(cur.P0, W);
    int j_hi = (cur.P0 + QB - 1) / KVBLK + 1; if (j_hi > skv / KVBLK) j_hi = skv / KVBLK;
    const int NT = j_hi - j_lo;
    const int kbn = swa_jlo(nxt.P0, W) * KVBLK;
    const int qlo = cur.P0 + wid * QBLK, qm = qlo + r32 - 4 * hi;
    char* V_lds = lds; char* K_lds = lds + 2 * SHM_V;
    float* ws = (float*)(lds + 2 * SHM_V + 2 * SHM_K) + wid * 64; float* li_l = ws, * al_l = ws + 32;
    float m_reg = -1e30f, l_reg = 0; f32x16 o[4] = {};
    const int sr = tid >> 4, sc = (tid & 15) * 8, vst0 = v_st(sr, sc), vst1 = v_st(32 + sr, sc), kws = KSWZ(sr, sc * 2);
    const int vb0 = (int)(uintptr_t)V_lds + v_rd_base(lane);
    const TIn* Kh = cur.K; const TIn* Vh = cur.V;
#define RESC(a) do { if (__any((a) < 1.f)) { if (hi == 0) al_l[r32] = (a); asm volatile("s_waitcnt lgkmcnt(0)" ::: "memory");              \
                     for (int d_ = 0; d_ < 4; ++d_) for (int r = 0; r < 16; ++r) o[d_][r] *= al_l[crow(r, hi)]; } } while (0)
#define KBASE(t) ((j_lo + (t)) * KVBLK)
#define ACT(t) (KBASE(t) <= qlo + QBLK - 1 && KBASE(t) + KVBLK - 1 >= qlo - W + 1)
#define MASKT(P0_, P1_, t) do { const int kb_ = KBASE(t); if ((!SK || ACT(t)) && (kb_ + KVBLK - 1 > qlo || kb_ <= qlo + QBLK - 1 - W)) mask_tile(P0_, P1_, qm - kb_, (unsigned)W); } while (0)
    constexpr int NQL = F32 ? 16 : 8;
    constexpr bool SK = WSKIP && !F32;
#define SEAM_K0() do { VMWN(NQL); if constexpr (F32) { SWRITE_KF(0); SBAR(); SLOAD_F((const float*)nxt.V, kbn); } else { SWRITE_HK(0); } SBAR(); } while (0)
    f32x16 pA0, pA1, pB0, pB1; float mnA, mnB, alA, alB; bf16x8 pa0, pa1, pa2, pa3;
    if constexpr (F32) { VMW(); SWRITE_VF(0); SBAR(); } else { SWRITE_HV(0); SBAR(); }
    if (NT > 1) { if constexpr (F32) SLOAD_F((const float*)Kh, KBASE(1)); else SLOAD_H(Kh, Vh, KBASE(1)); }
    SBAR(); qkt<0, SK>(pA0, pA1, K_lds, r32, hi, S.qr, ACT(0));
    if constexpr (F32) { if (NT > 1) { VMW(); SWRITE_KF(1); SBAR(); SLOAD_F((const float*)Vh, KBASE(1)); } }
    MASKT(pA0, pA1, 0); partialSM(pA0, pA1, m_reg, mnA, alA);
    if (NT > 1) { VMW(); if constexpr (F32) { SWRITE_VF(1); SBAR(); if (NT > 2) SLOAD_F((const float*)Kh, KBASE(2)); } else SWRITE_H(1); }
    __syncthreads();
#define HALF_STEP(PX0, PX1, mnX, alX, PY0, PY1, alY, t, KB, VB, SB) do {                                                      \
        SBAR(); qkt<KB, SK>(PX0, PX1, K_lds, r32, hi, S.qr, ACT(t));                                             \
        finishSM(PY0, PY1, alY, l_reg, pa0, pa1, pa2, pa3); SBAR();                                                           \
        if ((t) + 1 < NT) { if constexpr (F32) { VMW(); SWRITE_KF(SB); SBAR(); SLOAD_F((const float*)Vh, KBASE((t) + 1)); }  \
                            else { SLOAD_H(Kh, Vh, KBASE((t) + 1)); } SBAR(); }                                               \
        pv_tile<VB, SK>(o, vb0, pa0, pa1, pa2, pa3, ACT((t) - 1)); MASKT(PX0, PX1, (t)); partialSM(PX0, PX1, m_reg, mnX, alX);                                        \
        __syncthreads();                                                                                                      \
        if ((t) + 1 < NT) { VMW(); if constexpr (F32) { SWRITE_VF(SB); SBAR(); if ((t) + 2 < NT) SLOAD_F((const float*)Kh, KBASE((t) + 2)); } \
                            else { SWRITE_H(SB); } }                                                                          \
        RESC(alX); __syncthreads(); } while (0)
    for (int t = 1; t + 1 < NT; t += 2) {
        HALF_STEP(pB0, pB1, mnB, alB, pA0, pA1, alA, t, 1, 0, 0);
        HALF_STEP(pA0, pA1, mnA, alA, pB0, pB1, alB, t + 1, 0, 1, 1);
    }
    const bool even = (NT & 1) == 0;
    if (even) { SBAR(); qkt<1, SK>(pB0, pB1, K_lds, r32, hi, S.qr, ACT(NT - 1)); SBAR(); }
#define QROW(e) (nxt.Q + (size_t)(wid * QBLK + r32) * D + ((e) >> 1) * 16 + hi * 8 + ((e) & 1) * 4)
    if constexpr (F32) { SLOAD_F((const float*)nxt.K, kbn); SBAR();
#pragma unroll
        for (int e = 0; e < 8; ++e) S.tq[e] = *(const f32x4*)QROW(e); }
    else { SLOAD_H(nxt.K, nxt.V, kbn); SBAR();
#pragma unroll
        for (int d0 = 0; d0 < 8; ++d0) S.qr[d0] = load8<TIn>(nxt.Q + (size_t)(wid * QBLK + r32) * D + d0 * 16 + hi * 8); }
    SBAR();
    finishSM(pA0, pA1, alA, l_reg, pa0, pa1, pa2, pa3); SBAR();
    if constexpr (F32) {
#pragma unroll
        for (int e = 8; e < 16; ++e) S.tq[e] = *(const f32x4*)QROW(e); SBAR(); }
#undef QROW
    pv_tile<0, SK>(o, vb0, pa0, pa1, pa2, pa3, ACT(even ? NT - 2 : NT - 1));
    if (even) { MASKT(pB0, pB1, NT - 1); partialSM(pB0, pB1, m_reg, mnB, alB); __syncthreads(); RESC(alB);
        finishSM(pB0, pB1, alB, l_reg, pa0, pa1, pa2, pa3); SBAR(); pv_tile<1, SK>(o, vb0, pa0, pa1, pa2, pa3, ACT(NT - 1)); }
    SBAR(); SEAM_K0();
    if (hi == 0) li_l[r32] = l_reg; asm volatile("s_waitcnt lgkmcnt(0)" ::: "memory");
    float rli[16];
#pragma unroll
    for (int r = 0; r < 16; ++r) rli[r] = __builtin_amdgcn_rcpf(li_l[crow(r, hi)]);
    TOut* Ow = cur.O + (size_t)(wid * QBLK) * D;
#pragma unroll
    for (int r = 0; r < 16; ++r) { const int orow = crow(r, hi);
#pragma unroll
        for (int d0 = 0; d0 < 4; ++d0) { const float v = o[d0][r] * rli[r];
            if constexpr (same_t<TOut, float>::v) { Ow[(size_t)orow * D + d0 * 32 + r32] = v; }
            else { const float vn = __shfl_xor(v, 1);
                   if ((r32 & 1) == 0) *(unsigned*)(Ow + (size_t)orow * D + d0 * 32 + r32) = cvtpk(v, vn); } } }
    if constexpr (F32) {
#pragma unroll
        for (int d0 = 0; d0 < 8; ++d0) S.qr[d0] = pack8(S.tq[2 * d0], S.tq[2 * d0 + 1]); }
    __syncthreads();
#undef RESC
#undef KBASE
#undef ACT
#undef MASKT
#undef SEAM_K0
#undef HALF_STEP
}
#undef ROW
#undef VMW
#undef VMWN
#undef SLOAD_H
#undef SWRITE_HK
#undef SWRITE_HV
#undef SWRITE_H
#undef SLOAD_F
#undef SWRITE_KF
#undef SWRITE_VF
}
#include <hip/hip_cooperative_groups.h>
namespace cg = cooperative_groups;
#ifndef MK_N_LAUNCHES
#define MK_N_LAUNCHES 1
#endif
constexpr int NWAVES = 8;
constexpr int BATCH = 2, SEQ = 4096, DM = 2048, M = BATCH * SEQ, DFF = 5632, NMOD = 28672;
constexpr int MOD_A = 0, MOD_KV = 12288, MOD_B = 16384;
constexpr float EPS = 1e-6f;
constexpr float LAM_INIT = 0.35550906759f;
constexpr size_t MiB = 1u << 20;
constexpr size_t WS_MODS = 1 * MiB, WS_RT = 2 * MiB, WS_STATS = 6 * MiB;
constexpr size_t WS_W_IN = 8 * MiB, WS_W_OUT = 24 * MiB, WS_W_FIA = 32 * MiB, WS_W_FOA = 76 * MiB, WS_W_KV = 98 * MiB, WS_W_Q = 114 * MiB, WS_W_O = 122 * MiB, WS_W_FIB = 130 * MiB, WS_W_FOB = 174 * MiB;
constexpr size_t WS_XA = 196 * MiB, WS_XB = 260 * MiB, WS_XN = 324 * MiB, WS_XQ = 356 * MiB, WS_A3 = 388 * MiB, WS_Z = 420 * MiB, WS_QRAW = 420 * MiB, WS_H = 484 * MiB, WS_KRAW = 484 * MiB;
constexpr size_t WS_O = 420 * MiB, WS_VB = 548 * MiB, WS_KB = 580 * MiB, WS_QB = 612 * MiB, WS_SSQ = 644 * MiB, WS_END = 646 * MiB;
constexpr size_t WS_GAM = WS_MODS + 256 * 1024, WS_BIAS = WS_MODS + 512 * 1024;
constexpr int OFF_FIA = 0, OFF_KV = 11264, OFF_Q = 15360, OFF_FIB = 17408;
constexpr int LDS_BYTES = 147456;

#define GAS __attribute__((address_space(1)))
#define LAS __attribute__((address_space(3)))
typedef unsigned short hb;
typedef unsigned v4u __attribute__((ext_vector_type(4)));
typedef unsigned v2u __attribute__((ext_vector_type(2)));
typedef float f32x4 __attribute__((ext_vector_type(4)));
typedef float f32x2 __attribute__((ext_vector_type(2)));
typedef short bf16x8 __attribute__((ext_vector_type(8)));
#define LDS_WAIT() asm volatile("s_waitcnt lgkmcnt(0)" ::: "memory")
__device__ __forceinline__ unsigned f2bf(float f) { unsigned u = __builtin_bit_cast(unsigned, f); return (u + 0x7fffu + ((u >> 16) & 1u)) >> 16; }
__device__ __forceinline__ unsigned pk2(float lo, float hi) { return f2bf(lo) | (f2bf(hi) << 16); }
__device__ __forceinline__ float bflo(unsigned w) { return __builtin_bit_cast(float, w << 16); }
__device__ __forceinline__ float bfhi(unsigned w) { return __builtin_bit_cast(float, w & 0xffff0000u); }
__device__ __forceinline__ float wave_sum(float v) {
#pragma unroll
    for (int o = 1; o < 64; o <<= 1) v += __shfl_xor(v, o);
    return v;
}

__device__ __forceinline__ int wt_rowmap(int n, int mode, int N, int rope_lim) {
    if (mode == 1) { const int half = N / 2; const int mm = n < half ? n : n - half; return 256 * (mm / 128) + (mm % 128) + (n < half ? 0 : 128); }
    if (mode == 2 && n < rope_lim) { const int d = n & 127; return (n & ~127) + 32 * ((d & 63) >> 4) + 16 * (d >> 6) + 4 * ((d & 15) >> 2) + (d & 3); }
    return n;
}
struct TrItem { const float* W; hb* WT; int K, N, mode, lim, k0, n0; };
__device__ __forceinline__ void tr_load(const TrItem& t, float (&tv)[32], int lane) {
#pragma unroll
    for (int i = 0; i < 32; ++i) { const int kk = 2 * i + (lane >> 5); tv[i] = __builtin_nontemporal_load(t.W + (size_t)(t.k0 + kk) * t.N + t.n0 + (lane & 31)); }
}

#define XB_TMO      128
#define XB_XCNT(j)  (256  + 64 * (j))
#define XB_XSUB(j)  (1280 + 64 * (j))
#define XB_XGEN(j)  (2304 + 64 * (j))
#define XB_TOP      3328
#define XB_TOPGEN   3392
#define XCD_BAR_WORDS 3456
#define XB_SPIN_CAP (1u << 18)

__device__ __forceinline__ unsigned xb_ld(unsigned* p)              { return __hip_atomic_load(p, __ATOMIC_RELAXED, __HIP_MEMORY_SCOPE_AGENT); }
__device__ __forceinline__ unsigned xb_add(unsigned* p, unsigned v) { return __hip_atomic_fetch_add(p, v, __ATOMIC_RELAXED, __HIP_MEMORY_SCOPE_AGENT); }
__device__ __forceinline__ unsigned xb_xcc_id() { return (unsigned)__builtin_amdgcn_s_getreg((3 << 11) | 20) & 0xFu; }
#define XB_SPIN(cond, bar) do { unsigned _sp = 0; while (cond) { __builtin_amdgcn_s_sleep(1); \
    if ((++_sp & 255u) == 0u) { if (xb_ld(&(bar)[XB_TMO])) break; if (_sp > XB_SPIN_CAP) { atomicAdd(&(bar)[XB_TMO], 1u); break; } } } } while (0)

struct XcdBarrier {
    unsigned* bar; unsigned x;
    volatile LAS unsigned* st;
};

__device__ __forceinline__ XcdBarrier xcd_barrier_post(unsigned* bar, volatile LAS unsigned* st, int tid) {
    XcdBarrier b; b.bar = bar; b.x = xb_xcc_id(); b.st = st;
    if (tid == 0) (void)xb_add(&bar[XB_XCNT(b.x)], 1u);
    return b;
}
__device__ __forceinline__ void xcd_barrier_complete(unsigned* bar, unsigned x, unsigned& nloc, unsigned& nx) {
    const unsigned G = gridDim.x * gridDim.y * gridDim.z;
    unsigned sum, cnt, mine, sp = 0u;
    for (;;) {
        sum = 0u; cnt = 0u; mine = 0u;
#pragma unroll
        for (unsigned j = 0; j < 16; ++j) { const unsigned c = xb_ld(&bar[XB_XCNT(j)]); sum += c; cnt += (c > 0u) ? 1u : 0u; mine = (j == x) ? c : mine; }
        if (sum == G) break;
        __builtin_amdgcn_s_sleep(1);
        if ((++sp & 255u) == 0u) { if (xb_ld(&bar[XB_TMO])) break; if (sp > XB_SPIN_CAP) { atomicAdd(&bar[XB_TMO], 1u); break; } }
    }
    nloc = mine > 0u ? mine : 1u; nx = cnt > 0u ? cnt : 1u;
}

__device__ __forceinline__ void xcd_barrier(const XcdBarrier& b, int tid) {
    asm volatile("s_waitcnt vmcnt(0)" ::: "memory");
    __syncthreads();
    if (tid == 0) {
        unsigned* bar = b.bar;
        __builtin_amdgcn_s_waitcnt(0);
        unsigned nloc = b.st[0], nx = b.st[1];
        if (nloc == 0u) { xcd_barrier_complete(bar, b.x, nloc, nx); b.st[0] = nloc; b.st[1] = nx; }
        const unsigned old = xb_add(&bar[XB_XSUB(b.x)], 1u);
        const unsigned gen = old / nloc;
        if (old + 1u == (gen + 1u) * nloc) {
            __builtin_amdgcn_fence(__ATOMIC_RELEASE, "agent");
            asm volatile("s_waitcnt vmcnt(0)" ::: "memory");
            const unsigned og = xb_add(&bar[XB_TOP], 1u);
            const unsigned tg = og / nx;
            if (og + 1u == (tg + 1u) * nx) xb_add(&bar[XB_TOPGEN], 1u);
            else XB_SPIN(xb_ld(&bar[XB_TOPGEN]) == tg, bar);
            __builtin_amdgcn_fence(__ATOMIC_ACQUIRE, "agent");
            xb_add(&bar[XB_XGEN(b.x)], 1u);
            asm volatile("s_waitcnt vmcnt(0)" ::: "memory");
        } else {
            XB_SPIN(xb_ld(&bar[XB_XGEN(b.x)]) == gen, bar);
            __builtin_amdgcn_fence(__ATOMIC_ACQUIRE, "agent");
            asm volatile("s_waitcnt vmcnt(0)" ::: "memory");
        }
    }
    __syncthreads();
}

constexpr int CW_BAR = 4096; constexpr size_t CTL_ZERO_BYTES = 65536; constexpr int MISC_OFF = 131072;
__device__ __forceinline__ void epi_tables(LAS unsigned char* L, const pg8::StaticOrder& S, const float* ssq, const float* bias, int bstride, int tid) {
    LAS int* tags = (LAS int*)(L + pg8::TAB_OFF); LAS float* rT = (LAS float*)(L + pg8::TAB_OFF + 64); LAS float* bT = rT + pg8::TAB_SLOTS * 256;
    for (int i = 0; i < pg8::TAB_SLOTS; ++i) { pg8::Unit u;
        if (!S.next(i, u)) { if (tid == 0) tags[i] = -1; continue; }
        if (tid == 0) tags[i] = (u.pm << 8) | u.pn;
        if (ssq) { const int row = tid >> 1, hf = tid & 1; const float* q = ssq + (size_t)(u.pm * 256 + row) * 32 + hf * 16;
            const f32x4 a = *(const f32x4*)q, b = *(const f32x4*)(q + 4), c = *(const f32x4*)(q + 8), d = *(const f32x4*)(q + 12);
            float t = (((a.x + a.y) + (a.z + a.w)) + ((b.x + b.y) + (b.z + b.w))) + (((c.x + c.y) + (c.z + c.w)) + ((d.x + d.y) + (d.z + d.w)));
            t += __shfl_xor(t, 1); if (hf == 0) rT[i * 256 + row] = 1.0f / sqrtf(t * (1.0f / DM) + EPS); }
        if (tid < 256) bT[i * 256 + tid] = bias[(size_t)(u.pm >> 4) * bstride + u.pn * 256 + tid]; }
    __syncthreads();
}
struct Args { const void* in[35]; float* out; unsigned char* ws; int lo, hi; };
__device__ __forceinline__ int lane_id() { int l; asm volatile("v_mbcnt_lo_u32_b32 %0, -1, 0\n\tv_mbcnt_hi_u32_b32 %0, -1, %0" : "=v"(l)); return l; }
#define lt_tid() (wave * 64 + lane_id())
typedef const __attribute__((address_space(4))) unsigned long long* kargp_t;
__device__ __forceinline__ const void* karg(int i) { return (const void*)(const GAS void*)(((kargp_t)__builtin_amdgcn_kernarg_segment_ptr())[i]); }
#define KP(i) karg(i)

template <int NR> __device__ __forceinline__ void rows_norm_mod(const float* X, const float* g1, const float* sh1, const float* sc1, hb* o1, int gw, int NGW, int lane) {
    const unsigned l4 = 4u * (unsigned)lane;
    for (int R0 = NR * gw; R0 < M; R0 += NR * NGW) {
        const int b = R0 >> 12;
        const float* scb = sc1 + (size_t)b * NMOD; const float* shb = sh1 + (size_t)b * NMOD;
        f32x4 v[NR][8], gm[8], hh[8];
#pragma unroll
        for (int r = 0; r < NR; ++r) { const float* xr = X + (size_t)(R0 + r) * DM;
#pragma unroll
            for (int j = 0; j < 8; ++j) v[r][j] = __builtin_nontemporal_load((const f32x4*)(xr + (l4 + 256u * j))); }
#pragma unroll
        for (int j = 0; j < 8; ++j) { const unsigned col = l4 + 256u * j; gm[j] = *(const f32x4*)(g1 + col) * (*(const f32x4*)(scb + col) + 1.0f); hh[j] = *(const f32x4*)(shb + col); }
        float rstd[NR];
#pragma unroll
        for (int r = 0; r < NR; ++r) { float ss = 0.f;
#pragma unroll
            for (int j = 0; j < 8; ++j) ss += (v[r][j].x * v[r][j].x + v[r][j].y * v[r][j].y) + (v[r][j].z * v[r][j].z + v[r][j].w * v[r][j].w);
            rstd[r] = 1.0f / sqrtf(wave_sum(ss) * (1.0f / DM) + EPS); }
#pragma unroll
        for (int r = 0; r < NR; ++r) {
#pragma unroll
            for (int j = 0; j < 8; ++j) { const f32x4 y = (v[r][j] * rstd[r]) * gm[j] + hh[j]; *(v2u*)(o1 + tidx(R0 + r, (int)(l4 + 256u * j), DM)) = (v2u){pk2(y.x, y.y), pk2(y.z, y.w)}; } }
    }
}

__device__ __forceinline__ void qk_norm_rope(const float* raw, const float* g, const float* rt, hb* out, int gw, int NGW, int lane) {
    const int h = lane >> 2, q = lane & 3;
    float ga[16], gb[16];
#pragma unroll
    for (int e = 0; e < 16; ++e) { ga[e] = g[q * 16 + e]; gb[e] = g[64 + q * 16 + e]; }
    for (int row = gw; row < M; row += NGW) {
        const int b = row >> 12, s = row & 4095;
        const float* p = raw + (size_t)row * DM + h * 128 + q * 16;
        f32x4 a[4], c[4], cs[8]; float ss = 0.f;
#pragma unroll
        for (int e = 0; e < 4; ++e) { a[e] = *(const f32x4*)(p + 4 * e); c[e] = *(const f32x4*)(p + 64 + 4 * e);
            ss += (a[e].x * a[e].x + a[e].y * a[e].y) + (a[e].z * a[e].z + a[e].w * a[e].w) + (c[e].x * c[e].x + c[e].y * c[e].y) + (c[e].z * c[e].z + c[e].w * c[e].w); }
        const float* t = rt + ((size_t)row * 64 + q * 16) * 2;
#pragma unroll
        for (int e = 0; e < 8; ++e) cs[e] = *(const f32x4*)(t + 4 * e);
        ss += __shfl_xor(ss, 1); ss += __shfl_xor(ss, 2);
        const float rstd = 1.0f / sqrtf(ss * (1.0f / 128.0f) + EPS);
        float o1[16], o2[16];
#pragma unroll
        for (int e = 0; e < 16; ++e) { const float x1 = a[e >> 2][e & 3] * rstd * ga[e], x2 = c[e >> 2][e & 3] * rstd * gb[e];
            const float co = cs[e >> 1][(e & 1) * 2], si = cs[e >> 1][(e & 1) * 2 + 1];
            o1[e] = x1 * co - x2 * si; o2[e] = x2 * co + x1 * si; }
        hb* op = out + ((size_t)(b * 16 + h) * SEQ + s) * 128 + q * 16;
        *(v4u*)(op) = (v4u){pk2(o1[0], o1[1]), pk2(o1[2], o1[3]), pk2(o1[4], o1[5]), pk2(o1[6], o1[7])};
        *(v4u*)(op + 8) = (v4u){pk2(o1[8], o1[9]), pk2(o1[10], o1[11]), pk2(o1[12], o1[13]), pk2(o1[14], o1[15])};
        *(v4u*)(op + 64) = (v4u){pk2(o2[0], o2[1]), pk2(o2[2], o2[3]), pk2(o2[4], o2[5]), pk2(o2[6], o2[7])};
        *(v4u*)(op + 72) = (v4u){pk2(o2[8], o2[9]), pk2(o2[10], o2[11]), pk2(o2[12], o2[13]), pk2(o2[14], o2[15])};
    }
}

__device__ __forceinline__ void attn_combine(const float* O, const float* sg, float lam, hb* A, int gw, int NGW, int lane) {
    const int h = lane >> 3, q = lane & 7, v = q >> 2, d0 = (q & 3) * 32;
    f32x4 gg[8];
#pragma unroll
    for (int e = 0; e < 8; ++e) gg[e] = *(const f32x4*)(sg + v * 128 + d0 + 4 * e);
    for (int R0 = 2 * gw; R0 < M; R0 += 2 * NGW) {
        const int b = R0 >> 12, s = R0 & 4095;
        const float* p1 = O + ((size_t)(b * 32 + 4 * h + v) * SEQ + s) * 128 + d0;
        const float* p2 = O + ((size_t)(b * 32 + 4 * h + 2 + v) * SEQ + s) * 128 + d0;
        f32x4 x1[2][8], x2[2][8];
#pragma unroll
        for (int r = 0; r < 2; ++r)
#pragma unroll
            for (int e = 0; e < 8; ++e) { x1[r][e] = *(const f32x4*)(p1 + r * 128 + 4 * e); x2[r][e] = *(const f32x4*)(p2 + r * 128 + 4 * e); }
#pragma unroll
        for (int r = 0; r < 2; ++r) { float ss = 0.f;
#pragma unroll
            for (int e = 0; e < 8; ++e) { x1[r][e] = x1[r][e] - lam * x2[r][e]; ss += (x1[r][e].x * x1[r][e].x + x1[r][e].y * x1[r][e].y) + (x1[r][e].z * x1[r][e].z + x1[r][e].w * x1[r][e].w); }
            ss += __shfl_xor(ss, 1); ss += __shfl_xor(ss, 2); ss += __shfl_xor(ss, 4);
            const float rstd = (1.0f - LAM_INIT) / sqrtf(ss * (1.0f / 256.0f) + EPS);
            hb* op = A + tidx(R0 + r, h * 256 + v * 128 + d0, DM);
#pragma unroll
            for (int e = 0; e < 8; e += 2) { const f32x4 y0 = x1[r][e] * rstd * gg[e], y1 = x1[r][e + 1] * rstd * gg[e + 1];
                *(v4u*)(op + 4 * e) = (v4u){pk2(y0.x, y0.y), pk2(y0.z, y0.w), pk2(y1.x, y1.y), pk2(y1.z, y1.w)}; } }
    }
}

__device__ __forceinline__ att::BlockRef<att::bf16, float> mkref(int Lx, int pass, const hb* Qb, const hb* Kb, const hb* Vb, float* Ob) {
    const int bh = Lx >> 3, xx = Lx & 7, qb = pass ? 15 - xx : xx; const int b = bh >> 5, r = bh & 31, hh = r >> 2, s = (r >> 1) & 1, v = r & 1;
    att::BlockRef<att::bf16, float> rr;
    rr.Q = (const att::bf16*)Qb + ((size_t)(b * 16 + 2 * hh + s) * SEQ + (size_t)qb * att::QB) * 128; rr.K = (const att::bf16*)Kb + (size_t)(b * 16 + 2 * hh + s) * SEQ * 128;
    rr.V = (const att::bf16*)Vb + (size_t)(b * 16 + 2 * hh + v) * SEQ * 128; rr.O = Ob + ((size_t)(b * 32 + r) * SEQ + (size_t)qb * att::QB) * 128; rr.P0 = qb * att::QB; return rr;
}
#define XIN ((const float*)KP(0))
#define cvec ((const float*)KP(1))
#define positions ((const int*)KP(2))
#define mods ((float*)(ws + WS_MODS))
#define gam ((float*)(ws + WS_GAM))
#define biasT ((float*)(ws + WS_BIAS))
#define SSQ ((float*)(ws + WS_SSQ))
#define rt ((float*)(ws + WS_RT))
#define stats ((float*)(ws + WS_STATS))
#define W_in ((hb*)(ws + WS_W_IN))
#define W_out ((hb*)(ws + WS_W_OUT))
#define W_fia ((hb*)(ws + WS_W_FIA))
#define W_foa ((hb*)(ws + WS_W_FOA))
#define W_kv ((hb*)(ws + WS_W_KV))
#define W_q ((hb*)(ws + WS_W_Q))
#define W_o ((hb*)(ws + WS_W_O))
#define W_fib ((hb*)(ws + WS_W_FIB))
#define W_fob ((hb*)(ws + WS_W_FOB))
#define XA ((float*)(ws + WS_XA))
#define XB ((float*)(ws + WS_XB))
#define XN ((hb*)(ws + WS_XN))
#define XQ ((hb*)(ws + WS_XQ))
#define A3 ((hb*)(ws + WS_A3))
#define Z ((hb*)(ws + WS_Z))
#define H ((hb*)(ws + WS_H))
#define KRAW ((float*)(ws + WS_KRAW))
#define QRAW ((float*)(ws + WS_QRAW))
#define OB ((float*)(ws + WS_O))
#define VB ((hb*)(ws + WS_VB))
#define KB ((hb*)(ws + WS_KB))
#define QB_ ((hb*)(ws + WS_QB))
__device__ __forceinline__ void bias_chunks(unsigned char* ws, int c_lo, int c_hi, int gw, int NGW, int lane) {
        for (int c = c_lo + gw; c < c_hi; c += NGW) { const int r0 = 16 * c; const hb* Wt; int sho;
            int rl;
            if (r0 < OFF_KV) { Wt = W_fia; rl = r0; sho = MOD_A + 6144; } else if (r0 < OFF_Q) { Wt = W_kv; rl = r0 - OFF_KV; sho = MOD_KV; }
            else if (r0 < OFF_FIB) { Wt = W_q; rl = r0 - OFF_Q; sho = MOD_B; } else { Wt = W_fib; rl = r0 - OFF_FIB; sho = MOD_B + 6144; }
            f32x4 s0[4][2], s1[4][2];
#pragma unroll
            for (int j = 0; j < 4; ++j)
#pragma unroll
                for (int e = 0; e < 2; ++e) { s0[j][e] = *(const f32x4*)(mods + sho + 8 * lane + 512 * j + 4 * e); s1[j][e] = *(const f32x4*)(mods + NMOD + sho + 8 * lane + 512 * j + 4 * e); }
            for (int hf = 0; hf < 4; ++hf) { v4u wv[4][4];
#pragma unroll
                for (int r = 0; r < 4; ++r)
#pragma unroll
                    for (int j = 0; j < 4; ++j) wv[r][j] = __builtin_nontemporal_load((const v4u*)(Wt + tidx(rl + 4 * hf + r, 8 * lane + 512 * j, DM)));
                float myb0 = 0.f, myb1 = 0.f;
#pragma unroll
                for (int r = 0; r < 4; ++r) { float a0 = 0.f, a1 = 0.f;
#pragma unroll
                    for (int j = 0; j < 4; ++j) { const v4u w = wv[r][j]; const f32x4 lo = {bflo(w.x), bfhi(w.x), bflo(w.y), bfhi(w.y)}, hi2 = {bflo(w.z), bfhi(w.z), bflo(w.w), bfhi(w.w)};
                        const f32x4 p0 = lo * s0[j][0] + hi2 * s0[j][1], p1 = lo * s1[j][0] + hi2 * s1[j][1]; a0 += (p0.x + p0.y) + (p0.z + p0.w); a1 += (p1.x + p1.y) + (p1.z + p1.w); }
                    a0 = wave_sum(a0); a1 = wave_sum(a1); if (lane == r) { myb0 = a0; myb1 = a1; } }
                if (lane < 4) { biasT[r0 + 4 * hf + lane] = myb0; biasT[pg8::NBIAS + r0 + 4 * hf + lane] = myb1; } }
        }
}
__global__ void __launch_bounds__(NWAVES * 64, 2) yoco_fwd(Args args) {
    extern __shared__ __attribute__((aligned(16))) unsigned char lds[];
    LAS unsigned char* L = (LAS unsigned char*)lds;
    const int wave = __builtin_amdgcn_readfirstlane((int)threadIdx.x >> 6);
#define PH_IDS const int tid = lt_tid(), lane = tid & 63
    volatile LAS unsigned* MISC = (volatile LAS unsigned*)(L + MISC_OFF);
    { const int t0 = lt_tid(); if (t0 < 16) MISC[t0] = 0u; }
    __syncthreads();
    const int G = gridDim.x, bx = blockIdx.x;
    const int gw = bx * NWAVES + wave, NGW = G * NWAVES;
    unsigned char* ws = (unsigned char*)KP(36);
    const unsigned long long lohi = ((kargp_t)__builtin_amdgcn_kernarg_segment_ptr())[37]; const int lo = (int)(unsigned)lohi, hi = (int)(unsigned)(lohi >> 32);
#ifndef PHM
#define PHM 0x1ffff
#endif
#define IN(k) (((PHM >> (k)) & 1) && lo <= (k) && (k) < hi)
    XcdBarrier xbar; xbar.bar = (unsigned*)ws + CW_BAR; xbar.x = 0; xbar.st = nullptr;
    if (hi - lo > 1) xbar = xcd_barrier_post((unsigned*)ws + CW_BAR, MISC + 8, lt_tid());
#define SEAM(k) do { if (IN(k) && IN((k) + 1)) { xcd_barrier(xbar, lt_tid()); } } while (0)
    if (lo < 0) cg::this_grid().sync();

    if (IN(0)) { PH_IDS;
        {
            LAS float* sc = (LAS float*)L; LAS float* red = (LAS float*)(L + 16384);
            for (int i = tid; i < 2 * DM; i += NWAVES * 64) { const float cv = cvec[i]; sc[i] = cv / (1.0f + __expf(-cv)); }
            __syncthreads();
            for (int it = bx; it < NMOD / 128; it += G) {
                const int gc = it * 128; const float* Wm; const float* bm; int N, c0;
                if (gc < MOD_KV) { Wm = (const float*)KP(3); bm = (const float*)KP(4); N = 12288; c0 = gc; }
                else if (gc < MOD_B) { Wm = (const float*)KP(16); bm = (const float*)KP(17); N = 4096; c0 = gc - MOD_KV; }
                else { Wm = (const float*)KP(21); bm = (const float*)KP(22); N = 12288; c0 = gc - MOD_B; }
                const float* wp = Wm + (size_t)(256 * wave) * N + c0 + 2 * lane;
                f32x2 a0 = {0.f, 0.f}, a1 = {0.f, 0.f};
#pragma unroll 16
                for (int kk = 0; kk < 256; ++kk) { const f32x2 wv = __builtin_nontemporal_load((const f32x2*)(wp + (size_t)kk * N)); const float s0 = sc[256 * wave + kk], s1 = sc[DM + 256 * wave + kk]; a0 += wv * s0; a1 += wv * s1; }
                red[(wave * 2 + 0) * 128 + 2 * lane] = a0.x; red[(wave * 2 + 0) * 128 + 2 * lane + 1] = a0.y;
                red[(wave * 2 + 1) * 128 + 2 * lane] = a1.x; red[(wave * 2 + 1) * 128 + 2 * lane + 1] = a1.y;
                __syncthreads();
                if (tid < 256) { const int b = tid >> 7, cc = tid & 127; float s = bm[c0 + cc];
#pragma unroll
                    for (int w = 0; w < 8; ++w) s += red[(w * 2 + b) * 128 + cc];
                    mods[(size_t)b * NMOD + gc + cc] = s; }
                __syncthreads();
            }
        }
        for (int idx = gw * 64 + lane; idx < M * 64; idx += NGW * 64) { const int row = idx >> 6, i = idx & 63;
            const float inv = 1.0f / exp2f((float)i * (13.287712379549449f / 64.0f)); const float ang = (float)positions[row] * inv;
            double rev = (double)ang * 0.15915494309189535; rev -= floor(rev); const float rf = (float)rev;
            *(f32x2*)(rt + (size_t)idx * 2) = (f32x2){__builtin_amdgcn_cosf(rf), __builtin_amdgcn_sinf(rf)}; }
        {
            LAS float* scr = (LAS float*)(L + wave * 16384);
            constexpr int I_IN = (DM / 64) * (2 * DM / 32), I_SQ = (DM / 64) * (DM / 32), I_FI = (DM / 64) * (2 * DFF / 32), I_FO = (DFF / 64) * (DM / 32);
            constexpr int NITEMS = 2 * I_IN + 3 * I_SQ + 2 * I_FI + 2 * I_FO;
#define TR_DECODE(T, itx) do { int r = (itx); \
                if (r < I_IN) { T.W = (const float*)KP(6); T.WT = W_in; T.K = DM; T.N = 2 * DM; T.mode = 0; T.lim = 0; } else { r -= I_IN; \
                if (r < I_SQ) { T.W = (const float*)KP(12); T.WT = W_out; T.K = DM; T.N = DM; T.mode = 0; T.lim = 0; } else { r -= I_SQ; \
                if (r < I_FI) { T.W = (const float*)KP(14); T.WT = W_fia; T.K = DM; T.N = 2 * DFF; T.mode = 1; T.lim = 0; } else { r -= I_FI; \
                if (r < I_FO) { T.W = (const float*)KP(15); T.WT = W_foa; T.K = DFF; T.N = DM; T.mode = 0; T.lim = 0; } else { r -= I_FO; \
                if (r < I_IN) { T.W = (const float*)KP(19); T.WT = W_kv; T.K = DM; T.N = 2 * DM; T.mode = 2; T.lim = DM; } else { r -= I_IN; \
                if (r < I_SQ) { T.W = (const float*)KP(24); T.WT = W_q; T.K = DM; T.N = DM; T.mode = 2; T.lim = DM; } else { r -= I_SQ; \
                if (r < I_SQ) { T.W = (const float*)KP(31); T.WT = W_o; T.K = DM; T.N = DM; T.mode = 0; T.lim = 0; } else { r -= I_SQ; \
                if (r < I_FI) { T.W = (const float*)KP(33); T.WT = W_fib; T.K = DM; T.N = 2 * DFF; T.mode = 1; T.lim = 0; } else { r -= I_FI; \
                                T.W = (const float*)KP(34); T.WT = W_fob; T.K = DFF; T.N = DM; T.mode = 0; T.lim = 0; } } } } } } } } \
                const int nblk_ = T.N / 32; T.k0 = 64 * (r / nblk_); T.n0 = 32 * (r % nblk_); } while (0)
            float tv[32]; TrItem cur, nxt;
            int it = gw;
            if (it < NITEMS) { TR_DECODE(cur, it); tr_load(cur, tv, lane); nxt = cur; }
            while (it < NITEMS) {
#pragma unroll
                for (int i = 0; i < 32; ++i) { const int kk = 2 * i + (lane >> 5); scr[kk * 33 + (lane & 31)] = tv[i]; }
                LDS_WAIT(); asm volatile("" ::: "memory");
                const int itn = it + NGW;
                if (itn < NITEMS) { TR_DECODE(nxt, itn); tr_load(nxt, tv, lane); }
                const int c = lane & 7;
#pragma unroll
                for (int j = 0; j < 4; ++j) { const int n = (lane >> 3) + 8 * j; const LAS float* sp = scr + (8 * c) * 33 + n;
                    v4u o; o.x = pk2(sp[0 * 33], sp[1 * 33]); o.y = pk2(sp[2 * 33], sp[3 * 33]); o.z = pk2(sp[4 * 33], sp[5 * 33]); o.w = pk2(sp[6 * 33], sp[7 * 33]);
                    __builtin_nontemporal_store(o, (GAS v4u*)(cur.WT + tidx(wt_rowmap(cur.n0 + n, cur.mode, cur.N, cur.lim), cur.k0 + 8 * c, cur.K))); }
                LDS_WAIT(); asm volatile("" ::: "memory");
                cur = nxt; it = itn;
            }
#undef TR_DECODE
        }
        __syncthreads();
    }
    SEAM(0);
    if (IN(1)) { PH_IDS;
        rows_norm_mod<2>(XIN, (const float*)KP(5), mods + MOD_A + 0, mods + MOD_A + 2048, XN, gw, NGW, lane); }
    if (IN(1)) { PH_IDS;
        for (int idx = gw * 64 + lane; idx < 4 * 2 * DM; idx += NGW * 64) { const int m = idx >> 12, b = (idx >> 11) & 1, col = idx & 2047;
            const float* gp = m == 0 ? (const float*)KP(13) : m == 1 ? (const float*)KP(18) : m == 2 ? (const float*)KP(23) : (const float*)KP(32);
            const int so = m == 0 ? MOD_A + 8192 : m == 1 ? MOD_KV + 2048 : m == 2 ? MOD_B + 2048 : MOD_B + 8192;
            gam[idx] = gp[col] * (1.0f + mods[(size_t)b * NMOD + so + col]); }
        bias_chunks(ws, 0, (G == 256) ? OFF_KV / 16 : pg8::NBIAS / 16, gw, NGW, lane);
    }
    SEAM(1);
    if (IN(2)) { pg8::Gemm g{XN, W_in, M, 2 * DM, DM}; pg8::StaticOrder S; S.init(M, 2 * DM, G, bx);
        epi_tables(L, S, nullptr, (const float*)KP(7), 0, lt_tid());
        pg8::EpiGeluStats E{Z, 2 * DM, L + pg8::TAB_OFF, stats};
        pg8::gemm_phase<pg8::EpiGeluStats, pg8::StaticOrder, true, true>(L, g, S, E, lt_tid()); }
    SEAM(2);
    if (IN(3)) { PH_IDS;
        LAS hb* vTb = (LAS hb*)L; LAS f32x2* st = (LAS f32x2*)(L + 73728);
        const float* lng = (const float*)KP(8); const float* lnb = (const float*)KP(9); const float* sw = (const float*)KP(10); const float* sb = (const float*)KP(11);
        const int tl = lane & 15, quad = lane >> 4; int cur_g = -1; bf16x8 wf[4]; int buf = 0;
        v4u zpre[4]; v2u upre[8];
#define ZULOAD(uu) do { const int g_ = (uu) & 15, R_ = ((uu) >> 4) * 128; _Pragma("unroll") for (int i = 0; i < 4; ++i) { const int qd = tid + 512 * i; \
            zpre[i] = *(const v4u*)(Z + (size_t)(R_ + (qd >> 4)) * (2 * DM) + DM + g_ * 128 + (qd & 15) * 8); } \
            _Pragma("unroll") for (int nt = 0; nt < 8; ++nt) upre[nt] = *(const v2u*)(Z + (size_t)(R_ + 16 * wave + tl) * (2 * DM) + g_ * 128 + 16 * nt + quad * 4); } while (0)
        for (int u0 = bx; u0 < 1024; u0 += 4 * G) {
            { const int j = tid >> 7, r = tid & 127, uj = u0 + j * G;
              if (uj < 1024) { const float* sp = stats + (size_t)((uj >> 4) * 128 + r) * 64; float s1 = 0.f, s2 = 0.f;
#pragma unroll
                for (int i = 0; i < 16; ++i) { const f32x4 p = *(const f32x4*)(sp + 4 * i); s1 += p.x + p.z; s2 += p.y + p.w; }
                const float mean = s1 * (1.0f / DM); const float var = fmaxf(s2 * (1.0f / DM) - mean * mean, 0.f); st[tid] = (f32x2){mean, 1.0f / sqrtf(var + EPS)}; } }
            ZULOAD(u0);
            __syncthreads();
            for (int j = 0; j < 4; ++j) { const int u = u0 + j * G; if (u >= 1024) break;
                const int g = u & 15, R0 = (u >> 4) * 128; LAS hb* vT = vTb + buf * (128 * 136);
                if (g != cur_g) { cur_g = g; const int t = 16 * wave + tl;
#pragma unroll
                    for (int ks = 0; ks < 4; ++ks) { const int s0 = 32 * ks + 8 * quad; const float* wp = sw + ((size_t)g * 128 + t) * 128 + s0;
                        const f32x4 w0 = *(const f32x4*)wp, w1 = *(const f32x4*)(wp + 4); float wv[8] = {w0.x, w0.y, w0.z, w0.w, w1.x, w1.y, w1.z, w1.w};
#pragma unroll
                        for (int jj = 0; jj < 8; ++jj) if (s0 + jj > t) wv[jj] = 0.f;
                        v4u pw = {pk2(wv[0], wv[1]), pk2(wv[2], wv[3]), pk2(wv[4], wv[5]), pk2(wv[6], wv[7])}; wf[ks] = __builtin_bit_cast(bf16x8, pw); } }
#pragma unroll
                for (int i = 0; i < 4; ++i) { const int qd = tid + 512 * i, s = qd >> 4, cc = (qd & 15) * 8;
                    const v4u zv = zpre[i]; const f32x2 ms = st[j * 128 + s];
                    const f32x4 g0 = *(const f32x4*)(lng + g * 128 + cc), g1 = *(const f32x4*)(lng + g * 128 + cc + 4), b0 = *(const f32x4*)(lnb + g * 128 + cc), b1 = *(const f32x4*)(lnb + g * 128 + cc + 4);
                    float y[8] = {bflo(zv.x), bfhi(zv.x), bflo(zv.y), bfhi(zv.y), bflo(zv.z), bfhi(zv.z), bflo(zv.w), bfhi(zv.w)};
                    const float gg[8] = {g0.x, g0.y, g0.z, g0.w, g1.x, g1.y, g1.z, g1.w}, bb[8] = {b0.x, b0.y, b0.z, b0.w, b1.x, b1.y, b1.z, b1.w};
#pragma unroll
                    for (int e = 0; e < 8; ++e) vT[(cc + e) * 136 + s] = (hb)f2bf((y[e] - ms.x) * ms.y * gg[e] + bb[e]); }
                v2u ucur[8];
#pragma unroll
                for (int nt = 0; nt < 8; ++nt) ucur[nt] = upre[nt];
                if (j < 3 && u + G < 1024) ZULOAD(u + G);
                __syncthreads();
                { const int t = 16 * wave + tl, row = R0 + t; const float bias = sb[g * 128 + t];
#pragma unroll
                  for (int nt = 0; nt < 8; ++nt) { f32x4 acc = {0.f, 0.f, 0.f, 0.f};
#pragma unroll
                    for (int ks = 0; ks < 4; ++ks) if (ks <= (wave >> 1)) { const bf16x8 bfr = *(const LAS bf16x8*)(vT + (16 * nt + tl) * 136 + 32 * ks + 8 * quad);
                        acc = __builtin_amdgcn_mfma_f32_16x16x32_bf16(bfr, wf[ks], acc, 0, 0, 0); }
                    const int col = g * 128 + 16 * nt + quad * 4; const v2u uv = ucur[nt];
                    const float y0 = bflo(uv.x) * (acc[0] + bias), y1 = bfhi(uv.x) * (acc[1] + bias), y2 = bflo(uv.y) * (acc[2] + bias), y3 = bfhi(uv.y) * (acc[3] + bias);
                    *(v2u*)(A3 + tidx(row, col, DM)) = (v2u){pk2(y0, y1), pk2(y2, y3)}; } }
                buf ^= 1;
            }
            __syncthreads();
        }
#undef ZULOAD
    }
    SEAM(3);
    if (IN(4)) { pg8::Gemm g{A3, W_out, M, DM, DM}; pg8::StaticOrder S; S.init(M, DM, G, bx);
        pg8::EpiResNorm<true> E{XIN, XA, mods + MOD_A + 4096, NMOD, DM, gam + 0 * 4096, XN, nullptr, nullptr, SSQ};
        pg8::gemm_phase<pg8::EpiResNorm<true>, pg8::StaticOrder, true, true>(L, g, S, E, lt_tid()); }
    SEAM(4);
    if (IN(6)) { pg8::Gemm g{XN, W_fia, M, 2 * DFF, DM}; pg8::StaticOrder S; S.init(M, 2 * DFF, G, bx);
        epi_tables(L, S, SSQ, biasT + OFF_FIA, pg8::NBIAS, lt_tid());
        pg8::EpiSwiGLU E{H, DFF, L + pg8::TAB_OFF};
        pg8::gemm_phase<pg8::EpiSwiGLU, pg8::StaticOrder, true, true>(L, g, S, E, lt_tid());
        if (G == 256 && bx >= 128) { PH_IDS; (void)tid; bias_chunks(ws, OFF_KV / 16, pg8::NBIAS / 16, (bx - 128) * NWAVES + wave, 128 * NWAVES, lane); }
    }
    SEAM(6);
    if (IN(7)) { pg8::Gemm g{H, W_foa, M, DM, DFF}; pg8::StaticOrder S; S.init(M, DM, G, bx);
        pg8::EpiResNorm<false> E{XA, XB, mods + MOD_A + 10240, NMOD, DM, gam + 1 * 4096, XN, gam + 2 * 4096, XQ, SSQ};
        pg8::gemm_phase<pg8::EpiResNorm<false>, pg8::StaticOrder, true, true>(L, g, S, E, lt_tid()); }
    SEAM(7);
    if (IN(9)) {
        { pg8::Gemm g{XN, W_kv, M, DM, DM}; pg8::StaticOrder S; S.init(M, DM, G, bx); pg8::EpiQKRope E{KB, (const float*)KP(20), rt, SSQ, biasT + OFF_KV};
          pg8::gemm_phase<pg8::EpiQKRope, pg8::StaticOrder, false, true>(L, g, S, E, lt_tid()); }
        { pg8::Gemm g{XN, W_kv + (size_t)DM * DM, M, DM, DM}; pg8::StaticOrder S; S.init(M, DM, G, bx); pg8::EpiVhead E{VB, SSQ, biasT + OFF_KV + DM};
          pg8::gemm_phase<pg8::EpiVhead, pg8::StaticOrder, true, true>(L, g, S, E, lt_tid()); }
        { pg8::Gemm g{XQ, W_q, M, DM, DM}; pg8::StaticOrder S; S.init(M, DM, G, bx); pg8::EpiQKRope E{QB_, (const float*)KP(25), rt, SSQ, biasT + OFF_Q};
          pg8::gemm_phase<pg8::EpiQKRope, pg8::StaticOrder, false, true>(L, g, S, E, lt_tid()); }
    }
    SEAM(9);
#define SKIP10 1
    if (IN(11)) {
        typedef att::BlockRef<att::bf16, float> BR;
        const int total = 8 * 64, stride = G;
        int Li = (G % 8 == 0) ? (bx % 8) * (G / 8) + bx / 8 : bx;
        if (Li < total) {
#define MKREF(Lx, pass) mkref((Lx), (pass), QB_, KB, VB, OB)
            int pass = 0; BR cur = MKREF(Li, 0);
            att::Seam<att::bf16> S;
            att::causal_swa_prime<att::bf16, float>(cur, SEQ, (char*)lds, S, lt_tid());
            for (;;) {
                const bool more_pass = pass == 0, more_item = Li + stride < total, last = !more_pass && !more_item;
                int passn = pass + 1, Ln = Li;
                if (!more_pass) { passn = 0; Ln = more_item ? Li + stride : Li; }
                const BR nxt = last ? cur : MKREF(Ln, passn);
                att::causal_swa_block<att::bf16, float>(cur, nxt, SEQ, SEQ, (char*)lds, S, lt_tid());
                if (last) break;
                cur = nxt; pass = passn; Li = Ln;
            }
#undef MKREF
        }
    }
    SEAM(11);
    if (IN(12)) { PH_IDS;
        const float* q1 = (const float*)KP(26); const float* k1 = (const float*)KP(27); const float* q2 = (const float*)KP(28); const float* k2 = (const float*)KP(29);
        const float d1 = wave_sum(q1[lane] * k1[lane] + q1[lane + 64] * k1[lane + 64]), d2 = wave_sum(q2[lane] * k2[lane] + q2[lane + 64] * k2[lane + 64]);
        const float lam = expf(d1) - expf(d2) + LAM_INIT;
        attn_combine(OB, (const float*)KP(30), lam, A3, gw, NGW, lane);
    }
    SEAM(12);
    if (IN(13)) { pg8::Gemm g{A3, W_o, M, DM, DM}; pg8::StaticOrder S; S.init(M, DM, G, bx);
        pg8::EpiResNorm<false> E{XB, XA, mods + MOD_B + 4096, NMOD, DM, gam + 3 * 4096, XN, nullptr, nullptr, SSQ};
        pg8::gemm_phase<pg8::EpiResNorm<false>, pg8::StaticOrder, true, true>(L, g, S, E, lt_tid()); }
    SEAM(13);
    if (IN(15)) { pg8::Gemm g{XN, W_fib, M, 2 * DFF, DM}; pg8::StaticOrder S; S.init(M, 2 * DFF, G, bx);
        epi_tables(L, S, SSQ, biasT + OFF_FIB, pg8::NBIAS, lt_tid());
        pg8::EpiSwiGLU E{H, DFF, L + pg8::TAB_OFF};
        pg8::gemm_phase<pg8::EpiSwiGLU, pg8::StaticOrder, true, true>(L, g, S, E, lt_tid()); }
    SEAM(15);
    if (IN(16)) { pg8::Gemm g{H, W_fob, M, DM, DFF}; pg8::StaticOrder S; S.init(M, DM, G, bx);
        pg8::EpiResNorm<false> E{XA, (float*)KP(35), mods + MOD_B + 10240, NMOD, DM, nullptr, nullptr, nullptr, nullptr, nullptr};
        pg8::gemm_phase<pg8::EpiResNorm<false>, pg8::StaticOrder, true, true>(L, g, S, E, lt_tid()); }
#undef IN
#undef SEAM
}
constexpr int NPHASES = 17;

extern "C" void kernel_launch(void* const* d_in, const int* in_sizes, int n_in, void* d_out, int out_size, void* d_ws, size_t ws_size, hipStream_t stream) {
    static int grid = 0;
    if (grid == 0) {
        if (n_in != 35 || in_sizes[0] != M * DM || out_size != M * DM || ws_size < WS_END) { fprintf(stderr, "kernel_launch: unexpected shapes: n_in %d in0 %d out %d ws %zu (need %zu)\n", n_in, n_in > 0 ? in_sizes[0] : -1, out_size, ws_size, (size_t)WS_END); grid = -1; return; }
        int dev = 0, cus = 0, per_cu = 0;
        if (hipGetDevice(&dev) != hipSuccess || hipDeviceGetAttribute(&cus, hipDeviceAttributeMultiprocessorCount, dev) != hipSuccess) { grid = -1; return; }
        if (hipFuncSetAttribute((const void*)yoco_fwd, hipFuncAttributeMaxDynamicSharedMemorySize, LDS_BYTES) != hipSuccess) { fprintf(stderr, "kernel_launch: hipFuncSetAttribute failed\n"); grid = -1; return; }
        if (hipOccupancyMaxActiveBlocksPerMultiprocessor(&per_cu, (const void*)yoco_fwd, NWAVES * 64, LDS_BYTES) != hipSuccess || per_cu < 1) { fprintf(stderr, "kernel_launch: occupancy query gives %d\n", per_cu); per_cu = 1; }
        (void)hipGetLastError();
        if (cus != 256) fprintf(stderr, "kernel_launch: built for a 256-CU device (one 256x256 unit per workgroup in the fused-epilogue GEMM phases); found %d CUs\n", cus);
        grid = cus;
    }
    if (grid < 0) return;
    if (hipMemsetAsync(d_ws, 0, CTL_ZERO_BYTES, stream) != hipSuccess) { fprintf(stderr, "kernel_launch: hipMemsetAsync failed\n"); return; }
    Args a{};
    for (int i = 0; i < 35; ++i) a.in[i] = d_in[i];
    a.out = (float*)d_out; a.ws = (unsigned char*)d_ws;
#if MK_N_LAUNCHES == 1
    a.lo = 0; a.hi = NPHASES;
    void* kargs[] = {&a};
    hipError_t e = hipLaunchCooperativeKernel((const void*)yoco_fwd, dim3(grid), dim3(NWAVES * 64), kargs, LDS_BYTES, stream);
    if (e != hipSuccess) fprintf(stderr, "kernel_launch: cooperative launch failed: %s (grid %d)\n", hipGetErrorString(e), grid);
#else
#ifndef DUP_MASK
#define DUP_MASK 0
#endif
    for (int p = 0; p < NPHASES; ++p) { a.lo = p; a.hi = p + 1; for (int r = 0; r < 1 + ((DUP_MASK >> p) & 1); ++r) hipLaunchKernelGGL(yoco_fwd, dim3(grid), dim3(NWAVES * 64), LDS_BYTES, stream, a); }
#endif
}
```

```cpp
#define MK_N_LAUNCHES 1
#include <hip/hip_runtime.h>
#include <hip/hip_bf16.h>
#include <cstdio>
#include <cstdint>
#include <cmath>
__host__ __device__ __forceinline__ size_t tidx(int r, int k, int K) { return ((size_t)(r >> 7) * (size_t)(K >> 6) + (size_t)(k >> 6)) * 8192 + (size_t)((r & 127) * 64 + (k & 63)); }
namespace pg8 {
#define PG8_LAS __attribute__((address_space(3)))
typedef unsigned short bf16_t;
typedef short bf16x8 __attribute__((ext_vector_type(8)));
typedef float f32x4 __attribute__((ext_vector_type(4)));
typedef unsigned u32x4 __attribute__((ext_vector_type(4)));
constexpr int BM = 256, BK = 64, HALF = 128, HTB = HALF * BK * 2  , STAGE_BYTES = 8 * HTB, NXCD = 8, WGM = 8;

__host__ __device__ __forceinline__ int lds_byte(int r, int c) { const int st = (r >> 4) * 2 + (c >> 5), rr = r & 15, cc = c & 31, ob = rr * 64 + cc * 2; return st * 1024 + (ob ^ (((ob >> 9) & 1) << 5)); }
__host__ __device__ __forceinline__ void stage_rc(int b, int& R, int& C) { const int st = b / 1024, sb = b % 1024, swz = sb ^ (((sb >> 9) & 1) << 5); R = (st >> 1) * 16 + swz / 64; C = (st & 1) * 32 + (swz % 64) / 2; }
__host__ __device__ __forceinline__ int perm32(int rho) { const int n = rho >> 4, i = rho & 15; return 8 * (i >> 2) + 4 * n + (i & 3); }

struct Unit { int pm, pn; };
struct Gemm { const bf16_t* A; const bf16_t* Bt; int M, N, K; };

struct StaticOrder {
    int nM, nN, nwg, G, c;
    __host__ __device__ void init(int M, int N, int G_, int c_) { nM = M / BM; nN = N / BM; nwg = nM * nN; G = G_; c = c_; }
    __host__ __device__ bool next(int i, Unit& u) const {
        const long L = (long)i * G + c; if (L >= nwg) return false;
        int wgid = (int)L; { const int q = nwg / NXCD, r = nwg % NXCD, xcd = wgid % NXCD, off = wgid / NXCD; wgid = (xcd < r ? xcd * (q + 1) : r * (q + 1) + (xcd - r) * q) + off; }
        const int nig = WGM * nN, gid = wgid / nig, fm = gid * WGM, gsz = (nM - fm) < WGM ? (nM - fm) : WGM;
        u.pm = fm + ((wgid % nig) % gsz); u.pn = (wgid % nig) / gsz; return true;
    }
    __device__ __forceinline__ void a_ready(const Unit&) const {}
    __device__ __forceinline__ void done(const Unit&) const {}
};

__device__ __forceinline__ unsigned cvt_pk_bf16(float lo, float hi) { unsigned r; asm volatile("v_cvt_pk_bf16_f32 %0, %1, %2" : "=v"(r) : "v"(lo), "v"(hi)); return r; }
typedef float f32x2 __attribute__((ext_vector_type(2)));
__device__ __forceinline__ f32x2 gelu_pk(f32x2 v) {
    const f32x2 av = __builtin_elementwise_abs(v), d = av * 0.2316418882f + 1.0f;
    f32x2 t; t.x = __builtin_amdgcn_rcpf(d.x); t.y = __builtin_amdgcn_rcpf(d.y);
    f32x2 q = t * 0.5307027145f + (-0.7265760135f); q = q * t + 0.7107068705f; q = q * t + (-0.142248368f); q = q * t + 0.127414796f; q = q * t;
    const f32x2 s = (v * v) * (-0.72134752044f);
    f32x2 e; e.x = __builtin_amdgcn_exp2f(s.x); e.y = __builtin_amdgcn_exp2f(s.y);
    const f32x2 m = v * (q * e), r = v - m;
    f32x2 o; o.x = v.x < 0.f ? m.x : r.x; o.y = v.y < 0.f ? m.y : r.y; return o;
}

template <int ACT  > struct EpiBf16 {
    static constexpr bool PERM = true, AFTER_DRAIN = false; static_assert(ACT == 0 || ACT == 1, "EpiBf16: ACT is 0 (none) or 1 (gelu_pk)");
    bf16_t* O; int ldc; const float* bias; int split_cols; size_t split_stride; float scale0;
    __device__ __forceinline__ void operator()(const f32x4 (&acc)[2][2][4][2], const Unit& u, int wr, int wc, int fr, int fq) const {
        const int row0 = u.pm * BM + wr * 64 + fr; int colt = u.pn * BM; bf16_t* base = O;
        float sc = 1.f; if (split_cols) { const int t = colt / split_cols; base += (size_t)t * split_stride; colt -= t * split_cols; if (t == 0) sc = scale0; }
        const int col0 = colt + wc * 32 + 8 * fq, bcol0 = u.pn * BM + wc * 32 + 8 * fq;
        f32x4 bv[2][2];
#pragma unroll
        for (int bj = 0; bj < 2; ++bj)
#pragma unroll
            for (int n = 0; n < 2; ++n) bv[bj][n] = bias ? *(const f32x4*)(bias + bcol0 + bj * HALF + 4 * n) : (f32x4){0.f, 0.f, 0.f, 0.f};
#pragma unroll
        for (int ai = 0; ai < 2; ++ai)
#pragma unroll
            for (int m = 0; m < 4; ++m) { bf16_t* rowp = base + (size_t)(row0 + ai * HALF + m * 16) * ldc + col0;
#pragma unroll
                for (int bj = 0; bj < 2; ++bj) { f32x4 v0 = acc[ai][bj][m][0] + bv[bj][0], v1 = acc[ai][bj][m][1] + bv[bj][1];
                    if (ACT == 1) { f32x2 a = gelu_pk((f32x2){v0[0], v0[1]}), b = gelu_pk((f32x2){v0[2], v0[3]}), c = gelu_pk((f32x2){v1[0], v1[1]}), d = gelu_pk((f32x2){v1[2], v1[3]});
                        v0 = (f32x4){a.x, a.y, b.x, b.y}; v1 = (f32x4){c.x, c.y, d.x, d.y}; }
                    v0 = v0 * sc; v1 = v1 * sc; u32x4 w; w.x = cvt_pk_bf16(v0[0], v0[1]); w.y = cvt_pk_bf16(v0[2], v0[3]); w.z = cvt_pk_bf16(v1[0], v1[1]); w.w = cvt_pk_bf16(v1[2], v1[3]);
                    *(u32x4*)(rowp + bj * HALF) = w; } }
    }
};
template <class Epi, class Sched, bool ALIGN_EPI = false, bool SP2 = false>
__device__ __forceinline__ void gemm_phase(PG8_LAS unsigned char* lds, const Gemm g, const Sched& S, const Epi& E, int tid_in) {
    const int tid = tid_in, wid = __builtin_amdgcn_readfirstlane(tid >> 6), lane = tid & 63, wr = wid >> 2, wc = wid & 3, fr = lane & 15, fq = lane >> 4;
    const int K = g.K, nt = K / BK;
    unsigned voffA[2], voffB[2];
#pragma unroll
    for (int i = 0; i < 2; ++i) { int R, C; stage_rc(tid * 16 + i * 8192, R, C); const int Rb = Epi::PERM ? ((R & ~31) + perm32(R & 31)) : R;
        voffA[i] = (unsigned)(R * BK + C) * 2u; voffB[i] = (unsigned)(Rb * BK + C) * 2u; }
    const size_t kstep = (size_t)(HALF * BK * 2);
    const size_t hstep = (size_t)HALF * K * 2;
    const size_t tstep = 2 * hstep;
    const unsigned ldsw = (unsigned)wid * 1024u;
    const int aoff = lds_byte(wr * 64 + fr, fq * 8), boff = lds_byte(wc * 32 + fr, fq * 8);
#define PG8_SA(b, h) (((b) * 2 + (h)) * HTB)
#define PG8_SB(b, h) ((4 + (b) * 2 + (h)) * HTB)
#define PG8_STAGE(bufoff, gbase, voff) do { _Pragma("unroll") for (int _i = 0; _i < 2; ++_i) \
        __builtin_amdgcn_global_load_lds((const unsigned*)((const char*)(gbase) + (voff)[_i]), (PG8_LAS unsigned*)(lds + (bufoff) + ldsw + _i * 8192), 16, 0, 0); } while (0)
#define PG8_LDA(dst, b, h) do { _Pragma("unroll") for (int m = 0; m < 4; ++m) _Pragma("unroll") for (int k = 0; k < 2; ++k) dst[m][k] = *(const PG8_LAS bf16x8*)(lds + PG8_SA(b, h) + aoff + m * 2048 + k * 1024); } while (0)
#define PG8_LDB(dst, b, h) do { _Pragma("unroll") for (int n = 0; n < 2; ++n) _Pragma("unroll") for (int k = 0; k < 2; ++k) dst[n][k] = *(const PG8_LAS bf16x8*)(lds + PG8_SB(b, h) + boff + n * 2048 + k * 1024); } while (0)
#define PG8_MMA(ai, bj, At, Bt) do { __builtin_amdgcn_s_setprio(1); _Pragma("unroll") for (int m = 0; m < 4; ++m) _Pragma("unroll") for (int n = 0; n < 2; ++n) _Pragma("unroll") for (int k = 0; k < 2; ++k) \
        acc[ai][bj][m][n] = __builtin_amdgcn_mfma_f32_16x16x32_bf16(Bt[n][k], At[m][k], acc[ai][bj][m][n], 0, 0, 0); __builtin_amdgcn_s_setprio(0); } while (0)
#define PG8_WAIT_V(n) asm volatile("s_waitcnt vmcnt(" #n ")" ::: "memory")
#define PG8_WAIT_L(n) asm volatile("s_waitcnt lgkmcnt(" #n ")" ::: "memory")
#define PG8_BAR __builtin_amdgcn_s_barrier()
#define PG8_SCHED __builtin_amdgcn_sched_barrier(0)
    Unit cur, nxt; int ui = 0;
    if (!S.next(0, cur)) return;
    f32x4 acc[2][2][4][2];
#pragma unroll
    for (int a = 0; a < 2; ++a)
#pragma unroll
        for (int b = 0; b < 2; ++b)
#pragma unroll
            for (int m = 0; m < 4; ++m)
#pragma unroll
                for (int n = 0; n < 2; ++n) acc[a][b][m][n] = (f32x4){0.f, 0.f, 0.f, 0.f};
    bf16x8 At[4][2], B0[2][2], B1[2][2];
    const char* cA = (const char*)g.A + (size_t)cur.pm * tstep; const char* cB = (const char*)g.Bt + (size_t)cur.pn * tstep;
    S.a_ready(cur);
    if constexpr (SP2) {
        PG8_STAGE(PG8_SB(0, 0), cB, voffB); PG8_STAGE(PG8_SB(0, 1), cB + hstep, voffB); PG8_STAGE(PG8_SA(0, 0), cA, voffA); PG8_STAGE(PG8_SA(0, 1), cA + hstep, voffA);
        if (wr == 1) PG8_BAR;
        PG8_WAIT_V(2); PG8_BAR;
        PG8_STAGE(PG8_SB(1, 0), cB + kstep, voffB); PG8_STAGE(PG8_SA(1, 0), cA + kstep, voffA); PG8_STAGE(PG8_SB(1, 1), cB + hstep + kstep, voffB);
        PG8_WAIT_V(6); PG8_BAR;
    } else {
        PG8_STAGE(PG8_SB(0, 0), cB, voffB); PG8_STAGE(PG8_SA(0, 0), cA, voffA); PG8_STAGE(PG8_SB(0, 1), cB + hstep, voffB); PG8_STAGE(PG8_SA(0, 1), cA + hstep, voffA);
        if (wr == 1) PG8_BAR;
        PG8_WAIT_V(4); PG8_BAR;
        PG8_STAGE(PG8_SB(1, 0), cB + kstep, voffB); PG8_STAGE(PG8_SA(1, 0), cA + kstep, voffA); PG8_STAGE(PG8_SB(1, 1), cB + hstep + kstep, voffB);
        PG8_WAIT_V(6); PG8_BAR;
    }
    for (;;) {
        const bool has_next = S.next(ui + 1, nxt);
        const char* nA = has_next ? (const char*)g.A + (size_t)nxt.pm * tstep : cA; const char* nB = has_next ? (const char*)g.Bt + (size_t)nxt.pn * tstep : cB;
        for (int t = 0; t < nt; t += 2) {
            const bool last = (t == nt - 2);
            const char* a1 = cA + (size_t)(t + 1) * kstep;
            const char* a2 = last ? nA : cA + (size_t)(t + 2) * kstep; const char* b2 = last ? nB : cB + (size_t)(t + 2) * kstep;
            const char* a3 = a2 + kstep; const char* b3 = b2 + kstep;
            if (last && has_next) S.a_ready(nxt);
            if constexpr (SP2) {
            PG8_LDB(B0, 0, 0); PG8_LDB(B1, 0, 1); PG8_SCHED; PG8_LDA(At, 0, 0); PG8_STAGE(PG8_SA(1, 1), a1 + hstep, voffA);
            PG8_WAIT_V(8); PG8_WAIT_L(0); PG8_BAR; PG8_MMA(0, 0, At, B0); PG8_MMA(0, 1, At, B1); PG8_BAR; PG8_SCHED;
            PG8_LDA(At, 0, 1); PG8_STAGE(PG8_SB(0, 0), b2, voffB); PG8_STAGE(PG8_SB(0, 1), b2 + hstep, voffB); PG8_STAGE(PG8_SA(0, 0), a2, voffA);
            PG8_WAIT_V(8); PG8_WAIT_L(0); PG8_BAR; PG8_MMA(1, 0, At, B0); PG8_MMA(1, 1, At, B1); PG8_BAR; PG8_SCHED;
            PG8_LDB(B0, 1, 0); PG8_LDB(B1, 1, 1); PG8_SCHED; PG8_LDA(At, 1, 0); PG8_STAGE(PG8_SA(0, 1), a2 + hstep, voffA);
            PG8_WAIT_V(8); PG8_WAIT_L(0); PG8_BAR; PG8_MMA(0, 0, At, B0); PG8_MMA(0, 1, At, B1); PG8_BAR; PG8_SCHED;
            PG8_LDA(At, 1, 1); PG8_STAGE(PG8_SB(1, 0), b3, voffB); PG8_STAGE(PG8_SB(1, 1), b3 + hstep, voffB); PG8_STAGE(PG8_SA(1, 0), a3, voffA);
            PG8_WAIT_V(8); PG8_WAIT_L(0); PG8_BAR; PG8_MMA(1, 0, At, B0); PG8_MMA(1, 1, At, B1); PG8_BAR; PG8_SCHED;
            } else {
            PG8_LDB(B0, 0, 0); PG8_SCHED; PG8_LDA(At, 0, 0); PG8_STAGE(PG8_SA(1, 1), a1 + hstep, voffA);
            PG8_WAIT_L(8); PG8_BAR; PG8_WAIT_L(0); PG8_MMA(0, 0, At, B0); PG8_BAR; PG8_SCHED;
            PG8_LDB(B1, 0, 1); PG8_STAGE(PG8_SB(0, 0), b2, voffB);
            PG8_BAR; PG8_WAIT_L(0); PG8_MMA(0, 1, At, B1); PG8_BAR;
            PG8_LDA(At, 0, 1); PG8_STAGE(PG8_SA(0, 0), a2, voffA);
            PG8_BAR; PG8_WAIT_L(0); PG8_MMA(1, 0, At, B0); PG8_BAR; PG8_SCHED;
            PG8_STAGE(PG8_SB(0, 1), b2 + hstep, voffB);
            PG8_WAIT_V(6); PG8_BAR; PG8_MMA(1, 1, At, B1); PG8_BAR;
            PG8_LDB(B0, 1, 0); PG8_SCHED; PG8_LDA(At, 1, 0); PG8_STAGE(PG8_SA(0, 1), a2 + hstep, voffA);
            PG8_WAIT_L(8); PG8_BAR; PG8_WAIT_L(0); PG8_MMA(0, 0, At, B0); PG8_BAR; PG8_SCHED;
            PG8_LDB(B1, 1, 1); PG8_STAGE(PG8_SB(1, 0), b3, voffB);
            PG8_BAR; PG8_WAIT_L(0); PG8_MMA(0, 1, At, B1); PG8_BAR;
            PG8_LDA(At, 1, 1); PG8_STAGE(PG8_SA(1, 0), a3, voffA);
            PG8_BAR; PG8_WAIT_L(0); PG8_MMA(1, 0, At, B0); PG8_BAR; PG8_SCHED;
            PG8_STAGE(PG8_SB(1, 1), b3 + hstep, voffB);
            PG8_WAIT_V(6); PG8_BAR; PG8_MMA(1, 1, At, B1); PG8_BAR;
            }
        }
        if constexpr (ALIGN_EPI) { if (wr == 0) PG8_BAR; }
        if constexpr (!Epi::AFTER_DRAIN) { E(acc, cur, wr, wc, fr, fq); S.done(cur); }
        if (!has_next) break;
#pragma unroll
        for (int a = 0; a < 2; ++a)
#pragma unroll
            for (int b = 0; b < 2; ++b)
#pragma unroll
                for (int m = 0; m < 4; ++m)
#pragma unroll
                    for (int n = 0; n < 2; ++n) acc[a][b][m][n] = (f32x4){0.f, 0.f, 0.f, 0.f};
        cur = nxt; cA = nA; cB = nB; ++ui;
        if constexpr (ALIGN_EPI) { if (wr == 1) PG8_BAR; }
    }
    PG8_WAIT_V(0);
    if constexpr (!ALIGN_EPI) { if (wr == 0) PG8_BAR; }
    PG8_BAR;
    if constexpr (Epi::AFTER_DRAIN) { E.fused(acc, cur, wr, wc, fr, fq, lds, wid, lane); S.done(cur); }
#undef PG8_SA
#undef PG8_SB
#undef PG8_STAGE
#undef PG8_LDA
#undef PG8_LDB
#undef PG8_MMA
#undef PG8_WAIT_V
#undef PG8_WAIT_L
#undef PG8_BAR
#undef PG8_SCHED
}
}
namespace pg8 {
constexpr int TAB_OFF = 131072 + 256, TAB_SLOTS = 6;
__device__ __forceinline__ int tab_slot(PG8_LAS const unsigned char* tab, const Unit& u) { const PG8_LAS int* tags = (const PG8_LAS int*)tab; const int tag = (u.pm << 8) | u.pn; int slot = 0;
#pragma unroll
    for (int i = 1; i < TAB_SLOTS; ++i) if (tags[i] == tag) slot = i;
    return slot; }
constexpr int NBIAS = 28672;
typedef unsigned u32x2 __attribute__((ext_vector_type(2)));
__device__ __forceinline__ float silu_f(float x) { return x * __builtin_amdgcn_rcpf(1.0f + __builtin_amdgcn_exp2f(-1.4426950408889634f * x)); }
__device__ __forceinline__ void row_rstd8(const float* ssq, int row0, int fq, float (&rstd)[2][4]) {
    f32x4 p[2][4][2];
#pragma unroll
    for (int ai = 0; ai < 2; ++ai)
#pragma unroll
        for (int m = 0; m < 4; ++m) { const float* q = ssq + (size_t)(row0 + ai * HALF + m * 16) * 32 + fq * 8; p[ai][m][0] = *(const f32x4*)q; p[ai][m][1] = *(const f32x4*)(q + 4); }
#pragma unroll
    for (int ai = 0; ai < 2; ++ai)
#pragma unroll
        for (int m = 0; m < 4; ++m) { float t = ((p[ai][m][0][0] + p[ai][m][0][1]) + (p[ai][m][0][2] + p[ai][m][0][3])) + ((p[ai][m][1][0] + p[ai][m][1][1]) + (p[ai][m][1][2] + p[ai][m][1][3]));
            t += __shfl_xor(t, 16); t += __shfl_xor(t, 32); rstd[ai][m] = 1.0f / sqrtf(t * (1.0f / 2048.0f) + 1e-6f); }
}
struct EpiGeluStats {
    static constexpr bool PERM = true, AFTER_DRAIN = false;
    bf16_t* O; int ldc; PG8_LAS const unsigned char* tab; float* stats;
    __device__ __forceinline__ void operator()(const f32x4 (&acc)[2][2][4][2], const Unit& u, int wr, int wc, int fr, int fq) const {
        const int row0 = u.pm * BM + wr * 64 + fr; const int col0 = u.pn * BM + wc * 32 + 8 * fq;
        const PG8_LAS float* bT = (const PG8_LAS float*)(tab + 64 + TAB_SLOTS * 1024) + tab_slot(tab, u) * 256;
        f32x4 bv[2][2];
#pragma unroll
        for (int bj = 0; bj < 2; ++bj)
#pragma unroll
            for (int n = 0; n < 2; ++n) bv[bj][n] = *(const PG8_LAS f32x4*)(bT + bj * HALF + wc * 32 + 8 * fq + 4 * n);
#pragma unroll
        for (int ai = 0; ai < 2; ++ai)
#pragma unroll
            for (int m = 0; m < 4; ++m) { const int row = row0 + ai * HALF + m * 16; bf16_t* rowp = O + (size_t)row * ldc + col0; float s1 = 0.f, s2 = 0.f;
#pragma unroll
                for (int bj = 0; bj < 2; ++bj) { f32x4 v0 = acc[ai][bj][m][0] + bv[bj][0], v1 = acc[ai][bj][m][1] + bv[bj][1];
                    f32x2 a = gelu_pk((f32x2){v0[0], v0[1]}), b = gelu_pk((f32x2){v0[2], v0[3]}), c = gelu_pk((f32x2){v1[0], v1[1]}), d = gelu_pk((f32x2){v1[2], v1[3]});
                    s1 += ((a.x + a.y) + (b.x + b.y)) + ((c.x + c.y) + (d.x + d.y));
                    s2 += ((a.x * a.x + a.y * a.y) + (b.x * b.x + b.y * b.y)) + ((c.x * c.x + c.y * c.y) + (d.x * d.x + d.y * d.y));
                    u32x4 w; w.x = cvt_pk_bf16(a.x, a.y); w.y = cvt_pk_bf16(b.x, b.y); w.z = cvt_pk_bf16(c.x, c.y); w.w = cvt_pk_bf16(d.x, d.y);
                    *(u32x4*)(rowp + bj * HALF) = w; }
                if (u.pn >= 8) { s1 += __shfl_xor(s1, 16); s1 += __shfl_xor(s1, 32); s2 += __shfl_xor(s2, 16); s2 += __shfl_xor(s2, 32);
                    if (fq == 0) *(f32x2*)(stats + ((size_t)row * 32 + (u.pn - 8) * 4 + wc) * 2) = (f32x2){s1, s2}; } }
    }
};
struct EpiSwiGLU {
    static constexpr bool PERM = true, AFTER_DRAIN = false;
    bf16_t* O; int ldc; PG8_LAS const unsigned char* tab;
    __device__ __forceinline__ void operator()(const f32x4 (&acc)[2][2][4][2], const Unit& u, int wr, int wc, int fr, int fq) const {
        const int row0 = u.pm * BM + wr * 64 + fr; const int col0 = u.pn * HALF + wc * 32 + 8 * fq;
        const int slot = tab_slot(tab, u);
        const PG8_LAS float* rT = (const PG8_LAS float*)(tab + 64) + slot * 256; const PG8_LAS float* bT = (const PG8_LAS float*)(tab + 64 + TAB_SLOTS * 1024) + slot * 256;
        float rstd[2][4];
#pragma unroll
        for (int ai = 0; ai < 2; ++ai)
#pragma unroll
            for (int m = 0; m < 4; ++m) rstd[ai][m] = rT[ai * HALF + wr * 64 + m * 16 + fr];
        f32x4 bv[2][2];
#pragma unroll
        for (int bj = 0; bj < 2; ++bj)
#pragma unroll
            for (int n = 0; n < 2; ++n) bv[bj][n] = *(const PG8_LAS f32x4*)(bT + bj * HALF + wc * 32 + 8 * fq + 4 * n);
#pragma unroll
        for (int ai = 0; ai < 2; ++ai)
#pragma unroll
            for (int m = 0; m < 4; ++m) { bf16_t* rowp = O + tidx(row0 + ai * HALF + m * 16, col0, ldc); const float rs = rstd[ai][m];
                const f32x4 g0 = acc[ai][0][m][0] * rs + bv[0][0], g1 = acc[ai][0][m][1] * rs + bv[0][1], u0 = acc[ai][1][m][0] * rs + bv[1][0], u1 = acc[ai][1][m][1] * rs + bv[1][1];
                u32x4 w; w.x = cvt_pk_bf16(silu_f(g0[0]) * u0[0], silu_f(g0[1]) * u0[1]); w.y = cvt_pk_bf16(silu_f(g0[2]) * u0[2], silu_f(g0[3]) * u0[3]);
                w.z = cvt_pk_bf16(silu_f(g1[0]) * u1[0], silu_f(g1[1]) * u1[1]); w.w = cvt_pk_bf16(silu_f(g1[2]) * u1[2], silu_f(g1[3]) * u1[3]);
                *(u32x4*)rowp = w; }
    }
};
template <bool NTB> struct EpiResNorm {
    static constexpr bool PERM = false, AFTER_DRAIN = false;
    const float* base; float* out; const float* gate; int gate_bstride; int ldc;
    const float* gam1; bf16_t* A1; const float* gam2; bf16_t* A2; float* ssq;
    __device__ __forceinline__ void operator()(f32x4 (&acc)[2][2][4][2], const Unit& u, int wr, int wc, int fr, int fq) const {
        const int row0 = u.pm * BM + wr * 64 + fr; const int col0 = u.pn * BM + wc * 32 + 4 * fq; const int b = u.pm >> 4;
        f32x4 gv[2][2], g1[2][2];
#pragma unroll
        for (int bj = 0; bj < 2; ++bj)
#pragma unroll
            for (int n = 0; n < 2; ++n) { gv[bj][n] = *(const f32x4*)(gate + (size_t)b * gate_bstride + col0 + bj * HALF + n * 16);
                g1[bj][n] = gam1 ? *(const f32x4*)(gam1 + (size_t)b * 2048 + col0 + bj * HALF + n * 16) : (f32x4){0.f, 0.f, 0.f, 0.f}; }
#pragma unroll
        for (int ai = 0; ai < 2; ++ai)
#pragma unroll
            for (int mh = 0; mh < 2; ++mh) { f32x4 t[2][2][2];
#pragma unroll
                for (int mm = 0; mm < 2; ++mm) { const size_t off = (size_t)(row0 + ai * HALF + (2 * mh + mm) * 16) * ldc + col0;
#pragma unroll
                    for (int bj = 0; bj < 2; ++bj)
#pragma unroll
                        for (int n = 0; n < 2; ++n) { if constexpr (NTB) t[mm][bj][n] = __builtin_nontemporal_load((const f32x4*)(base + off + bj * HALF + n * 16)); else t[mm][bj][n] = *(const f32x4*)(base + off + bj * HALF + n * 16); } }
#pragma unroll
                for (int mm = 0; mm < 2; ++mm) { const int m = 2 * mh + mm; const int row = row0 + ai * HALF + m * 16; const size_t off = (size_t)row * ldc + col0;
#pragma unroll
                    for (int bj = 0; bj < 2; ++bj)
#pragma unroll
                        for (int n = 0; n < 2; ++n) { acc[ai][bj][m][n] = t[mm][bj][n] + acc[ai][bj][m][n] * gv[bj][n]; *(f32x4*)(out + off + bj * HALF + n * 16) = acc[ai][bj][m][n]; }
                    if (gam1) { float ss = 0.f;
#pragma unroll
                        for (int bj = 0; bj < 2; ++bj)
#pragma unroll
                            for (int n = 0; n < 2; ++n) { const f32x4 x = acc[ai][bj][m][n]; ss += (x[0] * x[0] + x[1] * x[1]) + (x[2] * x[2] + x[3] * x[3]);
                                const f32x4 y = x * g1[bj][n]; u32x2 w; w.x = cvt_pk_bf16(y[0], y[1]); w.y = cvt_pk_bf16(y[2], y[3]); *(u32x2*)(A1 + tidx(row, col0 + bj * HALF + n * 16, 2048)) = w; }
                        ss += __shfl_xor(ss, 16); ss += __shfl_xor(ss, 32);
                        if (fq == 0) ssq[(size_t)row * 32 + u.pn * 4 + wc] = ss; } } }
        if (gam2) {
#pragma unroll
            for (int bj = 0; bj < 2; ++bj)
#pragma unroll
                for (int n = 0; n < 2; ++n) g1[bj][n] = *(const f32x4*)(gam2 + (size_t)b * 2048 + col0 + bj * HALF + n * 16);
#pragma unroll
            for (int ai = 0; ai < 2; ++ai)
#pragma unroll
                for (int m = 0; m < 4; ++m) { const int row = row0 + ai * HALF + m * 16;
#pragma unroll
                    for (int bj = 0; bj < 2; ++bj)
#pragma unroll
                        for (int n = 0; n < 2; ++n) { const f32x4 y = acc[ai][bj][m][n] * g1[bj][n]; u32x2 w; w.x = cvt_pk_bf16(y[0], y[1]); w.y = cvt_pk_bf16(y[2], y[3]); *(u32x2*)(A2 + tidx(row, col0 + bj * HALF + n * 16, 2048)) = w; } } }
    }
};
struct EpiQKRope {
    static constexpr bool PERM = false, AFTER_DRAIN = true;
    bf16_t* O; const float* g; const float* rt; const float* ssq; const float* bias;
    __device__ __forceinline__ void fused(f32x4 (&acc)[2][2][4][2], const Unit& u, int wr, int wc, int fr, int fq, PG8_LAS unsigned char* lds, int wid, int lane) const {
        PG8_LAS float* P = (PG8_LAS float*)lds;
        { float rstd[2][4]; row_rstd8(ssq, u.pm * BM + wr * 64 + fr, fq, rstd);
#pragma unroll
          for (int bj = 0; bj < 2; ++bj)
#pragma unroll
            for (int n = 0; n < 2; ++n) { const f32x4 bv = *(const f32x4*)(bias + (size_t)(u.pm >> 4) * NBIAS + u.pn * BM + bj * HALF + wc * 32 + 16 * n + 4 * fq);
#pragma unroll
                for (int ai = 0; ai < 2; ++ai)
#pragma unroll
                    for (int m = 0; m < 4; ++m) acc[ai][bj][m][n] = acc[ai][bj][m][n] * rstd[ai][m] + bv; } }
#pragma unroll
        for (int ai = 0; ai < 2; ++ai)
#pragma unroll
            for (int m = 0; m < 4; ++m)
#pragma unroll
                for (int bj = 0; bj < 2; ++bj) { const f32x4 a = acc[ai][bj][m][0], c = acc[ai][bj][m][1];
                    float ss = ((a[0] * a[0] + a[1] * a[1]) + (a[2] * a[2] + a[3] * a[3])) + ((c[0] * c[0] + c[1] * c[1]) + (c[2] * c[2] + c[3] * c[3]));
                    ss += __shfl_xor(ss, 16); ss += __shfl_xor(ss, 32);
                    if (fq == 0) P[((ai * HALF + wr * 64 + m * 16 + fr) * 2 + bj) * 4 + wc] = ss; }
        asm volatile("s_waitcnt lgkmcnt(0)" ::: "memory"); __builtin_amdgcn_s_barrier(); asm volatile("" ::: "memory");
        const int d = 16 * wc + 4 * fq; const f32x4 ga = *(const f32x4*)(g + d), gb = *(const f32x4*)(g + 64 + d);
#pragma unroll
        for (int ai = 0; ai < 2; ++ai)
#pragma unroll
            for (int m = 0; m < 4; ++m) { const int rl = ai * HALF + wr * 64 + m * 16 + fr, row = u.pm * BM + rl, b = row >> 12, s = row & 4095;
                const f32x4 cs0 = *(const f32x4*)(rt + ((size_t)row * 64 + d) * 2), cs1 = *(const f32x4*)(rt + ((size_t)row * 64 + d) * 2 + 4);
                const float co[4] = {cs0[0], cs0[2], cs1[0], cs1[2]}, si[4] = {cs0[1], cs0[3], cs1[1], cs1[3]};
#pragma unroll
                for (int bj = 0; bj < 2; ++bj) { const f32x4 pp = *(const PG8_LAS f32x4*)(P + (rl * 2 + bj) * 4);
                    const float rstd = 1.0f / sqrtf(((pp[0] + pp[1]) + (pp[2] + pp[3])) * (1.0f / 128.0f) + 1e-6f);
                    const f32x4 x1 = acc[ai][bj][m][0] * rstd * ga, x2 = acc[ai][bj][m][1] * rstd * gb; float o1[4], o2[4];
#pragma unroll
                    for (int i = 0; i < 4; ++i) { o1[i] = x1[i] * co[i] - x2[i] * si[i]; o2[i] = x2[i] * co[i] + x1[i] * si[i]; }
                    bf16_t* op = O + ((size_t)(b * 16 + 2 * u.pn + bj) * 4096 + s) * 128 + d;
                    u32x2 w1, w2; w1.x = cvt_pk_bf16(o1[0], o1[1]); w1.y = cvt_pk_bf16(o1[2], o1[3]); w2.x = cvt_pk_bf16(o2[0], o2[1]); w2.y = cvt_pk_bf16(o2[2], o2[3]);
                    *(u32x2*)op = w1; *(u32x2*)(op + 64) = w2; } }
        asm volatile("s_waitcnt lgkmcnt(0)" ::: "memory"); __builtin_amdgcn_s_barrier(); asm volatile("" ::: "memory");
    }
};
struct EpiVhead {
    static constexpr bool PERM = true, AFTER_DRAIN = false;
    bf16_t* O; const float* ssq; const float* bias;
    __device__ __forceinline__ void operator()(const f32x4 (&acc)[2][2][4][2], const Unit& u, int wr, int wc, int fr, int fq) const {
        const int row0 = u.pm * BM + wr * 64 + fr;
        float rstd[2][4]; row_rstd8(ssq, row0, fq, rstd);
        f32x4 bv[2][2];
#pragma unroll
        for (int bj = 0; bj < 2; ++bj)
#pragma unroll
            for (int n = 0; n < 2; ++n) bv[bj][n] = *(const f32x4*)(bias + (size_t)(u.pm >> 4) * NBIAS + u.pn * BM + bj * HALF + wc * 32 + 8 * fq + 4 * n);
#pragma unroll
        for (int ai = 0; ai < 2; ++ai)
#pragma unroll
            for (int m = 0; m < 4; ++m) { const int row = row0 + ai * HALF + m * 16, b = row >> 12, s = row & 4095; const float rs = rstd[ai][m];
#pragma unroll
                for (int bj = 0; bj < 2; ++bj) { bf16_t* p = O + ((size_t)(b * 16 + 2 * u.pn + bj) * 4096 + s) * 128 + wc * 32 + 8 * fq;
                    const f32x4 v0 = acc[ai][bj][m][0] * rs + bv[bj][0], v1 = acc[ai][bj][m][1] * rs + bv[bj][1];
                    u32x4 w; w.x = cvt_pk_bf16(v0[0], v0[1]); w.y = cvt_pk_bf16(v0[2], v0[3]); w.z = cvt_pk_bf16(v1[0], v1[1]); w.w = cvt_pk_bf16(v1[2], v1[3]);
                    *(u32x4*)p = w; } }
    }
};
}
namespace att {
constexpr int D = 128; constexpr float THR = 8.f; constexpr bool WSKIP = false;
constexpr float SCALE = 0.08838834764831845f;
constexpr int NW = 8, QBLK = 32, KVBLK = 64, QB = NW * QBLK;
constexpr int SHM_V = KVBLK * D * 2, SHM_K = KVBLK * D * 2;
constexpr int LDS_BYTES = 2 * SHM_V + 2 * SHM_K + NW * 64 * 4;
using bf16 = __hip_bfloat16;
typedef short bf16x8 __attribute__((ext_vector_type(8)));
typedef short s16x4 __attribute__((ext_vector_type(4)));
typedef float f32x16 __attribute__((ext_vector_type(16)));
typedef float f32x4 __attribute__((ext_vector_type(4)));
typedef unsigned u32x4 __attribute__((ext_vector_type(4)));
template <class A, class Bt> struct same_t { static constexpr bool v = false; };
template <class A> struct same_t<A, A> { static constexpr bool v = true; };

#define KSWZ(row, colB) ((row) * 256 + ((colB) ^ (((row) & 7) << 4)))
#define SBAR() __builtin_amdgcn_sched_barrier(0)
__device__ __forceinline__ int v_st(int k, int c) { const int kk = (k & ~0xC) | ((k & 4) << 1) | ((k & 8) >> 1); return ((kk >> 3) * 4 + (c >> 5)) * 512 + ((kk & 7) * 32 + (c & 31)) * 2; }
__device__ __forceinline__ int v_rd_base(int lane) { return ((lane & 3) << 3) | (((lane >> 2) & 3) << 6) | (((lane >> 4) & 1) << 5) | (((lane >> 5) & 1) << 8); }
constexpr int v_rd_off(int d0, int ks, int half) { return d0 * 512 + ks * 4096 + half * 2048; }
__device__ __forceinline__ int crow(int r, int hi) { return (r & 3) + 8 * (r >> 2) + 4 * hi; }
__device__ __forceinline__ unsigned cvtpk(float lo, float hi) {
    unsigned r; asm volatile("v_cvt_pk_bf16_f32 %0, %1, %2" : "=v"(r) : "v"(lo), "v"(hi)); return r;
}
__device__ __forceinline__ bf16x8 pack8(f32x4 a, f32x4 b) {
    u32x4 w = {cvtpk(a[0], a[1]), cvtpk(a[2], a[3]), cvtpk(b[0], b[1]), cvtpk(b[2], b[3])};
    return *reinterpret_cast<bf16x8*>(&w);
}
template <class T> __device__ __forceinline__ bf16x8 load8(const T* p) {
    if constexpr (same_t<T, float>::v) { return pack8(*(const f32x4*)p, *(const f32x4*)(p + 4)); }
    else { return *reinterpret_cast<const bf16x8*>(p); }
}
__device__ __forceinline__ void mask_tile(f32x16& p0, f32x16& p1, int dq, unsigned W) {
    const float NEG = -__builtin_inff();
#pragma unroll
    for (int r = 0; r < 16; ++r) {
        const int c = (r & 3) + 8 * (r >> 2);
        if ((unsigned)(dq - c) >= W) p0[r] = NEG;
        if ((unsigned)(dq - c - 32) >= W) p1[r] = NEG;
    }
}
__device__ __forceinline__ void partialSM(f32x16& p0, f32x16& p1, float& m_reg, float& mn, float& alpha) {
    float pmax = p0[0]; for (int r = 1; r < 16; ++r) pmax = fmaxf(pmax, p0[r]); for (int r = 0; r < 16; ++r) pmax = fmaxf(pmax, p1[r]);
    { auto rr = __builtin_amdgcn_permlane32_swap(__float_as_uint(pmax), __float_as_uint(pmax), false, false);
      pmax = fmaxf(__uint_as_float(rr[0]), __uint_as_float(rr[1])); }
    constexpr float C2 = 1.4426950408889634f * SCALE;
    if (__builtin_expect(__all((pmax - m_reg) * SCALE <= THR), 1)) { mn = m_reg; alpha = 1.f; }
    else { mn = fmaxf(m_reg, pmax); alpha = __builtin_amdgcn_exp2f((m_reg - mn) * C2); m_reg = mn; }
    const float mnL = -mn * C2;
    for (int r = 0; r < 16; ++r) p0[r] = fmaf(p0[r], C2, mnL); for (int r = 0; r < 16; ++r) p1[r] = fmaf(p1[r], C2, mnL);
    for (int r = 0; r < 16; ++r) p0[r] = __builtin_amdgcn_exp2f(p0[r]);
}
__device__ __forceinline__ void finishSM(f32x16& p0, f32x16& p1, float alpha, float& l_reg, bf16x8& pa0, bf16x8& pa1, bf16x8& pa2, bf16x8& pa3) {
    for (int r = 0; r < 16; ++r) p1[r] = __builtin_amdgcn_exp2f(p1[r]);
    float ps = 0; for (int r = 0; r < 16; ++r) ps += p0[r]; for (int r = 0; r < 16; ++r) ps += p1[r];
    { auto rr = __builtin_amdgcn_permlane32_swap(__float_as_uint(ps), __float_as_uint(ps), false, false);
      ps = __uint_as_float(rr[0]) + __uint_as_float(rr[1]); }
    l_reg = l_reg * alpha + ps;
#define PK4(P, B_, OUT) do { unsigned a0 = cvtpk(P[B_+0], P[B_+1]), a1 = cvtpk(P[B_+2], P[B_+3]);                          \
        unsigned b0 = cvtpk(P[B_+4], P[B_+5]), b1 = cvtpk(P[B_+6], P[B_+7]);                                             \
        auto r0 = __builtin_amdgcn_permlane32_swap(a0, b0, false, false); auto r1 = __builtin_amdgcn_permlane32_swap(a1, b1, false, false); \
        u32x4 w = {r0[0], r1[0], r0[1], r1[1]}; OUT = *reinterpret_cast<bf16x8*>(&w); } while (0)
    PK4(p0, 0, pa0); PK4(p0, 8, pa1); PK4(p1, 0, pa2); PK4(p1, 8, pa3);
#undef PK4
}
template <int KB, bool SK>
__device__ __forceinline__ void qkt(f32x16& p0, f32x16& p1, const char* K_lds, int r32, int hi, const bf16x8* qr, bool act) {
    if (SK && !act) { const float NEG = -__builtin_inff();
#pragma unroll
        for (int r = 0; r < 16; ++r) { p0[r] = NEG; p1[r] = NEG; } return; }
    p0 = f32x16{}; p1 = f32x16{};
    const char* kb[4];
#pragma unroll
    for (int dd = 0; dd < 4; ++dd) kb[dd] = K_lds + KB * SHM_K + KSWZ(r32, (dd * 16 + hi * 8) * 2);
#pragma unroll
    for (int d0 = 0; d0 < 8; ++d0) { const char* a = kb[d0 & 3] + (d0 >> 2) * 128;
        bf16x8 b0 = *reinterpret_cast<const bf16x8*>(a);
        bf16x8 b1 = *reinterpret_cast<const bf16x8*>(a + 32 * 256);
        p0 = __builtin_amdgcn_mfma_f32_32x32x16_bf16(b0, qr[d0], p0, 0, 0, 0);
        p1 = __builtin_amdgcn_mfma_f32_32x32x16_bf16(b1, qr[d0], p1, 0, 0, 0); }
}
template <int VB, bool SK>
__device__ __forceinline__ void pv_tile(f32x16* o, int vb0, bf16x8 pa0, bf16x8 pa1, bf16x8 pa2, bf16x8 pa3, bool act) {
    if (SK && !act) return;
#define TRRD(dst, off) asm volatile("ds_read_b64_tr_b16 %0, %1 offset:%2" : "=&v"(dst) : "v"(vb0), "i"(off) : "memory")
#define PV_D0(d0) do { s16x4 l0, l1, l2, l3, h0, h1, h2, h3; constexpr int b_ = VB * SHM_V + v_rd_off(d0, 0, 0);     \
        TRRD(l0, b_); TRRD(h0, b_ + 2048); TRRD(l1, b_ + 4096); TRRD(h1, b_ + 6144); TRRD(l2, b_ + 8192); TRRD(h2, b_ + 10240); TRRD(l3, b_ + 12288); TRRD(h3, b_ + 14336); \
        asm volatile("s_waitcnt lgkmcnt(0)" ::: "memory"); SBAR();                 \
        o[d0] = __builtin_amdgcn_mfma_f32_32x32x16_bf16(pa0, (bf16x8){l0[0], l0[1], l0[2], l0[3], h0[0], h0[1], h0[2], h0[3]}, o[d0], 0, 0, 0);   \
        o[d0] = __builtin_amdgcn_mfma_f32_32x32x16_bf16(pa1, (bf16x8){l1[0], l1[1], l1[2], l1[3], h1[0], h1[1], h1[2], h1[3]}, o[d0], 0, 0, 0);   \
        o[d0] = __builtin_amdgcn_mfma_f32_32x32x16_bf16(pa2, (bf16x8){l2[0], l2[1], l2[2], l2[3], h2[0], h2[1], h2[2], h2[3]}, o[d0], 0, 0, 0);   \
        o[d0] = __builtin_amdgcn_mfma_f32_32x32x16_bf16(pa3, (bf16x8){l3[0], l3[1], l3[2], l3[3], h3[0], h3[1], h3[2], h3[3]}, o[d0], 0, 0, 0); } while (0)
    PV_D0(0); PV_D0(1); PV_D0(2); PV_D0(3);
#undef PV_D0
#undef TRRD
}

template <class TIn, class TOut> struct BlockRef { const TIn* Q; const TIn* K; const TIn* V; TOut* O; int P0; };
template <class TIn> struct Seam {
    bf16x8 qr[8];
    bf16x8 st_v0, st_v1, st_k0, st_k1; f32x4 sf0, sf1, sf2, sf3;
    f32x4 tq[16];
};
__device__ __forceinline__ int swa_jlo(int P0, int W) { const int lowk = P0 - W + 1; return lowk > 0 ? lowk / KVBLK : 0; }
#define ROW(p, k0, rr) ((p) + (size_t)((k0) + (rr)) * D + sc)
#define VMW() asm volatile("s_waitcnt vmcnt(0)" ::: "memory")
#define VMWN(n) asm volatile("s_waitcnt vmcnt(%0)" :: "i"(n) : "memory")
#define SLOAD_H(Kp, Vp, k0) do { S.st_v0 = load8<TIn>(ROW(Vp, k0, sr)); S.st_v1 = load8<TIn>(ROW(Vp, k0, 32 + sr));              \
                         S.st_k0 = load8<TIn>(ROW(Kp, k0, sr)); S.st_k1 = load8<TIn>(ROW(Kp, k0, 32 + sr)); } while (0)
#define SWRITE_HK(bf) do { *(bf16x8*)(K_lds + (bf) * SHM_K + kws) = S.st_k0; *(bf16x8*)(K_lds + (bf) * SHM_K + kws + 32 * 256) = S.st_k1; } while (0)
#define SWRITE_HV(bf) do { *(bf16x8*)(V_lds + (bf) * SHM_V + vst0) = S.st_v0; *(bf16x8*)(V_lds + (bf) * SHM_V + vst1) = S.st_v1; } while (0)
#define SWRITE_H(bf) do { SWRITE_HV(bf); SWRITE_HK(bf); } while (0)
#define SLOAD_F(p, k0) do { S.sf0 = *(const f32x4*)ROW(p, k0, sr); S.sf1 = *(const f32x4*)(ROW(p, k0, sr) + 4);                \
                            S.sf2 = *(const f32x4*)ROW(p, k0, 32 + sr); S.sf3 = *(const f32x4*)(ROW(p, k0, 32 + sr) + 4); } while (0)
#define SWRITE_KF(bf) do { *(bf16x8*)(K_lds + (bf) * SHM_K + kws) = pack8(S.sf0, S.sf1); *(bf16x8*)(K_lds + (bf) * SHM_K + kws + 32 * 256) = pack8(S.sf2, S.sf3); } while (0)
#define SWRITE_VF(bf) do { *(bf16x8*)(V_lds + (bf) * SHM_V + vst0) = pack8(S.sf0, S.sf1); *(bf16x8*)(V_lds + (bf) * SHM_V + vst1) = pack8(S.sf2, S.sf3); } while (0)
template <class TIn, class TOut>
__device__ __forceinline__ void causal_swa_prime(const BlockRef<TIn, TOut>& cur, int W, char* lds, Seam<TIn>& S, int tid_in) {
    constexpr bool F32 = same_t<TIn, float>::v;
    const int tid = tid_in, wid = __builtin_amdgcn_readfirstlane(tid >> 6), lane = tid & 63, r32 = lane & 31, hi = lane >> 5;
    const int sr = tid >> 4, sc = (tid & 15) * 8, kws = KSWZ(sr, sc * 2); char* K_lds = lds + 2 * SHM_V;
    const int kb0 = swa_jlo(cur.P0, W) * KVBLK;
    for (int d0 = 0; d0 < 8; ++d0) S.qr[d0] = load8<TIn>(cur.Q + (size_t)(wid * QBLK + r32) * D + d0 * 16 + hi * 8);
    if constexpr (F32) { SLOAD_F((const float*)cur.K, kb0); VMW(); SWRITE_KF(0); SBAR(); SLOAD_F((const float*)cur.V, kb0); }
    else { SLOAD_H(cur.K, cur.V, kb0); VMW(); SWRITE_HK(0); }
    __syncthreads();
}
template <class TIn, class TOut>
__device__ __forceinline__ void causal_swa_block(const BlockRef<TIn, TOut>& cur, const BlockRef<TIn, TOut>& nxt, int skv, int W, char* lds, Seam<TIn>& S, int tid_in) {
    constexpr bool F32 = same_t<TIn, float>::v;
    const int tid = tid_in, wid = __builtin_amdgcn_readfirstlane(tid >> 6), lane = tid & 63, r32 = lane & 31, hi = lane >> 5;
    const int j_lo = swa_jlo(cur.P0, W);
    int j_hi = (cur.P0 + QB - 1) / KVBLK + 1; if (j_hi > skv / KVBLK) j_hi = skv / KVBLK;
    const int NT = j_hi - j_lo;
    const int kbn = swa_jlo(nxt.P0, W) * KVBLK;
    const int qlo = cur.P0 + wid * QBLK, qm = qlo + r32 - 4 * hi;
    char* V_lds = lds; char* K_lds = lds + 2 * SHM_V;
    float* ws = (float*)(lds + 2 * SHM_V + 2 * SHM_K) + wid * 64; float* li_l = ws, * al_l = ws + 32;
    float m_reg = -1e30f, l_reg = 0; f32x16 o[4] = {};
    const int sr = tid >> 4, sc = (tid & 15) * 8, vst0 = v_st(sr, sc), vst1 = v_st(32 + sr, sc), kws = KSWZ(sr, sc * 2);
    const int vb0 = (int)(uintptr_t)V_lds + v_rd_base(lane);
    const TIn* Kh = cur.K; const TIn* Vh = cur.V;
#define RESC(a) do { if (__any((a) < 1.f)) { if (hi == 0) al_l[r32] = (a); asm volatile("s_waitcnt lgkmcnt(0)" ::: "memory");              \
                     for (int d_ = 0; d_ < 4; ++d_) for (int r = 0; r < 16; ++r) o[d_][r] *= al_l[crow(r, hi)]; } } while (0)
#define KBASE(t) ((j_lo + (t)) * KVBLK)
#define ACT(t) (KBASE(t) <= qlo + QBLK - 1 && KBASE(t) + KVBLK - 1 >= qlo - W + 1)
#define MASKT(P0_, P1_, t) do { const int kb_ = KBASE(t); if ((!SK || ACT(t)) && (kb_ + KVBLK - 1 > qlo || kb_ <= qlo + QBLK - 1 - W)) mask_tile(P0_, P1_, qm - kb_, (unsigned)W); } while (0)
    constexpr int NQL = F32 ? 16 : 8;
    constexpr bool SK = WSKIP && !F32;
#define SEAM_K0() do { VMWN(NQL); if constexpr (F32) { SWRITE_KF(0); SBAR(); SLOAD_F((const float*)nxt.V, kbn); } else { SWRITE_HK(0); } SBAR(); } while (0)
    f32x16 pA0, pA1, pB0, pB1; float mnA, mnB, alA, alB; bf16x8 pa0, pa1, pa2, pa3;
    if constexpr (F32) { VMW(); SWRITE_VF(0); SBAR(); } else { SWRITE_HV(0); SBAR(); }
    if (NT > 1) { if constexpr (F32) SLOAD_F((const float*)Kh, KBASE(1)); else SLOAD_H(Kh, Vh, KBASE(1)); }
    SBAR(); qkt<0, SK>(pA0, pA1, K_lds, r32, hi, S.qr, ACT(0));
    if constexpr (F32) { if (NT > 1) { VMW(); SWRITE_KF(1); SBAR(); SLOAD_F((const float*)Vh, KBASE(1)); } }
    MASKT(pA0, pA1, 0); partialSM(pA0, pA1, m_reg, mnA, alA);
    if (NT > 1) { VMW(); if constexpr (F32) { SWRITE_VF(1); SBAR(); if (NT > 2) SLOAD_F((const float*)Kh, KBASE(2)); } else SWRITE_H(1); }
    __syncthreads();
#define HALF_STEP(PX0, PX1, mnX, alX, PY0, PY1, alY, t, KB, VB, SB) do {                                                      \
        SBAR(); qkt<KB, SK>(PX0, PX1, K_lds, r32, hi, S.qr, ACT(t));                                             \
        finishSM(PY0, PY1, alY, l_reg, pa0, pa1, pa2, pa3); SBAR();                                                           \
        if ((t) + 1 < NT) { if constexpr (F32) { VMW(); SWRITE_KF(SB); SBAR(); SLOAD_F((const float*)Vh, KBASE((t) + 1)); }  \
                            else { SLOAD_H(Kh, Vh, KBASE((t) + 1)); } SBAR(); }                                               \
        pv_tile<VB, SK>(o, vb0, pa0, pa1, pa2, pa3, ACT((t) - 1)); MASKT(PX0, PX1, (t)); partialSM(PX0, PX1, m_reg, mnX, alX);                                        \
        __syncthreads();                                                                                                      \
        if ((t) + 1 < NT) { VMW(); if constexpr (F32) { SWRITE_VF(SB); SBAR(); if ((t) + 2 < NT) SLOAD_F((const float*)Kh, KBASE((t) + 2)); } \
                            else { SWRITE_H(SB); } }                                                                          \
        RESC(alX); __syncthreads(); } while (0)
    for (int t = 1; t + 1 < NT; t += 2) {
        HALF_STEP(pB0, pB1, mnB, alB, pA0, pA1, alA, t, 1, 0, 0);
        HALF_STEP(pA0, pA1, mnA, alA, pB0, pB1, alB, t + 1, 0, 1, 1);
    }
    const bool even = (NT & 1) == 0;
    if (even) { SBAR(); qkt<1, SK>(pB0, pB1, K_lds, r32, hi, S.qr, ACT(NT - 1)); SBAR(); }
#define QROW(e) (nxt.Q + (size_t)(wid * QBLK + r32) * D + ((e) >> 1) * 16 + hi * 8 + ((e) & 1) * 4)
    if constexpr (F32) { SLOAD_F((const float*)nxt.K, kbn); SBAR();
#pragma unroll
        for (int e = 0; e < 8; ++e) S.tq[e] = *(const f32x4*)QROW(e); }
    else { SLOAD_H(nxt.K, nxt.V, kbn); SBAR();
#pragma unroll
        for (int d0 = 0; d0 < 8; ++d0) S.qr[d0] = load8<TIn>(nxt.Q + (size_t)(wid * QBLK + r32) * D + d0 * 16 + hi * 8); }
    SBAR();
    finishSM(pA0, pA1, alA, l_reg, pa0, pa1, pa2, pa3); SBAR();
    if constexpr (F32) {
#pragma unroll
        for (int e = 8; e < 16; ++e) S.tq[e] = *(const f32x4*)QROW(e); SBAR(); }
#undef QROW
    pv_tile<0, SK>(o, vb0, pa0, pa1, pa2, pa3, ACT(even ? NT - 2 : NT - 1));
    if (even) { MASKT(pB0, pB1, NT - 1); partialSM(pB0, pB1, m_reg, mnB, alB); __syncthreads(); RESC(alB);
        finishSM(pB0, pB1, alB, l_reg, pa0, pa1, pa2, pa3); SBAR(); pv_tile<1, SK>(o, vb0, pa0, pa1, pa2, pa3, ACT(NT - 1)); }
    SBAR(); SEAM_K0();
    if (hi == 0) li_l[r32] = l_reg; asm volatile("s_waitcnt lgkmcnt(0)" ::: "memory");
    float rli[16];
#pragma unroll
    for (int r = 0; r < 16; ++r) rli[r] = __builtin_amdgcn_rcpf(li_l[crow(r, hi)]);
    TOut* Ow = cur.O + (size_t)(wid * QBLK) * D;
#pragma unroll
    for (int r = 0; r < 16; ++r) { const int orow = crow(r, hi);
#pragma unroll
        for (int d0 = 0; d0 < 4; ++d0) { const float v = o[d0][r] * rli[r];
            if constexpr (same_t<TOut, float>::v) { Ow[(size_t)orow * D + d0 * 32 + r32] = v; }
            else { const float vn = __shfl_xor(v, 1);
                   if ((r32 & 1) == 0) *(unsigned*)(Ow + (size_t)orow * D + d0 * 32 + r32) = cvtpk(v, vn); } } }
    if constexpr (F32) {
#pragma unroll
        for (int d0 = 0; d0 < 8; ++d0) S.qr[d0] = pack8(S.tq[2 * d0], S.tq[2 * d0 + 1]); }
    __syncthreads();
#undef RESC
#undef KBASE
#undef ACT
#undef MASKT
#undef SEAM_K0
#undef HALF_STEP
}
#undef ROW
#undef VMW
#undef VMWN
#undef SLOAD_H
#undef SWRITE_HK
#undef SWRITE_HV
#undef SWRITE_H
#undef SLOAD_F
#undef SWRITE_KF
#undef SWRITE_VF
}
#include <hip/hip_cooperative_groups.h>
namespace cg = cooperative_groups;
#ifndef MK_N_LAUNCHES
#define MK_N_LAUNCHES 1
#endif
constexpr int NWAVES = 8;
constexpr int BATCH = 2, SEQ = 4096, DM = 2048, M = BATCH * SEQ, DFF = 5632, NMOD = 28672;
constexpr int MOD_A = 0, MOD_KV = 12288, MOD_B = 16384;
constexpr float EPS = 1e-6f;
constexpr float LAM_INIT = 0.35550906759f;
constexpr size_t MiB = 1u << 20;
constexpr size_t WS_MODS = 1 * MiB, WS_RT = 2 * MiB, WS_STATS = 6 * MiB;
constexpr size_t WS_W_IN = 8 * MiB, WS_W_OUT = 24 * MiB, WS_W_FIA = 32 * MiB, WS_W_FOA = 76 * MiB, WS_W_KV = 98 * MiB, WS_W_Q = 114 * MiB, WS_W_O = 122 * MiB, WS_W_FIB = 130 * MiB, WS_W_FOB = 174 * MiB;
constexpr size_t WS_XA = 196 * MiB, WS_XB = 260 * MiB, WS_XN = 324 * MiB, WS_XQ = 356 * MiB, WS_A3 = 388 * MiB, WS_Z = 420 * MiB, WS_QRAW = 420 * MiB, WS_H = 484 * MiB, WS_KRAW = 484 * MiB;
constexpr size_t WS_O = 420 * MiB, WS_VB = 548 * MiB, WS_KB = 580 * MiB, WS_QB = 612 * MiB, WS_SSQ = 644 * MiB, WS_END = 646 * MiB;
constexpr size_t WS_GAM = WS_MODS + 256 * 1024, WS_BIAS = WS_MODS + 512 * 1024;
constexpr int OFF_FIA = 0, OFF_KV = 11264, OFF_Q = 15360, OFF_FIB = 17408;
constexpr int LDS_BYTES = 147456;

#define GAS __attribute__((address_space(1)))
#define LAS __attribute__((address_space(3)))
typedef unsigned short hb;
typedef unsigned v4u __attribute__((ext_vector_type(4)));
typedef unsigned v2u __attribute__((ext_vector_type(2)));
typedef float f32x4 __attribute__((ext_vector_type(4)));
typedef float f32x2 __attribute__((ext_vector_type(2)));
typedef short bf16x8 __attribute__((ext_vector_type(8)));
#define LDS_WAIT() asm volatile("s_waitcnt lgkmcnt(0)" ::: "memory")
__device__ __forceinline__ unsigned f2bf(float f) { unsigned u = __builtin_bit_cast(unsigned, f); return (u + 0x7fffu + ((u >> 16) & 1u)) >> 16; }
__device__ __forceinline__ unsigned pk2(float lo, float hi) { return f2bf(lo) | (f2bf(hi) << 16); }
__device__ __forceinline__ float bflo(unsigned w) { return __builtin_bit_cast(float, w << 16); }
__device__ __forceinline__ float bfhi(unsigned w) { return __builtin_bit_cast(float, w & 0xffff0000u); }
__device__ __forceinline__ float wave_sum(float v) {
#pragma unroll
    for (int o = 1; o < 64; o <<= 1) v += __shfl_xor(v, o);
    return v;
}

__device__ __forceinline__ int wt_rowmap(int n, int mode, int N, int rope_lim) {
    if (mode == 1) { const int half = N / 2; const int mm = n < half ? n : n - half; return 256 * (mm / 128) + (mm % 128) + (n < half ? 0 : 128); }
    if (mode == 2 && n < rope_lim) { const int d = n & 127; return (n & ~127) + 32 * ((d & 63) >> 4) + 16 * (d >> 6) + 4 * ((d & 15) >> 2) + (d & 3); }
    return n;
}
struct TrItem { const float* W; hb* WT; int K, N, mode, lim, k0, n0; };
__device__ __forceinline__ void tr_load(const TrItem& t, float (&tv)[32], int lane) {
#pragma unroll
    for (int i = 0; i < 32; ++i) { const int kk = 2 * i + (lane >> 5); tv[i] = __builtin_nontemporal_load(t.W + (size_t)(t.k0 + kk) * t.N + t.n0 + (lane & 31)); }
}

#define XB_TMO      128
#define XB_XCNT(j)  (256  + 64 * (j))
#define XB_XSUB(j)  (1280 + 64 * (j))
#define XB_XGEN(j)  (2304 + 64 * (j))
#define XB_TOP      3328
#define XB_TOPGEN   3392
#define XCD_BAR_WORDS 3456
#define XB_SPIN_CAP (1u << 18)

__device__ __forceinline__ unsigned xb_ld(unsigned* p)              { return __hip_atomic_load(p, __ATOMIC_RELAXED, __HIP_MEMORY_SCOPE_AGENT); }
__device__ __forceinline__ unsigned xb_add(unsigned* p, unsigned v) { return __hip_atomic_fetch_add(p, v, __ATOMIC_RELAXED, __HIP_MEMORY_SCOPE_AGENT); }
__device__ __forceinline__ unsigned xb_xcc_id() { return (unsigned)__builtin_amdgcn_s_getreg((3 << 11) | 20) & 0xFu; }
#define XB_SPIN(cond, bar) do { unsigned _sp = 0; while (cond) { __builtin_amdgcn_s_sleep(1); \
    if ((++_sp & 255u) == 0u) { if (xb_ld(&(bar)[XB_TMO])) break; if (_sp > XB_SPIN_CAP) { atomicAdd(&(bar)[XB_TMO], 1u); break; } } } } while (0)

struct XcdBarrier {
    unsigned* bar; unsigned x;
    volatile LAS unsigned* st;
};

__device__ __forceinline__ XcdBarrier xcd_barrier_post(unsigned* bar, volatile LAS unsigned* st, int tid) {
    XcdBarrier b; b.bar = bar; b.x = xb_xcc_id(); b.st = st;
    if (tid == 0) (void)xb_add(&bar[XB_XCNT(b.x)], 1u);
    return b;
}
__device__ __forceinline__ void xcd_barrier_complete(unsigned* bar, unsigned x, unsigned& nloc, unsigned& nx) {
    const unsigned G = gridDim.x * gridDim.y * gridDim.z;
    unsigned sum, cnt, mine, sp = 0u;
    for (;;) {
        sum = 0u; cnt = 0u; mine = 0u;
#pragma unroll
        for (unsigned j = 0; j < 16; ++j) { const unsigned c = xb_ld(&bar[XB_XCNT(j)]); sum += c; cnt += (c > 0u) ? 1u : 0u; mine = (j == x) ? c : mine; }
        if (sum == G) break;
        __builtin_amdgcn_s_sleep(1);
        if ((++sp & 255u) == 0u) { if (xb_ld(&bar[XB_TMO])) break; if (sp > XB_SPIN_CAP) { atomicAdd(&bar[XB_TMO], 1u); break; } }
    }
    nloc = mine > 0u ? mine : 1u; nx = cnt > 0u ? cnt : 1u;
}

__device__ __forceinline__ void xcd_barrier(const XcdBarrier& b, int tid) {
    asm volatile("s_waitcnt vmcnt(0)" ::: "memory");
    __syncthreads();
    if (tid == 0) {
        unsigned* bar = b.bar;
        __builtin_amdgcn_s_waitcnt(0);
        unsigned nloc = b.st[0], nx = b.st[1];
        if (nloc == 0u) { xcd_barrier_complete(bar, b.x, nloc, nx); b.st[0] = nloc; b.st[1] = nx; }
        const unsigned old = xb_add(&bar[XB_XSUB(b.x)], 1u);
        const unsigned gen = old / nloc;
        if (old + 1u == (gen + 1u) * nloc) {
            __builtin_amdgcn_fence(__ATOMIC_RELEASE, "agent");
            asm volatile("s_waitcnt vmcnt(0)" ::: "memory");
            const unsigned og = xb_add(&bar[XB_TOP], 1u);
            const unsigned tg = og / nx;
            if (og + 1u == (tg + 1u) * nx) xb_add(&bar[XB_TOPGEN], 1u);
            else XB_SPIN(xb_ld(&bar[XB_TOPGEN]) == tg, bar);
            __builtin_amdgcn_fence(__ATOMIC_ACQUIRE, "agent");
            xb_add(&bar[XB_XGEN(b.x)], 1u);
            asm volatile("s_waitcnt vmcnt(0)" ::: "memory");
        } else {
            XB_SPIN(xb_ld(&bar[XB_XGEN(b.x)]) == gen, bar);
            __builtin_amdgcn_fence(__ATOMIC_ACQUIRE, "agent");
            asm volatile("s_waitcnt vmcnt(0)" ::: "memory");
        }
    }
    __syncthreads();
}

constexpr int CW_BAR = 4096; constexpr size_t CTL_ZERO_BYTES = 65536; constexpr int MISC_OFF = 131072;
__device__ __forceinline__ void epi_tables(LAS unsigned char* L, const pg8::StaticOrder& S, const float* ssq, const float* bias, int bstride, int tid) {
    LAS int* tags = (LAS int*)(L + pg8::TAB_OFF); LAS float* rT = (LAS float*)(L + pg8::TAB_OFF + 64); LAS float* bT = rT + pg8::TAB_SLOTS * 256;
    for (int i = 0; i < pg8::TAB_SLOTS; ++i) { pg8::Unit u;
        if (!S.next(i, u)) { if (tid == 0) tags[i] = -1; continue; }
        if (tid == 0) tags[i] = (u.pm << 8) | u.pn;
        if (ssq) { const int row = tid >> 1, hf = tid & 1; const float* q = ssq + (size_t)(u.pm * 256 + row) * 32 + hf * 16;
            const f32x4 a = *(const f32x4*)q, b = *(const f32x4*)(q + 4), c = *(const f32x4*)(q + 8), d = *(const f32x4*)(q + 12);
            float t = (((a.x + a.y) + (a.z + a.w)) + ((b.x + b.y) + (b.z + b.w))) + (((c.x + c.y) + (c.z + c.w)) + ((d.x + d.y) + (d.z + d.w)));
            t += __shfl_xor(t, 1); if (hf == 0) rT[i * 256 + row] = 1.0f / sqrtf(t * (1.0f / DM) + EPS); }
        if (tid < 256) bT[i * 256 + tid] = bias[(size_t)(u.pm >> 4) * bstride + u.pn * 256 + tid]; }
    __syncthreads();
}
struct Args { const void* in[35]; float* out; unsigned char* ws; int lo, hi; };
__device__ __forceinline__ int lane_id() { int l; asm volatile("v_mbcnt_lo_u32_b32 %0, -1, 0\n\tv_mbcnt_hi_u32_b32 %0, -1, %0" : "=v"(l)); return l; }
#define lt_tid() (wave * 64 + lane_id())
typedef const __attribute__((address_space(4))) unsigned long long* kargp_t;
__device__ __forceinline__ const void* karg(int i) { return (const void*)(const GAS void*)(((kargp_t)__builtin_amdgcn_kernarg_segment_ptr())[i]); }
#define KP(i) karg(i)

template <int NR> __device__ __forceinline__ void rows_norm_mod(const float* X, const float* g1, const float* sh1, const float* sc1, hb* o1, int gw, int NGW, int lane) {
    const unsigned l4 = 4u * (unsigned)lane;
    for (int R0 = NR * gw; R0 < M; R0 += NR * NGW) {
        const int b = R0 >> 12;
        const float* scb = sc1 + (size_t)b * NMOD; const float* shb = sh1 + (size_t)b * NMOD;
        f32x4 v[NR][8], gm[8], hh[8];
#pragma unroll
        for (int r = 0; r < NR; ++r) { const float* xr = X + (size_t)(R0 + r) * DM;
#pragma unroll
            for (int j = 0; j < 8; ++j) v[r][j] = __builtin_nontemporal_load((const f32x4*)(xr + (l4 + 256u * j))); }
#pragma unroll
        for (int j = 0; j < 8; ++j) { const unsigned col = l4 + 256u * j; gm[j] = *(const f32x4*)(g1 + col) * (*(const f32x4*)(scb + col) + 1.0f); hh[j] = *(const f32x4*)(shb + col); }
        float rstd[NR];
#pragma unroll
        for (int r = 0; r < NR; ++r) { float ss = 0.f;
#pragma unroll
            for (int j = 0; j < 8; ++j) ss += (v[r][j].x * v[r][j].x + v[r][j].y * v[r][j].y) + (v[r][j].z * v[r][j].z + v[r][j].w * v[r][j].w);
            rstd[r] = 1.0f / sqrtf(wave_sum(ss) * (1.0f / DM) + EPS); }
#pragma unroll
        for (int r = 0; r < NR; ++r) {
#pragma unroll
            for (int j = 0; j < 8; ++j) { const f32x4 y = (v[r][j] * rstd[r]) * gm[j] + hh[j]; *(v2u*)(o1 + tidx(R0 + r, (int)(l4 + 256u * j), DM)) = (v2u){pk2(y.x, y.y), pk2(y.z, y.w)}; } }
    }
}

__device__ __forceinline__ void qk_norm_rope(const float* raw, const float* g, const float* rt, hb* out, int gw, int NGW, int lane) {
    const int h = lane >> 2, q = lane & 3;
    float ga[16], gb[16];
#pragma unroll
    for (int e = 0; e < 16; ++e) { ga[e] = g[q * 16 + e]; gb[e] = g[64 + q * 16 + e]; }
    for (int row = gw; row < M; row += NGW) {
        const int b = row >> 12, s = row & 4095;
        const float* p = raw + (size_t)row * DM + h * 128 + q * 16;
        f32x4 a[4], c[4], cs[8]; float ss = 0.f;
#pragma unroll
        for (int e = 0; e < 4; ++e) { a[e] = *(const f32x4*)(p + 4 * e); c[e] = *(const f32x4*)(p + 64 + 4 * e);
            ss += (a[e].x * a[e].x + a[e].y * a[e].y) + (a[e].z * a[e].z + a[e].w * a[e].w) + (c[e].x * c[e].x + c[e].y * c[e].y) + (c[e].z * c[e].z + c[e].w * c[e].w); }
        const float* t = rt + ((size_t)row * 64 + q * 16) * 2;
#pragma unroll
        for (int e = 0; e < 8; ++e) cs[e] = *(const f32x4*)(t + 4 * e);
        ss += __shfl_xor(ss, 1); ss += __shfl_xor(ss, 2);
        const float rstd = 1.0f / sqrtf(ss * (1.0f / 128.0f) + EPS);
        float o1[16], o2[16];
#pragma unroll
        for (int e = 0; e < 16; ++e) { const float x1 = a[e >> 2][e & 3] * rstd * ga[e], x2 = c[e >> 2][e & 3] * rstd * gb[e];
            const float co = cs[e >> 1][(e & 1) * 2], si = cs[e >> 1][(e & 1) * 2 + 1];
            o1[e] = x1 * co - x2 * si; o2[e] = x2 * co + x1 * si; }
        hb* op = out + ((size_t)(b * 16 + h) * SEQ + s) * 128 + q * 16;
        *(v4u*)(op) = (v4u){pk2(o1[0], o1[1]), pk2(o1[2], o1[3]), pk2(o1[4], o1[5]), pk2(o1[6], o1[7])};
        *(v4u*)(op + 8) = (v4u){pk2(o1[8], o1[9]), pk2(o1[10], o1[11]), pk2(o1[12], o1[13]), pk2(o1[14], o1[15])};
        *(v4u*)(op + 64) = (v4u){pk2(o2[0], o2[1]), pk2(o2[2], o2[3]), pk2(o2[4], o2[5]), pk2(o2[6], o2[7])};
        *(v4u*)(op + 72) = (v4u){pk2(o2[8], o2[9]), pk2(o2[10], o2[11]), pk2(o2[12], o2[13]), pk2(o2[14], o2[15])};
    }
}

__device__ __forceinline__ void attn_combine(const float* O, const float* sg, float lam, hb* A, int gw, int NGW, int lane) {
    const int h = lane >> 3, q = lane & 7, v = q >> 2, d0 = (q & 3) * 32;
    f32x4 gg[8];
#pragma unroll
    for (int e = 0; e < 8; ++e) gg[e] = *(const f32x4*)(sg + v * 128 + d0 + 4 * e);
    for (int R0 = 2 * gw; R0 < M; R0 += 2 * NGW) {
        const int b = R0 >> 12, s = R0 & 4095;
        const float* p1 = O + ((size_t)(b * 32 + 4 * h + v) * SEQ + s) * 128 + d0;
        const float* p2 = O + ((size_t)(b * 32 + 4 * h + 2 + v) * SEQ + s) * 128 + d0;
        f32x4 x1[2][8], x2[2][8];
#pragma unroll
        for (int r = 0; r < 2; ++r)
#pragma unroll
            for (int e = 0; e < 8; ++e) { x1[r][e] = *(const f32x4*)(p1 + r * 128 + 4 * e); x2[r][e] = *(const f32x4*)(p2 + r * 128 + 4 * e); }
#pragma unroll
        for (int r = 0; r < 2; ++r) { float ss = 0.f;
#pragma unroll
            for (int e = 0; e < 8; ++e) { x1[r][e] = x1[r][e] - lam * x2[r][e]; ss += (x1[r][e].x * x1[r][e].x + x1[r][e].y * x1[r][e].y) + (x1[r][e].z * x1[r][e].z + x1[r][e].w * x1[r][e].w); }
            ss += __shfl_xor(ss, 1); ss += __shfl_xor(ss, 2); ss += __shfl_xor(ss, 4);
            const float rstd = (1.0f - LAM_INIT) / sqrtf(ss * (1.0f / 256.0f) + EPS);
            hb* op = A + tidx(R0 + r, h * 256 + v * 128 + d0, DM);
#pragma unroll
            for (int e = 0; e < 8; e += 2) { const f32x4 y0 = x1[r][e] * rstd * gg[e], y1 = x1[r][e + 1] * rstd * gg[e + 1];
                *(v4u*)(op + 4 * e) = (v4u){pk2(y0.x, y0.y), pk2(y0.z, y0.w), pk2(y1.x, y1.y), pk2(y1.z, y1.w)}; } }
    }
}

__device__ __forceinline__ att::BlockRef<att::bf16, float> mkref(int Lx, int pass, const hb* Qb, const hb* Kb, const hb* Vb, float* Ob) {
    const int bh = Lx >> 3, xx = Lx & 7, qb = pass ? 15 - xx : xx; const int b = bh >> 5, r = bh & 31, hh = r >> 2, s = (r >> 1) & 1, v = r & 1;
    att::BlockRef<att::bf16, float> rr;
    rr.Q = (const att::bf16*)Qb + ((size_t)(b * 16 + 2 * hh + s) * SEQ + (size_t)qb * att::QB) * 128; rr.K = (const att::bf16*)Kb + (size_t)(b * 16 + 2 * hh + s) * SEQ * 128;
    rr.V = (const att::bf16*)Vb + (size_t)(b * 16 + 2 * hh + v) * SEQ * 128; rr.O = Ob + ((size_t)(b * 32 + r) * SEQ + (size_t)qb * att::QB) * 128; rr.P0 = qb * att::QB; return rr;
}
#define XIN ((const float*)KP(0))
#define cvec ((const float*)KP(1))
#define positions ((const int*)KP(2))
#define mods ((float*)(ws + WS_MODS))
#define gam ((float*)(ws + WS_GAM))
#define biasT ((float*)(ws + WS_BIAS))
#define SSQ ((float*)(ws + WS_SSQ))
#define rt ((float*)(ws + WS_RT))
#define stats ((float*)(ws + WS_STATS))
#define W_in ((hb*)(ws + WS_W_IN))
#define W_out ((hb*)(ws + WS_W_OUT))
#define W_fia ((hb*)(ws + WS_W_FIA))
#define W_foa ((hb*)(ws + WS_W_FOA))
#define W_kv ((hb*)(ws + WS_W_KV))
#define W_q ((hb*)(ws + WS_W_Q))
#define W_o ((hb*)(ws + WS_W_O))
#define W_fib ((hb*)(ws + WS_W_FIB))
#define W_fob ((hb*)(ws + WS_W_FOB))
#define XA ((float*)(ws + WS_XA))
#define XB ((float*)(ws + WS_XB))
#define XN ((hb*)(ws + WS_XN))
#define XQ ((hb*)(ws + WS_XQ))
#define A3 ((hb*)(ws + WS_A3))
#define Z ((hb*)(ws + WS_Z))
#define H ((hb*)(ws + WS_H))
#define KRAW ((float*)(ws + WS_KRAW))
#define QRAW ((float*)(ws + WS_QRAW))
#define OB ((float*)(ws + WS_O))
#define VB ((hb*)(ws + WS_VB))
#define KB ((hb*)(ws + WS_KB))
#define QB_ ((hb*)(ws + WS_QB))
__device__ __forceinline__ void bias_chunks(unsigned char* ws, int c_lo, int c_hi, int gw, int NGW, int lane) {
        for (int c = c_lo + gw; c < c_hi; c += NGW) { const int r0 = 16 * c; const hb* Wt; int sho;
            int rl;
            if (r0 < OFF_KV) { Wt = W_fia; rl = r0; sho = MOD_A + 6144; } else if (r0 < OFF_Q) { Wt = W_kv; rl = r0 - OFF_KV; sho = MOD_KV; }
            else if (r0 < OFF_FIB) { Wt = W_q; rl = r0 - OFF_Q; sho = MOD_B; } else { Wt = W_fib; rl = r0 - OFF_FIB; sho = MOD_B + 6144; }
            f32x4 s0[4][2], s1[4][2];
#pragma unroll
            for (int j = 0; j < 4; ++j)
#pragma unroll
                for (int e = 0; e < 2; ++e) { s0[j][e] = *(const f32x4*)(mods + sho + 8 * lane + 512 * j + 4 * e); s1[j][e] = *(const f32x4*)(mods + NMOD + sho + 8 * lane + 512 * j + 4 * e); }
            for (int hf = 0; hf < 4; ++hf) { v4u wv[4][4];
#pragma unroll
                for (int r = 0; r < 4; ++r)
#pragma unroll
                    for (int j = 0; j < 4; ++j) wv[r][j] = __builtin_nontemporal_load((const v4u*)(Wt + tidx(rl + 4 * hf + r, 8 * lane + 512 * j, DM)));
                float myb0 = 0.f, myb1 = 0.f;
#pragma unroll
                for (int r = 0; r < 4; ++r) { float a0 = 0.f, a1 = 0.f;
#pragma unroll
                    for (int j = 0; j < 4; ++j) { const v4u w = wv[r][j]; const f32x4 lo = {bflo(w.x), bfhi(w.x), bflo(w.y), bfhi(w.y)}, hi2 = {bflo(w.z), bfhi(w.z), bflo(w.w), bfhi(w.w)};
                        const f32x4 p0 = lo * s0[j][0] + hi2 * s0[j][1], p1 = lo * s1[j][0] + hi2 * s1[j][1]; a0 += (p0.x + p0.y) + (p0.z + p0.w); a1 += (p1.x + p1.y) + (p1.z + p1.w); }
                    a0 = wave_sum(a0); a1 = wave_sum(a1); if (lane == r) { myb0 = a0; myb1 = a1; } }
                if (lane < 4) { biasT[r0 + 4 * hf + lane] = myb0; biasT[pg8::NBIAS + r0 + 4 * hf + lane] = myb1; } }
        }
}
__global__ void __launch_bounds__(NWAVES * 64, 2) yoco_fwd(Args args) {
    extern __shared__ __attribute__((aligned(16))) unsigned char lds[];
    LAS unsigned char* L = (LAS unsigned char*)lds;
    const int wave = __builtin_amdgcn_readfirstlane((int)threadIdx.x >> 6);
#define PH_IDS const int tid = lt_tid(), lane = tid & 63
    volatile LAS unsigned* MISC = (volatile LAS unsigned*)(L + MISC_OFF);
    { const int t0 = lt_tid(); if (t0 < 16) MISC[t0] = 0u; }
    __syncthreads();
    const int G = gridDim.x, bx = blockIdx.x;
    const int gw = bx * NWAVES + wave, NGW = G * NWAVES;
    unsigned char* ws = (unsigned char*)KP(36);
    const unsigned long long lohi = ((kargp_t)__builtin_amdgcn_kernarg_segment_ptr())[37]; const int lo = (int)(unsigned)lohi, hi = (int)(unsigned)(lohi >> 32);
#ifndef PHM
#define PHM 0x1ffff
#endif
#define IN(k) (((PHM >> (k)) & 1) && lo <= (k) && (k) < hi)
    XcdBarrier xbar; xbar.bar = (unsigned*)ws + CW_BAR; xbar.x = 0; xbar.st = nullptr;
    if (hi - lo > 1) xbar = xcd_barrier_post((unsigned*)ws + CW_BAR, MISC + 8, lt_tid());
#define SEAM(k) do { if (IN(k) && IN((k) + 1)) { xcd_barrier(xbar, lt_tid()); } } while (0)
    if (lo < 0) cg::this_grid().sync();

    if (IN(0)) { PH_IDS;
        {
            LAS float* sc = (LAS float*)L; LAS float* red = (LAS float*)(L + 16384);
            for (int i = tid; i < 2 * DM; i += NWAVES * 64) { const float cv = cvec[i]; sc[i] = cv / (1.0f + __expf(-cv)); }
            __syncthreads();
            for (int it = bx; it < NMOD / 128; it += G) {
                const int gc = it * 128; const float* Wm; const float* bm; int N, c0;
                if (gc < MOD_KV) { Wm = (const float*)KP(3); bm = (const float*)KP(4); N = 12288; c0 = gc; }
                else if (gc < MOD_B) { Wm = (const float*)KP(16); bm = (const float*)KP(17); N = 4096; c0 = gc - MOD_KV; }
                else { Wm = (const float*)KP(21); bm = (const float*)KP(22); N = 12288; c0 = gc - MOD_B; }
                const float* wp = Wm + (size_t)(256 * wave) * N + c0 + 2 * lane;
                f32x2 a0 = {0.f, 0.f}, a1 = {0.f, 0.f};
#pragma unroll 32
                for (int kk = 0; kk < 256; ++kk) { const f32x2 wv = __builtin_nontemporal_load((const f32x2*)(wp + (size_t)kk * N)); const float s0 = sc[256 * wave + kk], s1 = sc[DM + 256 * wave + kk]; a0 += wv * s0; a1 += wv * s1; }
                red[(wave * 2 + 0) * 128 + 2 * lane] = a0.x; red[(wave * 2 + 0) * 128 + 2 * lane + 1] = a0.y;
                red[(wave * 2 + 1) * 128 + 2 * lane] = a1.x; red[(wave * 2 + 1) * 128 + 2 * lane + 1] = a1.y;
                __syncthreads();
                if (tid < 256) { const int b = tid >> 7, cc = tid & 127; float s = bm[c0 + cc];
#pragma unroll
                    for (int w = 0; w < 8; ++w) s += red[(w * 2 + b) * 128 + cc];
                    mods[(size_t)b * NMOD + gc + cc] = s; }
                __syncthreads();
            }
        }
        for (int idx = gw * 64 + lane; idx < M * 64; idx += NGW * 64) { const int row = idx >> 6, i = idx & 63;
            const float inv = 1.0f / exp2f((float)i * (13.287712379549449f / 64.0f)); const float ang = (float)positions[row] * inv;
            double rev = (double)ang * 0.15915494309189535; rev -= floor(rev); const float rf = (float)rev;
            *(f32x2*)(rt + (size_t)idx * 2) = (f32x2){__builtin_amdgcn_cosf(rf), __builtin_amdgcn_sinf(rf)}; }
        {
            LAS float* scr = (LAS float*)(L + wave * 16384);
            constexpr int I_IN = (DM / 64) * (2 * DM / 32), I_SQ = (DM / 64) * (DM / 32), I_FI = (DM / 64) * (2 * DFF / 32), I_FO = (DFF / 64) * (DM / 32);
            constexpr int NITEMS = 2 * I_IN + 3 * I_SQ + 2 * I_FI + 2 * I_FO;
#define TR_DECODE(T, itx) do { int r = (itx); \
                if (r < I_IN) { T.W = (const float*)KP(6); T.WT = W_in; T.K = DM; T.N = 2 * DM; T.mode = 0; T.lim = 0; } else { r -= I_IN; \
                if (r < I_SQ) { T.W = (const float*)KP(12); T.WT = W_out; T.K = DM; T.N = DM; T.mode = 0; T.lim = 0; } else { r -= I_SQ; \
                if (r < I_FI) { T.W = (const float*)KP(14); T.WT = W_fia; T.K = DM; T.N = 2 * DFF; T.mode = 1; T.lim = 0; } else { r -= I_FI; \
                if (r < I_FO) { T.W = (const float*)KP(15); T.WT = W_foa; T.K = DFF; T.N = DM; T.mode = 0; T.lim = 0; } else { r -= I_FO; \
                if (r < I_IN) { T.W = (const float*)KP(19); T.WT = W_kv; T.K = DM; T.N = 2 * DM; T.mode = 2; T.lim = DM; } else { r -= I_IN; \
                if (r < I_SQ) { T.W = (const float*)KP(24); T.WT = W_q; T.K = DM; T.N = DM; T.mode = 2; T.lim = DM; } else { r -= I_SQ; \
                if (r < I_SQ) { T.W = (const float*)KP(31); T.WT = W_o; T.K = DM; T.N = DM; T.mode = 0; T.lim = 0; } else { r -= I_SQ; \
                if (r < I_FI) { T.W = (const float*)KP(33); T.WT = W_fib; T.K = DM; T.N = 2 * DFF; T.mode = 1; T.lim = 0; } else { r -= I_FI; \
                                T.W = (const float*)KP(34); T.WT = W_fob; T.K = DFF; T.N = DM; T.mode = 0; T.lim = 0; } } } } } } } } \
                const int nblk_ = T.N / 32; T.k0 = 64 * (r / nblk_); T.n0 = 32 * (r % nblk_); } while (0)
            float tv[32]; TrItem cur, nxt;
            int it = gw;
            if (it < NITEMS) { TR_DECODE(cur, it); tr_load(cur, tv, lane); nxt = cur; }
            while (it < NITEMS) {
#pragma unroll
                for (int i = 0; i < 32; ++i) { const int kk = 2 * i + (lane >> 5); scr[kk * 33 + (lane & 31)] = tv[i]; }
                LDS_WAIT(); asm volatile("" ::: "memory");
                const int itn = it + NGW;
                if (itn < NITEMS) { TR_DECODE(nxt, itn); tr_load(nxt, tv, lane); }
                const int c = lane & 7;
#pragma unroll
                for (int j = 0; j < 4; ++j) { const int n = (lane >> 3) + 8 * j; const LAS float* sp = scr + (8 * c) * 33 + n;
                    v4u o; o.x = pk2(sp[0 * 33], sp[1 * 33]); o.y = pk2(sp[2 * 33], sp[3 * 33]); o.z = pk2(sp[4 * 33], sp[5 * 33]); o.w = pk2(sp[6 * 33], sp[7 * 33]);
                    __builtin_nontemporal_store(o, (GAS v4u*)(cur.WT + tidx(wt_rowmap(cur.n0 + n, cur.mode, cur.N, cur.lim), cur.k0 + 8 * c, cur.K))); }
                LDS_WAIT(); asm volatile("" ::: "memory");
                cur = nxt; it = itn;
            }
#undef TR_DECODE
        }
        __syncthreads();
    }
    SEAM(0);
    if (IN(1)) { PH_IDS;
        rows_norm_mod<2>(XIN, (const float*)KP(5), mods + MOD_A + 0, mods + MOD_A + 2048, XN, gw, NGW, lane); }
    if (IN(1)) { PH_IDS;
        for (int idx = gw * 64 + lane; idx < 4 * 2 * DM; idx += NGW * 64) { const int m = idx >> 12, b = (idx >> 11) & 1, col = idx & 2047;
            const float* gp = m == 0 ? (const float*)KP(13) : m == 1 ? (const float*)KP(18) : m == 2 ? (const float*)KP(23) : (const float*)KP(32);
            const int so = m == 0 ? MOD_A + 8192 : m == 1 ? MOD_KV + 2048 : m == 2 ? MOD_B + 2048 : MOD_B + 8192;
            gam[idx] = gp[col] * (1.0f + mods[(size_t)b * NMOD + so + col]); }
        bias_chunks(ws, 0, (G == 256) ? OFF_KV / 16 : pg8::NBIAS / 16, gw, NGW, lane);
    }
    SEAM(1);
    if (IN(2)) { pg8::Gemm g{XN, W_in, M, 2 * DM, DM}; pg8::StaticOrder S; S.init(M, 2 * DM, G, bx);
        epi_tables(L, S, nullptr, (const float*)KP(7), 0, lt_tid());
        pg8::EpiGeluStats E{Z, 2 * DM, L + pg8::TAB_OFF, stats};
        pg8::gemm_phase<pg8::EpiGeluStats, pg8::StaticOrder, true, true>(L, g, S, E, lt_tid()); }
    SEAM(2);
    if (IN(3)) { PH_IDS;
        LAS hb* vTb = (LAS hb*)L; LAS f32x2* st = (LAS f32x2*)(L + 73728);
        const float* lng = (const float*)KP(8); const float* lnb = (const float*)KP(9); const float* sw = (const float*)KP(10); const float* sb = (const float*)KP(11);
        const int tl = lane & 15, quad = lane >> 4; int cur_g = -1; bf16x8 wf[4]; int buf = 0;
        v4u zpre[4]; v2u upre[8];
#define ZULOAD(uu) do { const int g_ = (uu) & 15, R_ = ((uu) >> 4) * 128; _Pragma("unroll") for (int i = 0; i < 4; ++i) { const int qd = tid + 512 * i; \
            zpre[i] = *(const v4u*)(Z + (size_t)(R_ + (qd >> 4)) * (2 * DM) + DM + g_ * 128 + (qd & 15) * 8); } \
            _Pragma("unroll") for (int nt = 0; nt < 8; ++nt) upre[nt] = *(const v2u*)(Z + (size_t)(R_ + 16 * wave + tl) * (2 * DM) + g_ * 128 + 16 * nt + quad * 4); } while (0)
        for (int u0 = bx; u0 < 1024; u0 += 4 * G) {
            { const int j = tid >> 7, r = tid & 127, uj = u0 + j * G;
              if (uj < 1024) { const float* sp = stats + (size_t)((uj >> 4) * 128 + r) * 64; float s1 = 0.f, s2 = 0.f;
#pragma unroll
                for (int i = 0; i < 16; ++i) { const f32x4 p = *(const f32x4*)(sp + 4 * i); s1 += p.x + p.z; s2 += p.y + p.w; }
                const float mean = s1 * (1.0f / DM); const float var = fmaxf(s2 * (1.0f / DM) - mean * mean, 0.f); st[tid] = (f32x2){mean, 1.0f / sqrtf(var + EPS)}; } }
            ZULOAD(u0);
            __syncthreads();
            for (int j = 0; j < 4; ++j) { const int u = u0 + j * G; if (u >= 1024) break;
                const int g = u & 15, R0 = (u >> 4) * 128; LAS hb* vT = vTb + buf * (128 * 136);
                if (g != cur_g) { cur_g = g; const int t = 16 * wave + tl;
#pragma unroll
                    for (int ks = 0; ks < 4; ++ks) { const int s0 = 32 * ks + 8 * quad; const float* wp = sw + ((size_t)g * 128 + t) * 128 + s0;
                        const f32x4 w0 = *(const f32x4*)wp, w1 = *(const f32x4*)(wp + 4); float wv[8] = {w0.x, w0.y, w0.z, w0.w, w1.x, w1.y, w1.z, w1.w};
#pragma unroll
                        for (int jj = 0; jj < 8; ++jj) if (s0 + jj > t) wv[jj] = 0.f;
                        v4u pw = {pk2(wv[0], wv[1]), pk2(wv[2], wv[3]), pk2(wv[4], wv[5]), pk2(wv[6], wv[7])}; wf[ks] = __builtin_bit_cast(bf16x8, pw); } }
#pragma unroll
                for (int i = 0; i < 4; ++i) { const int qd = tid + 512 * i, s = qd >> 4, cc = (qd & 15) * 8;
                    const v4u zv = zpre[i]; const f32x2 ms = st[j * 128 + s];
                    const f32x4 g0 = *(const f32x4*)(lng + g * 128 + cc), g1 = *(const f32x4*)(lng + g * 128 + cc + 4), b0 = *(const f32x4*)(lnb + g * 128 + cc), b1 = *(const f32x4*)(lnb + g * 128 + cc + 4);
                    float y[8] = {bflo(zv.x), bfhi(zv.x), bflo(zv.y), bfhi(zv.y), bflo(zv.z), bfhi(zv.z), bflo(zv.w), bfhi(zv.w)};
                    const float gg[8] = {g0.x, g0.y, g0.z, g0.w, g1.x, g1.y, g1.z, g1.w}, bb[8] = {b0.x, b0.y, b0.z, b0.w, b1.x, b1.y, b1.z, b1.w};
#pragma unroll
                    for (int e = 0; e < 8; ++e) vT[(cc + e) * 136 + s] = (hb)f2bf((y[e] - ms.x) * ms.y * gg[e] + bb[e]); }
                v2u ucur[8];
#pragma unroll
                for (int nt = 0; nt < 8; ++nt) ucur[nt] = upre[nt];
                if (j < 3 && u + G < 1024) ZULOAD(u + G);
                __syncthreads();
                { const int t = 16 * wave + tl, row = R0 + t; const float bias = sb[g * 128 + t];
#pragma unroll
                  for (int nt = 0; nt < 8; ++nt) { f32x4 acc = {0.f, 0.f, 0.f, 0.f};
#pragma unroll
                    for (int ks = 0; ks < 4; ++ks) if (ks <= (wave >> 1)) { const bf16x8 bfr = *(const LAS bf16x8*)(vT + (16 * nt + tl) * 136 + 32 * ks + 8 * quad);
                        acc = __builtin_amdgcn_mfma_f32_16x16x32_bf16(bfr, wf[ks], acc, 0, 0, 0); }
                    const int col = g * 128 + 16 * nt + quad * 4; const v2u uv = ucur[nt];
                    const float y0 = bflo(uv.x) * (acc[0] + bias), y1 = bfhi(uv.x) * (acc[1] + bias), y2 = bflo(uv.y) * (acc[2] + bias), y3 = bfhi(uv.y) * (acc[3] + bias);
                    *(v2u*)(A3 + tidx(row, col, DM)) = (v2u){pk2(y0, y1), pk2(y2, y3)}; } }
                buf ^= 1;
            }
            __syncthreads();
        }
#undef ZULOAD
    }
    SEAM(3);
    if (IN(4)) { pg8::Gemm g{A3, W_out, M, DM, DM}; pg8::StaticOrder S; S.init(M, DM, G, bx);
        pg8::EpiResNorm<true> E{XIN, XA, mods + MOD_A + 4096, NMOD, DM, gam + 0 * 4096, XN, nullptr, nullptr, SSQ};
        pg8::gemm_phase<pg8::EpiResNorm<true>, pg8::StaticOrder, true, true>(L, g, S, E, lt_tid()); }
    SEAM(4);
    if (IN(6)) { pg8::Gemm g{XN, W_fia, M, 2 * DFF, DM}; pg8::StaticOrder S; S.init(M, 2 * DFF, G, bx);
        epi_tables(L, S, SSQ, biasT + OFF_FIA, pg8::NBIAS, lt_tid());
        pg8::EpiSwiGLU E{H, DFF, L + pg8::TAB_OFF};
        pg8::gemm_phase<pg8::EpiSwiGLU, pg8::StaticOrder, true, true>(L, g, S, E, lt_tid());
        if (G == 256 && bx >= 128) { PH_IDS; (void)tid; bias_chunks(ws, OFF_KV / 16, pg8::NBIAS / 16, (bx - 128) * NWAVES + wave, 128 * NWAVES, lane); }
    }
    SEAM(6);
    if (IN(7)) { pg8::Gemm g{H, W_foa, M, DM, DFF}; pg8::StaticOrder S; S.init(M, DM, G, bx);
        pg8::EpiResNorm<false> E{XA, XB, mods + MOD_A + 10240, NMOD, DM, gam + 1 * 4096, XN, gam + 2 * 4096, XQ, SSQ};
        pg8::gemm_phase<pg8::EpiResNorm<false>, pg8::StaticOrder, true, true>(L, g, S, E, lt_tid()); }
    SEAM(7);
    if (IN(9)) {
        { pg8::Gemm g{XN, W_kv, M, DM, DM}; pg8::StaticOrder S; S.init(M, DM, G, bx); pg8::EpiQKRope E{KB, (const float*)KP(20), rt, SSQ, biasT + OFF_KV};
          pg8::gemm_phase<pg8::EpiQKRope, pg8::StaticOrder, false, true>(L, g, S, E, lt_tid()); }
        { pg8::Gemm g{XN, W_kv + (size_t)DM * DM, M, DM, DM}; pg8::StaticOrder S; S.init(M, DM, G, bx); pg8::EpiVhead E{VB, SSQ, biasT + OFF_KV + DM};
          pg8::gemm_phase<pg8::EpiVhead, pg8::StaticOrder, true, true>(L, g, S, E, lt_tid()); }
        { pg8::Gemm g{XQ, W_q, M, DM, DM}; pg8::StaticOrder S; S.init(M, DM, G, bx); pg8::EpiQKRope E{QB_, (const float*)KP(25), rt, SSQ, biasT + OFF_Q};
          pg8::gemm_phase<pg8::EpiQKRope, pg8::StaticOrder, false, true>(L, g, S, E, lt_tid()); }
    }
    SEAM(9);
#define SKIP10 1
    if (IN(11)) {
        typedef att::BlockRef<att::bf16, float> BR;
        const int total = 8 * 64, stride = G;
        int Li = (G % 8 == 0) ? (bx % 8) * (G / 8) + bx / 8 : bx;
        if (Li < total) {
#define MKREF(Lx, pass) mkref((Lx), (pass), QB_, KB, VB, OB)
            int pass = 0; BR cur = MKREF(Li, 0);
            att::Seam<att::bf16> S;
            att::causal_swa_prime<att::bf16, float>(cur, SEQ, (char*)lds, S, lt_tid());
            for (;;) {
                const bool more_pass = pass == 0, more_item = Li + stride < total, last = !more_pass && !more_item;
                int passn = pass + 1, Ln = Li;
                if (!more_pass) { passn = 0; Ln = more_item ? Li + stride : Li; }
                const BR nxt = last ? cur : MKREF(Ln, passn);
                att::causal_swa_block<att::bf16, float>(cur, nxt, SEQ, SEQ, (char*)lds, S, lt_tid());
                if (last) break;
                cur = nxt; pass = passn; Li = Ln;
            }
#undef MKREF
        }
    }
    SEAM(11);
    if (IN(12)) { PH_IDS;
        const float* q1 = (const float*)KP(26); const float* k1 = (const float*)KP(27); const float* q2 = (const float*)KP(28); const float* k2 = (const float*)KP(29);
        const float d1 = wave_sum(q1[lane] * k1[lane] + q1[lane + 64] * k1[lane + 64]), d2 = wave_sum(q2[lane] * k2[lane] + q2[lane + 64] * k2[lane + 64]);
        const float lam = expf(d1) - expf(d2) + LAM_INIT;
        attn_combine(OB, (const float*)KP(30), lam, A3, gw, NGW, lane);
    }
    SEAM(12);
    if (IN(13)) { pg8::Gemm g{A3, W_o, M, DM, DM}; pg8::StaticOrder S; S.init(M, DM, G, bx);
        pg8::EpiResNorm<false> E{XB, XA, mods + MOD_B + 4096, NMOD, DM, gam + 3 * 4096, XN, nullptr, nullptr, SSQ};
        pg8::gemm_phase<pg8::EpiResNorm<false>, pg8::StaticOrder, true, true>(L, g, S, E, lt_tid()); }
    SEAM(13);
    if (IN(15)) { pg8::Gemm g{XN, W_fib, M, 2 * DFF, DM}; pg8::StaticOrder S; S.init(M, 2 * DFF, G, bx);
        epi_tables(L, S, SSQ, biasT + OFF_FIB, pg8::NBIAS, lt_tid());
        pg8::EpiSwiGLU E{H, DFF, L + pg8::TAB_OFF};
        pg8::gemm_phase<pg8::EpiSwiGLU, pg8::StaticOrder, true, true>(L, g, S, E, lt_tid()); }
    SEAM(15);
    if (IN(16)) { pg8::Gemm g{H, W_fob, M, DM, DFF}; pg8::StaticOrder S; S.init(M, DM, G, bx);
        pg8::EpiResNorm<false> E{XA, (float*)KP(35), mods + MOD_B + 10240, NMOD, DM, nullptr, nullptr, nullptr, nullptr, nullptr};
        pg8::gemm_phase<pg8::EpiResNorm<false>, pg8::StaticOrder, true, true>(L, g, S, E, lt_tid()); }
#undef IN
#undef SEAM
}
constexpr int NPHASES = 17;

extern "C" void kernel_launch(void* const* d_in, const int* in_sizes, int n_in, void* d_out, int out_size, void* d_ws, size_t ws_size, hipStream_t stream) {
    static int grid = 0;
    if (grid == 0) {
        if (n_in != 35 || in_sizes[0] != M * DM || out_size != M * DM || ws_size < WS_END) { fprintf(stderr, "kernel_launch: unexpected shapes: n_in %d in0 %d out %d ws %zu (need %zu)\n", n_in, n_in > 0 ? in_sizes[0] : -1, out_size, ws_size, (size_t)WS_END); grid = -1; return; }
        int dev = 0, cus = 0, per_cu = 0;
        if (hipGetDevice(&dev) != hipSuccess || hipDeviceGetAttribute(&cus, hipDeviceAttributeMultiprocessorCount, dev) != hipSuccess) { grid = -1; return; }
        if (hipFuncSetAttribute((const void*)yoco_fwd, hipFuncAttributeMaxDynamicSharedMemorySize, LDS_BYTES) != hipSuccess) { fprintf(stderr, "kernel_launch: hipFuncSetAttribute failed\n"); grid = -1; return; }
        if (hipOccupancyMaxActiveBlocksPerMultiprocessor(&per_cu, (const void*)yoco_fwd, NWAVES * 64, LDS_BYTES) != hipSuccess || per_cu < 1) { fprintf(stderr, "kernel_launch: occupancy query gives %d\n", per_cu); per_cu = 1; }
        (void)hipGetLastError();
        if (cus != 256) fprintf(stderr, "kernel_launch: built for a 256-CU device (one 256x256 unit per workgroup in the fused-epilogue GEMM phases); found %d CUs\n", cus);
        grid = cus;
    }
    if (grid < 0) return;
    if (hipMemsetAsync(d_ws, 0, CTL_ZERO_BYTES, stream) != hipSuccess) { fprintf(stderr, "kernel_launch: hipMemsetAsync failed\n"); return; }
    Args a{};
    for (int i = 0; i < 35; ++i) a.in[i] = d_in[i];
    a.out = (float*)d_out; a.ws = (unsigned char*)d_ws;
#if MK_N_LAUNCHES == 1
    a.lo = 0; a.hi = NPHASES;
    void* kargs[] = {&a};
    hipError_t e = hipLaunchCooperativeKernel((const void*)yoco_fwd, dim3(grid), dim3(NWAVES * 64), kargs, LDS_BYTES, stream);
    if (e != hipSuccess) fprintf(stderr, "kernel_launch: cooperative launch failed: %s (grid %d)\n", hipGetErrorString(e), grid);
#else
#ifndef DUP_MASK
#define DUP_MASK 0
#endif
    for (int p = 0; p < NPHASES; ++p) { a.lo = p; a.hi = p + 1; for (int r = 0; r < 1 + ((DUP_MASK >> p) & 1); ++r) hipLaunchKernelGGL(yoco_fwd, dim3(grid), dim3(NWAVES * 64), LDS_BYTES, stream, a); }
#endif
}
```
